# Optimizing an MI355X kernel written in HIP

```python
import math
import jax, jax.numpy as jnp
from jax import lax
import numpy as np

D_MODEL = 2048
BATCH = 2
SEQ = 4096
DEPTH = 4
DEC_BATCH = 8
DEC_SEQ = 4
PAST_LEN = 16384
PAGE_SIZE = 128

N_A_LAYERS = DEPTH // 2
N_B_LAYERS = DEPTH - N_A_LAYERS
SSM_GROUP = 16
N_GROUPS = D_MODEL // SSM_GROUP
SSM_STATE = 64
SCAN_CHUNK = 128
D_FF = 4 * D_MODEL
N_HEADS = 16
HEAD_DIM = D_MODEL // N_HEADS
N_KV = 4
GROUP_Q = N_HEADS // N_KV
ROT_DIM = HEAD_DIM // 4
ROPE_THETA = 500000.0
N_BRANCH = 3
CMP_BLOCK = 32
CMP_STRIDE = 16
CMP_HIDDEN = 2 * HEAD_DIM
SLC_BLOCK = 64
N_SELECT = 16
WINDOW = 512
Q_BLOCK = 32
FORCE_SCORE = 1.0e4
EPS = 1e-6
Q_WIDTH = N_HEADS * HEAD_DIM
KV_WIDTH = N_BRANCH * 2 * N_KV * HEAD_DIM

kernel_name = 'yoco_s5_nsa_decoder_step'


def rmsnorm(x, g):
    xf = x.astype(jnp.float32)
    var = jnp.mean(xf * xf, axis=-1, keepdims=True)
    return (xf * lax.rsqrt(var + EPS) * g.astype(jnp.float32)).astype(x.dtype)


def partial_rope(x, pos):
    half = ROT_DIM // 2
    inv = ROPE_THETA ** (-jnp.arange(half, dtype=jnp.float32) / half)
    ang = pos.astype(jnp.float32)[:, None] * inv[None, :]
    cos = jnp.cos(ang)[None, :, None, :]
    sin = jnp.sin(ang)[None, :, None, :]
    x1 = x[..., :half].astype(jnp.float32)
    x2 = x[..., half:ROT_DIM].astype(jnp.float32)
    rot = jnp.concatenate([x1 * cos - x2 * sin, x2 * cos + x1 * sin], axis=-1).astype(x.dtype)
    return jnp.concatenate([rot, x[..., ROT_DIM:]], axis=-1)


def masked_softmax(s, mask):
    s = jnp.where(mask, s.astype(jnp.float32), -jnp.inf)
    m = jnp.max(s, axis=-1, keepdims=True)
    m = jnp.where(jnp.isfinite(m), m, 0.0)
    e = jnp.where(mask, jnp.exp(s - m), 0.0)
    den = jnp.sum(e, axis=-1, keepdims=True)
    return e / jnp.where(den > 0.0, den, 1.0)


def s5_discretize(lam_re, lam_im, log_dt, b_re, b_im):
    dt = jnp.exp(log_dt.astype(jnp.float32))[:, None]
    lr = lam_re.astype(jnp.float32)
    li = lam_im.astype(jnp.float32)
    mag = jnp.exp(lr * dt)
    a_re = mag * jnp.cos(li * dt)
    a_im = mag * jnp.sin(li * dt)
    den = lr * lr + li * li
    nr = a_re - 1.0
    f_re = (nr * lr + a_im * li) / den
    f_im = (a_im * lr - nr * li) / den
    br = b_re.astype(jnp.float32)
    bi = b_im.astype(jnp.float32)
    bb_re = f_re[..., None] * br - f_im[..., None] * bi
    bb_im = f_re[..., None] * bi + f_im[..., None] * br
    return a_re, a_im, bb_re, bb_im


def _ssm_combine(e1, e2):
    a1r, a1i, b1r, b1i = e1
    a2r, a2i, b2r, b2i = e2
    return (a2r * a1r - a2i * a1i, a2r * a1i + a2i * a1r,
            a2r * b1r - a2i * b1i + b2r, a2r * b1i + a2i * b1r + b2i)


def s5_scan(u, h_re, h_im, a_re, a_im, bb_re, bb_im, c_re, c_im):
    bt, L = u.shape[:2]
    chunk = math.gcd(L, SCAN_CHUNK)
    uc = u.reshape(bt, L // chunk, chunk, N_GROUPS, SSM_GROUP).transpose(1, 0, 2, 3, 4)
    cr = c_re.astype(jnp.float32)
    ci = c_im.astype(jnp.float32)

    def step(carry, u_blk):
        hr, hi = carry
        br = jnp.einsum('bcgi,gpi->bcgp', u_blk, bb_re)
        bi = jnp.einsum('bcgi,gpi->bcgp', u_blk, bb_im)
        br = br.at[:, 0].add(a_re * hr - a_im * hi)
        bi = bi.at[:, 0].add(a_re * hi + a_im * hr)
        ar = jnp.broadcast_to(a_re, br.shape)
        ai = jnp.broadcast_to(a_im, br.shape)
        _, _, sr, si = lax.associative_scan(_ssm_combine, (ar, ai, br, bi), axis=1)
        y = jnp.einsum('bcgp,gip->bcgi', sr, cr) - jnp.einsum('bcgp,gip->bcgi', si, ci)
        return (sr[:, -1], si[:, -1]), y

    (hr, hi), y = lax.scan(step, (h_re, h_im), uc)
    y = y.transpose(1, 0, 2, 3, 4).reshape(bt, L, N_GROUPS, SSM_GROUP)
    return y, hr, hi


def s5_mixer(xn, h_re, h_im, lam_re, lam_im, log_dt, b_re, b_im, c_re, c_im, d_skip, w_glu, b_glu):
    bt, L, _ = xn.shape
    u = xn.astype(jnp.float32).reshape(bt, L, N_GROUPS, SSM_GROUP)
    a_re, a_im, bb_re, bb_im = s5_discretize(lam_re, lam_im, log_dt, b_re, b_im)
    y, hr, hi = s5_scan(u, h_re.astype(jnp.float32), h_im.astype(jnp.float32),
                        a_re, a_im, bb_re, bb_im, c_re, c_im)
    y = y.reshape(bt, L, D_MODEL) + d_skip.astype(jnp.float32) * xn.astype(jnp.float32)
    y = jax.nn.gelu(y).astype(xn.dtype)
    out = y * jax.nn.sigmoid(y @ w_glu + b_glu)
    return out, hr, hi


def sq_relu_mlp(x, w_up, w_down):
    h = jax.nn.relu(x @ w_up)
    return (h * h) @ w_down


def compress_rows(rows, w1, pe, w2):
    bt, T = rows.shape[:2]
    r = CMP_BLOCK // CMP_STRIDE
    n_ch = T // CMP_STRIDE
    n_cmp = n_ch - r + 1
    ch = rows[:, :n_ch * CMP_STRIDE].reshape(bt, n_ch, CMP_STRIDE, N_KV, HEAD_DIM)
    w1r = w1.reshape(r, CMP_STRIDE, HEAD_DIM, CMP_HIDDEN)
    proj = jnp.einsum('bnsgd,jsdh->bnjgh', ch, w1r)
    pre = jnp.einsum('ld,ldh->h', pe, w1)
    for j in range(r):
        pre = pre + proj[:, j:j + n_cmp, j]
    return jax.nn.gelu(pre) @ w2


def shared_kv_stream(x, pos0, past_cmp, past_slc, past_swa, kv_norm, w_kv,
                     cmp_w1_k, cmp_pe_k, cmp_w2_k, cmp_w1_v, cmp_pe_v, cmp_w2_v):
    bt, L, _ = x.shape
    pos = pos0 + jnp.arange(L)
    kv = (rmsnorm(x, kv_norm) @ w_kv).reshape(bt, L, N_BRANCH, 2, N_KV, HEAD_DIM)
    rows_cmp = kv[:, :, 0]
    rows_slc = jnp.stack([partial_rope(kv[:, :, 1, 0], pos), kv[:, :, 1, 1]], axis=2)
    rows_swa = jnp.stack([partial_rope(kv[:, :, 2, 0], pos), kv[:, :, 2, 1]], axis=2)
    if past_cmp is None:
        full_cmp, full_slc, local_swa = rows_cmp, rows_slc, rows_swa
        swa_start = pos0
    else:
        full_cmp = jnp.concatenate([past_cmp, rows_cmp], axis=1)
        full_slc = jnp.concatenate([past_slc, rows_slc], axis=1)
        local_swa = jnp.concatenate([past_swa, rows_swa], axis=1)
        swa_start = pos0 - past_swa.shape[1]
    k_cmp = compress_rows(full_cmp[:, :, 0], cmp_w1_k, cmp_pe_k, cmp_w2_k)
    v_cmp = compress_rows(full_cmp[:, :, 1], cmp_w1_v, cmp_pe_v, cmp_w2_v)
    return rows_cmp, rows_slc, full_slc, local_swa, swa_start, k_cmp, v_cmp


def nsa_attention(q, gates, k_cmp, v_cmp, full_slc, local_swa, q_off, swa_start):
    bt, L = q.shape[:2]
    T = full_slc.shape[1]
    n_cmp = k_cmp.shape[1]
    n_slc = -(-T // SLC_BLOCK)
    k_sel = min(N_SELECT, n_slc)
    scale = HEAD_DIM ** -0.5
    q_pos = q_off + jnp.arange(L)
    q_rot = partial_rope(q, q_pos)
    qg = q.reshape(bt, L, N_KV, GROUP_Q, HEAD_DIM) * scale
    qrg = q_rot.reshape(bt, L, N_KV, GROUP_Q, HEAD_DIM) * scale
    gg = gates.reshape(bt, L, N_KV, GROUP_Q, N_BRANCH)
    slc = jnp.pad(full_slc, ((0, 0), (0, n_slc * SLC_BLOCK - T), (0, 0), (0, 0), (0, 0)))
    slc = slc.reshape(bt, n_slc, SLC_BLOCK, 2, N_KV, HEAD_DIM).transpose(0, 4, 1, 2, 3, 5)
    ci = np.arange(n_cmp)[:, None]
    sj = np.arange(n_slc)[None, :]
    overlap = jnp.asarray(((ci * CMP_STRIDE < (sj + 1) * SLC_BLOCK)
                           & (ci * CMP_STRIDE + CMP_BLOCK > sj * SLC_BLOCK)).astype(np.float32))
    cmp_end = jnp.arange(n_cmp) * CMP_STRIDE + CMP_BLOCK - 1
    blk_idx = jnp.arange(n_slc)
    tw = local_swa.shape[1]
    swa = jnp.pad(local_swa, ((0, 0), (WINDOW, 0), (0, 0), (0, 0), (0, 0)))
    swa_pos = swa_start - WINDOW + jnp.arange(tw + WINDOW)
    b_ix = jnp.arange(bt)[:, None, None, None]
    g_ix = jnp.arange(N_KV)[None, None, :, None]
    qb = math.gcd(L, Q_BLOCK)

    def block(i):
        s = i * qb
        qc = lax.dynamic_slice_in_dim(qg, s, qb, axis=1)
        qr = lax.dynamic_slice_in_dim(qrg, s, qb, axis=1)
        gt = lax.dynamic_slice_in_dim(gg, s, qb, axis=1).astype(jnp.float32)
        t = q_off + s + jnp.arange(qb)
        sc = jnp.einsum('bqgrd,bngd->bqgrn', qc, k_cmp)
        m_c = (cmp_end[None, :] <= t[:, None])[None, :, None, None, :]
        p_c = masked_softmax(sc, m_c)
        o_c = jnp.einsum('bqgrn,bngd->bqgrd', p_c, v_cmp.astype(jnp.float32))
        imp = jnp.einsum('bqgrn,ns->bqgs', p_c, overlap)
        cur = t // SLC_BLOCK
        forced = (blk_idx[None, :] == 0) | (blk_idx[None, :] == cur[:, None]) | (blk_idx[None, :] == cur[:, None] - 1)
        eligible = blk_idx[None, :] * SLC_BLOCK <= t[:, None]
        imp = jnp.where(forced[None, :, None, :], FORCE_SCORE, imp)
        imp = jnp.where(eligible[None, :, None, :], imp, -jnp.inf)
        top_s, top_i = lax.top_k(imp, k_sel)
        sel = slc[b_ix, g_ix, top_i].reshape(bt, qb, N_KV, k_sel * SLC_BLOCK, 2, HEAD_DIM)
        key_pos = (top_i[..., None] * SLC_BLOCK + jnp.arange(SLC_BLOCK)).reshape(bt, qb, N_KV, k_sel * SLC_BLOCK)
        valid = jnp.repeat(jnp.isfinite(top_s), SLC_BLOCK, axis=-1)
        m_s = valid & (key_pos <= t[None, :, None, None])
        ss = jnp.einsum('bqgrd,bqgkd->bqgrk', qr, sel[..., 0, :])
        p_s = masked_softmax(ss, m_s[:, :, :, None, :])
        o_s = jnp.einsum('bqgrk,bqgkd->bqgrd', p_s, sel[..., 1, :].astype(jnp.float32))
        w0 = q_off + s - swa_start
        kw = lax.dynamic_slice_in_dim(swa, w0, WINDOW + qb, axis=1)
        pw = lax.dynamic_slice_in_dim(swa_pos, w0, WINDOW + qb)
        dist = t[:, None] - pw[None, :]
        m_w = ((dist >= 0) & (dist < WINDOW) & (pw[None, :] >= swa_start))[None, :, None, None, :]
        sw = jnp.einsum('bqgrd,bkgd->bqgrk', qr, kw[:, :, 0])
        p_w = masked_softmax(sw, m_w)
        o_w = jnp.einsum('bqgrk,bkgd->bqgrd', p_w, kw[:, :, 1].astype(jnp.float32))
        return o_c * gt[..., 0:1] + o_s * gt[..., 1:2] + o_w * gt[..., 2:3]

    out = lax.map(block, jnp.arange(L // qb))
    return out.transpose(1, 0, 2, 3, 4, 5).reshape(bt, L, Q_WIDTH)


def nsa_layer(x, g_pre, w_qg, w_o, g_post, k_cmp, v_cmp, full_slc, local_swa, q_off, swa_start):
    bt, L, _ = x.shape
    qg = rmsnorm(x, g_pre) @ w_qg
    q = qg[..., :Q_WIDTH].reshape(bt, L, N_HEADS, HEAD_DIM)
    gates = jax.nn.sigmoid(qg[..., Q_WIDTH:].astype(jnp.float32)).reshape(bt, L, N_HEADS, N_BRANCH)
    o = nsa_attention(q, gates, k_cmp, v_cmp, full_slc, local_swa, q_off, swa_start)
    return rmsnorm(o.astype(x.dtype) @ w_o, g_post)


def run_trunk(x, h_re0, h_im0, past_cmp, past_slc, past_swa, pos0, p):
    bt = x.shape[0]
    ssm_re, ssm_im = [], []
    for layer in range(DEPTH):
        if layer < N_A_LAYERS:
            if h_re0 is None:
                h_re = jnp.zeros((bt, N_GROUPS, SSM_STATE), jnp.float32)
                h_im = jnp.zeros((bt, N_GROUPS, SSM_STATE), jnp.float32)
            else:
                h_re, h_im = h_re0[layer], h_im0[layer]
            m, hr, hi = s5_mixer(rmsnorm(x, p['a_norm_pre'][layer]), h_re, h_im,
                                 p['a_lam_re'][layer], p['a_lam_im'][layer], p['a_log_dt'][layer],
                                 p['a_b_re'][layer], p['a_b_im'][layer], p['a_c_re'][layer], p['a_c_im'][layer],
                                 p['a_d'][layer], p['a_w_glu'][layer], p['a_b_glu'][layer])
            x = x + rmsnorm(m, p['a_norm_post'][layer])
            ssm_re.append(hr)
            ssm_im.append(hi)
        else:
            if layer == N_A_LAYERS:
                rows_cmp, rows_slc, full_slc, local_swa, swa_start, k_cmp, v_cmp = shared_kv_stream(
                    x, pos0, past_cmp, past_slc, past_swa, p['kv_norm'], p['w_kv'],
                    p['cmp_w1_k'], p['cmp_pe_k'], p['cmp_w2_k'], p['cmp_w1_v'], p['cmp_pe_v'], p['cmp_w2_v'])
            j = layer - N_A_LAYERS
            x = x + nsa_layer(x, p['b_norm_pre'][j], p['b_w_qg'][j], p['b_w_o'][j], p['b_norm_post'][j],
                              k_cmp, v_cmp, full_slc, local_swa, pos0, swa_start)
        h = sq_relu_mlp(rmsnorm(x, p['mlp_norm_pre'][layer]), p['mlp_w_up'][layer], p['mlp_w_down'][layer])
        x = x + rmsnorm(h, p['mlp_norm_post'][layer])
    w_keep = min(WINDOW, PAST_LEN)
    swa_buf = jnp.pad(local_swa, ((0, 0), (w_keep, 0), (0, 0), (0, 0), (0, 0)))[:, -w_keep:]
    return x, rows_cmp, rows_slc, swa_buf, jnp.stack(ssm_re), jnp.stack(ssm_im)


def setup_inputs(seed: int = 0) -> dict:
    key = jax.random.key(seed)
    ks = iter(jax.random.split(key, 48))

    def nrm(shape, scale):
        return jax.random.normal(next(ks), shape, jnp.float32) * scale

    n_pages = PAST_LEN // PAGE_SIZE
    n_used = DEC_BATCH * n_pages
    n_pool = n_used + n_used // 4
    w_keep = min(WINDOW, PAST_LEN)
    page_table = jax.random.permutation(next(ks), n_pool)[:n_used].reshape(DEC_BATCH, n_pages).astype(jnp.int32)
    lam_n = jnp.pi * jnp.arange(SSM_STATE, dtype=jnp.float32)
    return {
        'x_prompt': nrm((BATCH, SEQ, D_MODEL), 1.0),
        'x_sample': nrm((DEC_BATCH, DEC_SEQ, D_MODEL), 1.0),
        'cache_kv_cmp': nrm((n_pool, PAGE_SIZE, 2, N_KV, HEAD_DIM), 1.0),
        'cache_kv_slc': nrm((n_pool, PAGE_SIZE, 2, N_KV, HEAD_DIM), 1.0),
        'state_kv_swa': nrm((DEC_BATCH, w_keep, 2, N_KV, HEAD_DIM), 1.0),
        'state_ssm_re': nrm((N_A_LAYERS, DEC_BATCH, N_GROUPS, SSM_STATE), 0.1),
        'state_ssm_im': nrm((N_A_LAYERS, DEC_BATCH, N_GROUPS, SSM_STATE), 0.1),
        'page_table': page_table,
        'a_norm_pre': 1.0 + nrm((N_A_LAYERS, D_MODEL), 0.01),
        'a_lam_re': -0.5 + nrm((N_A_LAYERS, N_GROUPS, SSM_STATE), 0.01),
        'a_lam_im': lam_n + nrm((N_A_LAYERS, N_GROUPS, SSM_STATE), 0.01),
        'a_log_dt': jax.random.uniform(next(ks), (N_A_LAYERS, N_GROUPS), jnp.float32, math.log(1e-3), math.log(1e-1)),
        'a_b_re': nrm((N_A_LAYERS, N_GROUPS, SSM_STATE, SSM_GROUP), SSM_GROUP ** -0.5),
        'a_b_im': nrm((N_A_LAYERS, N_GROUPS, SSM_STATE, SSM_GROUP), SSM_GROUP ** -0.5),
        'a_c_re': nrm((N_A_LAYERS, N_GROUPS, SSM_GROUP, SSM_STATE), SSM_STATE ** -0.5),
        'a_c_im': nrm((N_A_LAYERS, N_GROUPS, SSM_GROUP, SSM_STATE), SSM_STATE ** -0.5),
        'a_d': nrm((N_A_LAYERS, D_MODEL), 1.0),
        'a_w_glu': nrm((N_A_LAYERS, D_MODEL, D_MODEL), D_MODEL ** -0.5),
        'a_b_glu': nrm((N_A_LAYERS, D_MODEL), 0.01),
        'a_norm_post': 1.0 + nrm((N_A_LAYERS, D_MODEL), 0.01),
        'kv_norm': 1.0 + nrm((D_MODEL,), 0.01),
        'w_kv': nrm((D_MODEL, KV_WIDTH), D_MODEL ** -0.5),
        'cmp_w1_k': nrm((CMP_BLOCK, HEAD_DIM, CMP_HIDDEN), (CMP_BLOCK * HEAD_DIM) ** -0.5),
        'cmp_pe_k': nrm((CMP_BLOCK, HEAD_DIM), 0.5),
        'cmp_w2_k': nrm((CMP_HIDDEN, HEAD_DIM), CMP_HIDDEN ** -0.5),
        'cmp_w1_v': nrm((CMP_BLOCK, HEAD_DIM, CMP_HIDDEN), (CMP_BLOCK * HEAD_DIM) ** -0.5),
        'cmp_pe_v': nrm((CMP_BLOCK, HEAD_DIM), 0.5),
        'cmp_w2_v': nrm((CMP_HIDDEN, HEAD_DIM), CMP_HIDDEN ** -0.5),
        'b_norm_pre': 1.0 + nrm((N_B_LAYERS, D_MODEL), 0.01),
        'b_w_qg': nrm((N_B_LAYERS, D_MODEL, Q_WIDTH + N_BRANCH * N_HEADS), D_MODEL ** -0.5),
        'b_w_o': nrm((N_B_LAYERS, Q_WIDTH, D_MODEL), Q_WIDTH ** -0.5),
        'b_norm_post': 1.0 + nrm((N_B_LAYERS, D_MODEL), 0.01),
        'mlp_norm_pre': 1.0 + nrm((DEPTH, D_MODEL), 0.01),
        'mlp_w_up': nrm((DEPTH, D_MODEL, D_FF), D_MODEL ** -0.5),
        'mlp_w_down': nrm((DEPTH, D_FF, D_MODEL), D_FF ** -0.5),
        'mlp_norm_post': 1.0 + nrm((DEPTH, D_MODEL), 0.01),
    }


def reference(x_prompt, x_sample, cache_kv_cmp, cache_kv_slc, state_kv_swa, state_ssm_re, state_ssm_im,
              page_table, a_norm_pre, a_lam_re, a_lam_im, a_log_dt, a_b_re, a_b_im, a_c_re, a_c_im, a_d,
              a_w_glu, a_b_glu, a_norm_post, kv_norm, w_kv, cmp_w1_k, cmp_pe_k, cmp_w2_k, cmp_w1_v,
              cmp_pe_v, cmp_w2_v, b_norm_pre, b_w_qg, b_w_o, b_norm_post, mlp_norm_pre, mlp_w_up,
              mlp_w_down, mlp_norm_post):
    params = {
        'a_norm_pre': a_norm_pre, 'a_lam_re': a_lam_re, 'a_lam_im': a_lam_im, 'a_log_dt': a_log_dt,
        'a_b_re': a_b_re, 'a_b_im': a_b_im, 'a_c_re': a_c_re, 'a_c_im': a_c_im, 'a_d': a_d,
        'a_w_glu': a_w_glu, 'a_b_glu': a_b_glu, 'a_norm_post': a_norm_post,
        'kv_norm': kv_norm, 'w_kv': w_kv,
        'cmp_w1_k': cmp_w1_k, 'cmp_pe_k': cmp_pe_k, 'cmp_w2_k': cmp_w2_k,
        'cmp_w1_v': cmp_w1_v, 'cmp_pe_v': cmp_pe_v, 'cmp_w2_v': cmp_w2_v,
        'b_norm_pre': b_norm_pre, 'b_w_qg': b_w_qg, 'b_w_o': b_w_o, 'b_norm_post': b_norm_post,
        'mlp_norm_pre': mlp_norm_pre, 'mlp_w_up': mlp_w_up, 'mlp_w_down': mlp_w_down,
        'mlp_norm_post': mlp_norm_post,
    }
    y_prompt, cmp_p, slc_p, swa_p, re_p, im_p = run_trunk(x_prompt, None, None, None, None, None, 0, params)
    n_pages = page_table.shape[1]
    past_cmp = cache_kv_cmp[page_table].reshape(page_table.shape[0], n_pages * PAGE_SIZE, 2, N_KV, HEAD_DIM)
    past_slc = cache_kv_slc[page_table].reshape(page_table.shape[0], n_pages * PAGE_SIZE, 2, N_KV, HEAD_DIM)
    y_sample, cmp_s, slc_s, swa_s, re_s, im_s = run_trunk(
        x_sample, state_ssm_re, state_ssm_im, past_cmp, past_slc, state_kv_swa, PAST_LEN, params)
    return (y_prompt, y_sample, cmp_p, cmp_s, slc_p, slc_s, swa_p, swa_s, re_p, im_p, re_s, im_s)
```

```cpp
#include <hip/hip_runtime.h>
#include <cstdio>
#include <cmath>

#define LAS __attribute__((address_space(3)))
#define GAS __attribute__((address_space(1)))
typedef _Float16 f16;
typedef f16 f16x8 __attribute__((ext_vector_type(8)));
typedef f16 f16x4 __attribute__((ext_vector_type(4)));
typedef f16 f16x2 __attribute__((ext_vector_type(2)));
typedef float f32x2 __attribute__((ext_vector_type(2)));
typedef float f32x4 __attribute__((ext_vector_type(4)));
typedef float f32x16 __attribute__((ext_vector_type(16)));
typedef unsigned u32x4 __attribute__((ext_vector_type(4)));
typedef unsigned u32x2 __attribute__((ext_vector_type(2)));
#define LDS_WAIT() asm volatile("s_waitcnt lgkmcnt(0)" ::: "memory")
#define VM_WAIT() asm volatile("s_waitcnt vmcnt(0)" ::: "memory")

constexpr int DM = 2048, FF = 8192, SEQ = 4096, NBP = 2, MP = NBP * SEQ;
constexpr int NBS = 8, LS = 4, MS = NBS * LS;
constexpr int PAST = 16384, NPAGES = 128, PAGE = 128;
constexpr int NG = 128, NST = 64;
constexpr int NQG = 2096, NQGP = 2304, NKV = 3072;
constexpr float EPS = 1e-6f;
constexpr float QSCALE = 0.08838834764831845f;
constexpr float LOG2E = 1.4426950408889634f;

constexpr size_t O_YP = 0, O_YS = O_YP + (size_t)MP * DM, O_CMPP = O_YS + (size_t)MS * DM, O_CMPS = O_CMPP + (size_t)MP * 1024,
                 O_SLCP = O_CMPS + (size_t)MS * 1024, O_SLCS = O_SLCP + (size_t)MP * 1024, O_SWAP = O_SLCS + (size_t)MS * 1024,
                 O_SWAS = O_SWAP + (size_t)NBP * 512 * 1024, O_REP = O_SWAS + (size_t)NBS * 512 * 1024, O_IMP = O_REP + 2 * NBP * NG * NST,
                 O_RES = O_IMP + 2 * NBP * NG * NST, O_IMS = O_RES + 2 * NBS * NG * NST, O_END = O_IMS + 2 * NBS * NG * NST;

constexpr size_t al256(size_t x) { return (x + 255) & ~(size_t)255; }
constexpr size_t WS_CTL = 0, CTL_BYTES = 1u << 20;
constexpr size_t WS_WGLU = WS_CTL + CTL_BYTES;
constexpr size_t WS_WUP = WS_WGLU + (size_t)2 * DM * DM * 2;
constexpr size_t WS_WDN = WS_WUP + (size_t)4 * FF * DM * 2;
constexpr size_t WS_WKVQG = WS_WDN + (size_t)4 * FF * DM * 2;
constexpr size_t WS_WQG1 = WS_WKVQG + (size_t)(NKV + NQGP) * DM * 2;
constexpr size_t WS_WO = WS_WQG1 + (size_t)NQGP * DM * 2;
constexpr size_t WS_CW1 = WS_WO + (size_t)2 * DM * DM * 2;
constexpr size_t WS_CW2 = WS_CW1 + (size_t)2 * 512 * 2048 * 2;
constexpr size_t WS_BST = WS_CW2 + (size_t)2 * 128 * 256 * 2;
constexpr size_t WS_CCT = WS_BST + (size_t)2 * NG * 128 * 16 * 2;
constexpr size_t WS_AT = WS_CCT + (size_t)2 * NG * 16 * 128 * 2;
constexpr size_t WS_BBF = WS_AT + (size_t)2 * NG * NST * 2 * 4;
constexpr size_t WS_DT = WS_BBF + (size_t)2 * NG * NST * 32 * 4;
constexpr size_t WS_ROPE = WS_DT + 1024;
constexpr size_t WS_PE = al256(WS_ROPE + (size_t)4100 * 32 * 4);
constexpr size_t WS_X = WS_PE + 2048;
constexpr size_t WS_Y = WS_X + (size_t)MP * DM * 4;
constexpr size_t WS_A0 = WS_Y + (size_t)MP * DM * 4;
constexpr size_t WS_A1 = WS_A0 + (size_t)MP * DM * 2;
constexpr size_t WS_H = WS_A1 + (size_t)MP * DM * 2;
constexpr size_t WS_QN = WS_H + (size_t)MP * FF * 2;
constexpr size_t WS_QR = WS_QN + (size_t)MP * DM * 2;
constexpr size_t WS_GATES = WS_QR + (size_t)MP * DM * 2;
constexpr size_t WS_RC = WS_GATES + (size_t)MP * 48 * 4;
constexpr size_t RC_P_ELEMS = (size_t)2 * 2 * 4 * 4096 * 128, RC_S_ELEMS = (size_t)2 * 8 * 4 * 16384 * 128;
constexpr size_t WS_KS = WS_RC + (RC_P_ELEMS + RC_S_ELEMS) * 2;
constexpr size_t KVB = (size_t)2 * 4 * 4096 * 128 * 2;
constexpr size_t WS_VST = WS_KS + KVB, WS_KW = WS_VST + KVB, WS_VWT = WS_KW + KVB;
constexpr size_t WS_PROJ = WS_VWT + KVB;
constexpr size_t WS_KC = WS_PROJ + (size_t)(4096 + 65536) * 512 * 4;
constexpr size_t WS_VCT = WS_KC + (size_t)8 * 256 * 128 * 2;
constexpr size_t WS_KCS = WS_VCT + (size_t)8 * 256 * 128 * 2;
constexpr size_t WS_VCS = WS_KCS + (size_t)32 * 1024 * 128 * 2;
constexpr size_t WS_XS = WS_VCS + (size_t)32 * 1024 * 128 * 2;
constexpr size_t WS_YS = WS_XS + (size_t)MS * DM * 4;
constexpr size_t WS_XNS = WS_YS + (size_t)MS * DM * 4;
constexpr size_t WS_AS0 = WS_XNS + (size_t)MS * DM * 4;
constexpr size_t WS_AS1 = WS_AS0 + (size_t)MS * DM * 2;
constexpr size_t WS_HS = WS_AS1 + (size_t)MS * DM * 2;
constexpr size_t WS_QNS = WS_HS + (size_t)MS * FF * 2;
constexpr size_t WS_QRS = WS_QNS + (size_t)MS * DM * 4;
constexpr size_t WS_GATESS = WS_QRS + (size_t)MS * DM * 4;
constexpr size_t WS_END = al256(WS_GATESS + (size_t)MS * 48 * 4);
constexpr int CW_BAR = 4096;

constexpr int LDS_BYTES = 155648;
constexpr int LDS_XB = 155632;

struct Params {
    const float* in[36];
    float* out;
    unsigned char* ws;
    float inv_freq[16];
    int ph_lo, ph_hi;
};

__device__ __forceinline__ float wave_sum(float v) {
#pragma unroll
    for (int o = 1; o < 64; o <<= 1) v += __shfl_xor(v, o);
    return v;
}
__device__ __forceinline__ float wave_max(float v) {
#pragma unroll
    for (int o = 1; o < 64; o <<= 1) v = fmaxf(v, __shfl_xor(v, o));
    return v;
}
__device__ __forceinline__ float sigmoidf_(float x) { return __builtin_amdgcn_rcpf(1.0f + __expf(-x)); }
__device__ __forceinline__ float gelu_tanh(float y) { const float z = 0.7978845608028654f * (y + 0.044715f * y * y * y); return y * __builtin_amdgcn_rcpf(1.0f + __expf(-2.0f * z)); }

__device__ __forceinline__ f16x4 cvt4(const f32x4 v) { f16x4 r; r[0] = (f16)v[0]; r[1] = (f16)v[1]; r[2] = (f16)v[2]; r[3] = (f16)v[3]; return r; }
#define XB_TMO      128
#define XB_XCNT(j)  (256  + 64 * (j))
#define XB_XSUB(j)  (1280 + 64 * (j))
#define XB_XGEN(j)  (2304 + 64 * (j))
#define XB_TOP      3328
#define XB_TOPGEN   3392
#define XCD_BAR_WORDS 3456
#define XB_SPIN_CAP (1u << 22)
__device__ __forceinline__ unsigned xb_ld(unsigned* p)              { return __hip_atomic_load(p, __ATOMIC_RELAXED, __HIP_MEMORY_SCOPE_AGENT); }
__device__ __forceinline__ unsigned xb_add(unsigned* p, unsigned v) { return __hip_atomic_fetch_add(p, v, __ATOMIC_RELAXED, __HIP_MEMORY_SCOPE_AGENT); }
__device__ __forceinline__ unsigned xb_xcc_id() { return (unsigned)__builtin_amdgcn_s_getreg((3 << 11) | 20) & 0xFu; }
#define XB_SPIN(cond, bar) do { unsigned _sp = 0; while (cond) { __builtin_amdgcn_s_sleep(1); \
    if ((++_sp & 255u) == 0u) { if (xb_ld(&(bar)[XB_TMO])) break; if (_sp > XB_SPIN_CAP) { atomicAdd(&(bar)[XB_TMO], 1u); break; } } } } while (0)
struct XcdBarrier { unsigned* bar; unsigned x; volatile LAS unsigned* st; };
__device__ __forceinline__ XcdBarrier xcd_barrier_post(unsigned* bar, volatile LAS unsigned* st) {
    XcdBarrier b; b.bar = bar; b.x = xb_xcc_id(); b.st = st;
    if (threadIdx.x == 0) (void)xb_add(&bar[XB_XCNT(b.x)], 1u);
    return b;
}
__device__ __forceinline__ void xcd_barrier_complete(unsigned* bar, unsigned x, unsigned& nloc, unsigned& nx) {
    const unsigned G = gridDim.x * gridDim.y * gridDim.z;
    unsigned sum, cnt, mine, sp = 0u;
    for (;;) {
        sum = 0u; cnt = 0u; mine = 0u;
#pragma unroll
        for (unsigned j = 0; j < 16; ++j) { const unsigned c = xb_ld(&bar[XB_XCNT(j)]); sum += c; cnt += (c > 0u) ? 1u : 0u; mine = (j == x) ? c : mine; }
        if (sum == G) break;
        __builtin_amdgcn_s_sleep(1);
        if ((++sp & 255u) == 0u) { if (xb_ld(&bar[XB_TMO])) break; if (sp > XB_SPIN_CAP) { atomicAdd(&bar[XB_TMO], 1u); break; } }
    }
    nloc = mine > 0u ? mine : 1u; nx = cnt > 0u ? cnt : 1u;
}
__device__ __forceinline__ void xcd_barrier(const XcdBarrier& b) {
    asm volatile("s_waitcnt vmcnt(0)" ::: "memory");
    __syncthreads();
    if (threadIdx.x == 0) {
        unsigned* bar = b.bar;
        __builtin_amdgcn_s_waitcnt(0);
        unsigned nloc = b.st[0], nx = b.st[1];
        if (nloc == 0u) { xcd_barrier_complete(bar, b.x, nloc, nx); b.st[0] = nloc; b.st[1] = nx; }
        const unsigned old = xb_add(&bar[XB_XSUB(b.x)], 1u);
        const unsigned gen = old / nloc;
        if (old + 1u == (gen + 1u) * nloc) {
            __builtin_amdgcn_fence(__ATOMIC_RELEASE, "agent");
            asm volatile("s_waitcnt vmcnt(0)" ::: "memory");
            const unsigned og = xb_add(&bar[XB_TOP], 1u);
            const unsigned tg = og / nx;
            if (og + 1u == (tg + 1u) * nx) xb_add(&bar[XB_TOPGEN], 1u);
            else XB_SPIN(xb_ld(&bar[XB_TOPGEN]) == tg, bar);
            __builtin_amdgcn_fence(__ATOMIC_ACQUIRE, "agent");
            xb_add(&bar[XB_XGEN(b.x)], 1u);
            asm volatile("s_waitcnt vmcnt(0)" ::: "memory");
        } else {
            XB_SPIN(xb_ld(&bar[XB_XGEN(b.x)]) == gen, bar);
            __builtin_amdgcn_fence(__ATOMIC_ACQUIRE, "agent");
            asm volatile("s_waitcnt vmcnt(0)" ::: "memory");
        }
    }
    __syncthreads();
}
namespace pg8 {
#define PG8_LAS __attribute__((address_space(3)))
typedef f16 bf16_t;
typedef f16x8 bf16x8;
constexpr int BM = 256, BK = 64, HALF = 128, HTB = HALF * BK * 2  , STAGE_BYTES = 8 * HTB, NXCD = 8, WGM = 8;

__host__ __device__ __forceinline__ int lds_byte(int r, int c) { const int st = (r >> 4) * 2 + (c >> 5), rr = r & 15, cc = c & 31, ob = rr * 64 + cc * 2; return st * 1024 + (ob ^ (((ob >> 9) & 1) << 5)); }
__host__ __device__ __forceinline__ void stage_rc(int b, int& R, int& C) { const int st = b / 1024, sb = b % 1024, swz = sb ^ (((sb >> 9) & 1) << 5); R = (st >> 1) * 16 + swz / 64; C = (st & 1) * 32 + (swz % 64) / 2; }
__host__ __device__ __forceinline__ int perm32(int rho) { const int n = rho >> 4, i = rho & 15; return 8 * (i >> 2) + 4 * n + (i & 3); }

struct Unit { int pm, pn; };
struct Gemm { const bf16_t* A; const bf16_t* Bt; int M, N, K; };

struct StaticOrder {
    int nM, nN, nwg, G, c;
    __host__ __device__ void init(int M, int N, int G_, int c_) { nM = M / BM; nN = N / BM; nwg = nM * nN; G = G_; c = c_; }
    __host__ __device__ bool next(int i, Unit& u) const {
        const long L = (long)i * G + c; if (L >= nwg) return false;
        int wgid = (int)L; { const int q = nwg / NXCD, r = nwg % NXCD, xcd = wgid % NXCD, off = wgid / NXCD; wgid = (xcd < r ? xcd * (q + 1) : r * (q + 1) + (xcd - r) * q) + off; }
        const int nig = WGM * nN, gid = wgid / nig, fm = gid * WGM, gsz = (nM - fm) < WGM ? (nM - fm) : WGM;
        u.pm = fm + ((wgid % nig) % gsz); u.pn = (wgid % nig) / gsz; return true;
    }
    __device__ __forceinline__ void a_ready(const Unit&) const {}
    __device__ __forceinline__ void done(const Unit&) const {}
};

struct EpiF32 {
    static constexpr bool PERM = false, AFTER_DRAIN = false;
    float* C; int ldc; int pn_mask;
    __device__ __forceinline__ void operator()(const f32x4 (&acc)[2][2][4][2], const Unit& u, int wr, int wc, int fr, int fq) const {
        const int row0 = u.pm * BM + wr * 64 + fr, col0 = (u.pn & pn_mask) * BM + wc * 32 + 4 * fq;
#pragma unroll
        for (int ai = 0; ai < 2; ++ai)
#pragma unroll
            for (int m = 0; m < 4; ++m) { float* rowp = C + (size_t)(row0 + ai * HALF + m * 16) * ldc + col0;
#pragma unroll
                for (int bj = 0; bj < 2; ++bj)
#pragma unroll
                    for (int n = 0; n < 2; ++n) *(f32x4*)(rowp + bj * HALF + n * 16) = acc[ai][bj][m][n]; }
    }
};
struct EpiGLU {
    static constexpr bool PERM = false, AFTER_DRAIN = false;
    float* C; const f16* Y; const float* bias;
    __device__ __forceinline__ void operator()(const f32x4 (&acc)[2][2][4][2], const Unit& u, int wr, int wc, int fr, int fq) const {
        const int row0 = u.pm * BM + wr * 64 + fr, col0 = u.pn * BM + wc * 32 + 4 * fq;
        f32x4 bv[2][2];
#pragma unroll
        for (int bj = 0; bj < 2; ++bj)
#pragma unroll
            for (int n = 0; n < 2; ++n) bv[bj][n] = *(const f32x4*)(bias + col0 + bj * HALF + n * 16);
#pragma unroll
        for (int ai = 0; ai < 2; ++ai)
#pragma unroll
            for (int m = 0; m < 4; ++m) { const size_t off = (size_t)(row0 + ai * HALF + m * 16) * DM + col0;
#pragma unroll
                for (int bj = 0; bj < 2; ++bj)
#pragma unroll
                    for (int n = 0; n < 2; ++n) { const f16x4 y = *(const f16x4*)(Y + off + bj * HALF + n * 16); const f32x4 v = acc[ai][bj][m][n] + bv[bj][n]; f32x4 o;
#pragma unroll
                        for (int i = 0; i < 4; ++i) o[i] = (float)y[i] * sigmoidf_(v[i]);
                        *(f32x4*)(C + off + bj * HALF + n * 16) = o; } }
    }
};
struct EpiRelu2 {
    static constexpr bool PERM = true, AFTER_DRAIN = false;
    f16* O; int ldc;
    __device__ __forceinline__ void operator()(const f32x4 (&acc)[2][2][4][2], const Unit& u, int wr, int wc, int fr, int fq) const {
        const int row0 = u.pm * BM + wr * 64 + fr, col0 = u.pn * BM + wc * 32 + 8 * fq;
#pragma unroll
        for (int ai = 0; ai < 2; ++ai)
#pragma unroll
            for (int m = 0; m < 4; ++m) { f16* rowp = O + (size_t)(row0 + ai * HALF + m * 16) * ldc + col0;
#pragma unroll
                for (int bj = 0; bj < 2; ++bj) { const f32x4 v0 = acc[ai][bj][m][0], v1 = acc[ai][bj][m][1]; f16x8 w;
#pragma unroll
                    for (int i = 0; i < 4; ++i) { const float a = fmaxf(v0[i], 0.f), b = fmaxf(v1[i], 0.f); w[i] = (f16)(a * a); w[4 + i] = (f16)(b * b); }
                    *(f16x8*)(rowp + bj * HALF) = w; } }
    }
};
struct EpiProj {
    static constexpr bool PERM = false, AFTER_DRAIN = false;
    int nkv; float* out; f16 *RC, *KS, *VST, *KW, *VWT, *QN, *QR; float* GATES; const float* rope;
    __device__ __forceinline__ void operator()(const f32x4 (&acc)[2][2][4][2], const Unit& u, int wr, int wc, int fr, int fq) const {
        const int row0 = u.pm * BM + wr * 64 + fr, d0 = wc * 32 + 4 * fq, d1 = d0 + 16;
#pragma unroll
        for (int bj = 0; bj < 2; ++bj) {
            if (u.pn < nkv) {
                const int hh = 2 * u.pn + bj, br = hh >> 3, kv = (hh >> 2) & 1, g = hh & 3, cbase = kv * 512 + g * 128;
                const bool rot = (br >= 1) && (kv == 0) && (wc == 0);
#pragma unroll
                for (int ai = 0; ai < 2; ++ai)
#pragma unroll
                    for (int m = 0; m < 4; ++m) {
                        const int row = row0 + ai * HALF + m * 16, b = row >> 12, t = row & 4095;
                        f32x4 v0 = acc[ai][bj][m][0], v1 = acc[ai][bj][m][1];
                        if (rot) { const f32x4 cs = *(const f32x4*)(rope + (size_t)t * 32 + 4 * fq), sn = *(const f32x4*)(rope + (size_t)t * 32 + 16 + 4 * fq);
                            const f32x4 n0 = v0 * cs - v1 * sn, n1 = v1 * cs + v0 * sn; v0 = n0; v1 = n1; }
                        const f16x4 h0 = cvt4(v0), h1 = cvt4(v1);
                        if (br == 0) {
                            float* o = out + O_CMPP + (size_t)row * 1024 + cbase; *(f32x4*)(o + d0) = v0; *(f32x4*)(o + d1) = v1;
                            f16* r = RC + ((size_t)(((kv * 2 + b) * 4 + g) * 4096 + t)) * 128; *(f16x4*)(r + d0) = h0; *(f16x4*)(r + d1) = h1;
                        } else {
                            if (br == 1) { float* o = out + O_SLCP + (size_t)row * 1024 + cbase; *(f32x4*)(o + d0) = v0; *(f32x4*)(o + d1) = v1; }
                            else if (t >= SEQ - 512) { float* o = out + O_SWAP + ((size_t)(b * 512 + t - (SEQ - 512))) * 1024 + cbase; *(f32x4*)(o + d0) = v0; *(f32x4*)(o + d1) = v1; }
                            if (kv == 0) { f16* r = (br == 1 ? KS : KW) + ((size_t)((b * 4 + g) * 4096 + t)) * 128; *(f16x4*)(r + d0) = h0; *(f16x4*)(r + d1) = h1; }
                            else { f16* r = (br == 1 ? VST : VWT) + ((size_t)(b * 4 + g) * 128) * 4096 + t;
#pragma unroll
                                for (int i = 0; i < 4; ++i) { r[(size_t)(d0 + i) * 4096] = h0[i]; r[(size_t)(d1 + i) * 4096] = h1[i]; } }
                        }
                    }
            } else {
                const int c0 = (u.pn - nkv) * 256 + bj * 128;
                if (c0 < 2048) {
#pragma unroll
                    for (int ai = 0; ai < 2; ++ai)
#pragma unroll
                        for (int m = 0; m < 4; ++m) {
                            const int row = row0 + ai * HALF + m * 16, t = row & 4095;
                            f32x4 v0 = acc[ai][bj][m][0] * QSCALE, v1 = acc[ai][bj][m][1] * QSCALE;
                            f16* qn = QN + (size_t)row * DM + c0; *(f16x4*)(qn + d0) = cvt4(v0); *(f16x4*)(qn + d1) = cvt4(v1);
                            if (wc == 0) { const f32x4 cs = *(const f32x4*)(rope + (size_t)t * 32 + 4 * fq), sn = *(const f32x4*)(rope + (size_t)t * 32 + 16 + 4 * fq);
                                const f32x4 n0 = v0 * cs - v1 * sn, n1 = v1 * cs + v0 * sn; v0 = n0; v1 = n1; }
                            f16* qr = QR + (size_t)row * DM + c0; *(f16x4*)(qr + d0) = cvt4(v0); *(f16x4*)(qr + d1) = cvt4(v1);
                        }
                } else if (c0 == 2048) {
#pragma unroll
                    for (int ai = 0; ai < 2; ++ai)
#pragma unroll
                        for (int m = 0; m < 4; ++m) {
                            const int row = row0 + ai * HALF + m * 16;
#pragma unroll
                            for (int n = 0; n < 2; ++n) { const int lc = wc * 32 + 16 * n + 4 * fq;
                                if (lc < 48) { const f32x4 v = acc[ai][bj][m][n]; f32x4 o;
#pragma unroll
                                    for (int i = 0; i < 4; ++i) o[i] = sigmoidf_(v[i]);
                                    *(f32x4*)(GATES + (size_t)row * 48 + lc) = o; } }
                        }
                }
            }
        }
    }
};
struct CmpOrder {
    int G, c;
    __device__ __forceinline__ bool next(int i, Unit& u) const {
        const int idx = i * G + c; if (idx >= 544) return false;
        const int pm = idx >> 1, kv = pm < 16 ? (pm >> 3) : ((pm - 16) >> 7);
        u.pm = pm; u.pn = (idx & 1) + 2 * kv; return true;
    }
    __device__ __forceinline__ void a_ready(const Unit&) const {}
    __device__ __forceinline__ void done(const Unit&) const {}
};

template <class Epi, class Sched, bool STAMP = false>
__device__ __forceinline__ void gemm_phase(PG8_LAS unsigned char* lds, const Gemm g, const Sched& S, const Epi& E, unsigned long long* stamps) {
    const int tid = threadIdx.x, wid = __builtin_amdgcn_readfirstlane(tid >> 6), lane = tid & 63, wr = wid >> 2, wc = wid & 3, fr = lane & 15, fq = lane >> 4;
    const int K = g.K, nt = K / BK;
    int ts_lo = 0, ts_hi = 0, nts = 0; const unsigned long long rt_entry = STAMP ? (unsigned long long)wall_clock64() : 0ull;
#define PG8_STAMP() do { if (STAMP && wid == 0 && nts < 64) { const unsigned long long _c = (unsigned long long)clock64(); \
        ts_lo = (lane == nts) ? (int)(unsigned)_c : ts_lo; ts_hi = (lane == nts) ? (int)(unsigned)(_c >> 32) : ts_hi; ++nts; } } while (0)
    PG8_STAMP();
    unsigned voffA[2], voffB[2];
#pragma unroll
    for (int i = 0; i < 2; ++i) { int R, C; stage_rc(tid * 16 + i * 8192, R, C); const int Rb = Epi::PERM ? ((R & ~31) + perm32(R & 31)) : R;
        voffA[i] = (unsigned)(R * K + C) * 2u; voffB[i] = (unsigned)(Rb * K + C) * 2u; }
    const size_t kstep = (size_t)(BK * 2);
    const size_t hstep = (size_t)HALF * K * 2;
    const size_t tstep = 2 * hstep;
    const unsigned ldsw = (unsigned)wid * 1024u;
    const int aoff = lds_byte(wr * 64 + fr, fq * 8), boff = lds_byte(wc * 32 + fr, fq * 8);
#define PG8_SA(b, h) (((b) * 2 + (h)) * HTB)
#define PG8_SB(b, h) ((4 + (b) * 2 + (h)) * HTB)
#define PG8_STAGE(bufoff, gbase, voff) do { _Pragma("unroll") for (int _i = 0; _i < 2; ++_i) \
        __builtin_amdgcn_global_load_lds((const unsigned*)((const char*)(gbase) + (voff)[_i]), (PG8_LAS unsigned*)(lds + (bufoff) + ldsw + _i * 8192), 16, 0, 0); } while (0)
#define PG8_LDA(dst, b, h) do { _Pragma("unroll") for (int m = 0; m < 4; ++m) _Pragma("unroll") for (int k = 0; k < 2; ++k) dst[m][k] = *(const PG8_LAS bf16x8*)(lds + PG8_SA(b, h) + aoff + m * 2048 + k * 1024); } while (0)
#define PG8_LDB(dst, b, h) do { _Pragma("unroll") for (int n = 0; n < 2; ++n) _Pragma("unroll") for (int k = 0; k < 2; ++k) dst[n][k] = *(const PG8_LAS bf16x8*)(lds + PG8_SB(b, h) + boff + n * 2048 + k * 1024); } while (0)
#define PG8_MMA(ai, bj, At, Bt) do { __builtin_amdgcn_s_setprio(1); _Pragma("unroll") for (int m = 0; m < 4; ++m) _Pragma("unroll") for (int n = 0; n < 2; ++n) _Pragma("unroll") for (int k = 0; k < 2; ++k) \
        acc[ai][bj][m][n] = __builtin_amdgcn_mfma_f32_16x16x32_f16(Bt[n][k], At[m][k], acc[ai][bj][m][n], 0, 0, 0); __builtin_amdgcn_s_setprio(0); } while (0)
#define PG8_WAIT_V(n) asm volatile("s_waitcnt vmcnt(" #n ")" ::: "memory")
#define PG8_WAIT_L(n) asm volatile("s_waitcnt lgkmcnt(" #n ")" ::: "memory")
#define PG8_BAR __builtin_amdgcn_s_barrier()
#define PG8_SCHED __builtin_amdgcn_sched_barrier(0)
    Unit cur, nxt; int ui = 0;
    if (!S.next(0, cur)) return;
    f32x4 acc[2][2][4][2];
#pragma unroll
    for (int a = 0; a < 2; ++a)
#pragma unroll
        for (int b = 0; b < 2; ++b)
#pragma unroll
            for (int m = 0; m < 4; ++m)
#pragma unroll
                for (int n = 0; n < 2; ++n) acc[a][b][m][n] = (f32x4){0.f, 0.f, 0.f, 0.f};
    bf16x8 At[4][2], B0[2][2], B1[2][2];
    const char* cA = (const char*)g.A + (size_t)cur.pm * tstep; const char* cB = (const char*)g.Bt + (size_t)cur.pn * tstep;
    S.a_ready(cur);
    PG8_STAGE(PG8_SB(0, 0), cB, voffB); PG8_STAGE(PG8_SA(0, 0), cA, voffA); PG8_STAGE(PG8_SB(0, 1), cB + hstep, voffB); PG8_STAGE(PG8_SA(0, 1), cA + hstep, voffA);
    if (wr == 1) PG8_BAR;
    PG8_WAIT_V(4); PG8_BAR;
    PG8_STAGE(PG8_SB(1, 0), cB + kstep, voffB); PG8_STAGE(PG8_SA(1, 0), cA + kstep, voffA); PG8_STAGE(PG8_SB(1, 1), cB + hstep + kstep, voffB);
    PG8_WAIT_V(6); PG8_BAR;
    PG8_STAMP();
    for (;;) {
        const bool has_next = S.next(ui + 1, nxt);
        const char* nA = has_next ? (const char*)g.A + (size_t)nxt.pm * tstep : cA; const char* nB = has_next ? (const char*)g.Bt + (size_t)nxt.pn * tstep : cB;
        for (int t = 0; t < nt; t += 2) {
            const bool last = (t == nt - 2);
            const char* a1 = cA + (size_t)(t + 1) * kstep;
            const char* a2 = last ? nA : cA + (size_t)(t + 2) * kstep; const char* b2 = last ? nB : cB + (size_t)(t + 2) * kstep;
            const char* a3 = a2 + kstep; const char* b3 = b2 + kstep;
            if (last && has_next) S.a_ready(nxt);
            PG8_LDB(B0, 0, 0); PG8_SCHED; PG8_LDA(At, 0, 0); PG8_STAGE(PG8_SA(1, 1), a1 + hstep, voffA);
            PG8_WAIT_L(8); PG8_BAR; PG8_WAIT_L(0); PG8_MMA(0, 0, At, B0); PG8_BAR; PG8_SCHED;
            PG8_LDB(B1, 0, 1); PG8_STAGE(PG8_SB(0, 0), b2, voffB);
            PG8_BAR; PG8_WAIT_L(0); PG8_MMA(0, 1, At, B1); PG8_BAR;
            PG8_LDA(At, 0, 1); PG8_STAGE(PG8_SA(0, 0), a2, voffA);
            PG8_BAR; PG8_WAIT_L(0); PG8_MMA(1, 0, At, B0); PG8_BAR; PG8_SCHED;
            PG8_STAGE(PG8_SB(0, 1), b2 + hstep, voffB);
            PG8_WAIT_V(6); PG8_BAR; PG8_MMA(1, 1, At, B1); PG8_BAR;
            PG8_LDB(B0, 1, 0); PG8_SCHED; PG8_LDA(At, 1, 0); PG8_STAGE(PG8_SA(0, 1), a2 + hstep, voffA);
            PG8_WAIT_L(8); PG8_BAR; PG8_WAIT_L(0); PG8_MMA(0, 0, At, B0); PG8_BAR; PG8_SCHED;
            PG8_LDB(B1, 1, 1); PG8_STAGE(PG8_SB(1, 0), b3, voffB);
            PG8_BAR; PG8_WAIT_L(0); PG8_MMA(0, 1, At, B1); PG8_BAR;
            PG8_LDA(At, 1, 1); PG8_STAGE(PG8_SA(1, 0), a3, voffA);
            PG8_BAR; PG8_WAIT_L(0); PG8_MMA(1, 0, At, B0); PG8_BAR; PG8_SCHED;
            PG8_STAGE(PG8_SB(1, 1), b3 + hstep, voffB);
            PG8_WAIT_V(6); PG8_BAR; PG8_MMA(1, 1, At, B1); PG8_BAR;
        }
        PG8_STAMP();
        if constexpr (!Epi::AFTER_DRAIN) { E(acc, cur, wr, wc, fr, fq); S.done(cur); }
        PG8_STAMP();
        if (!has_next) break;
#pragma unroll
        for (int a = 0; a < 2; ++a)
#pragma unroll
            for (int b = 0; b < 2; ++b)
#pragma unroll
                for (int m = 0; m < 4; ++m)
#pragma unroll
                    for (int n = 0; n < 2; ++n) acc[a][b][m][n] = (f32x4){0.f, 0.f, 0.f, 0.f};
        cur = nxt; cA = nA; cB = nB; ++ui;
    }
    PG8_WAIT_V(0);
    if (wr == 0) PG8_BAR;
    PG8_BAR;
    if constexpr (Epi::AFTER_DRAIN) { E.fused(acc, cur, wr, wc, fr, fq, lds, wid, lane); S.done(cur); }
    PG8_STAMP();
    if (STAMP && wid == 0) { stamps[lane] = lane < nts ? (((unsigned long long)(unsigned)ts_hi << 32) | (unsigned)ts_lo) : 0ull;
        if (lane == 62) stamps[62] = rt_entry; if (lane == 63) stamps[63] = (unsigned long long)wall_clock64(); }
#undef PG8_STAMP
#undef PG8_SA
#undef PG8_SB
#undef PG8_STAGE
#undef PG8_LDA
#undef PG8_LDB
#undef PG8_MMA
#undef PG8_WAIT_V
#undef PG8_WAIT_L
#undef PG8_BAR
#undef PG8_SCHED
}
}
__device__ __forceinline__ void transpose_item(const float* W, int K, int N, int Npad, f16* WT, int row_off, const float* gain, LAS float* scr, int item, int lane) {
    const int nblk = Npad / 32, kb = item / nblk, nb = item % nblk, k0 = 64 * kb, n0 = 32 * nb;
    const int n = n0 + (lane & 31);
#pragma unroll 8
    for (int i = 0; i < 32; ++i) { const int kk = 2 * i + (lane >> 5); float v = (n < N) ? W[(size_t)(k0 + kk) * N + n] : 0.f; if (gain) v *= gain[k0 + kk]; scr[kk * 33 + (lane & 31)] = v; }
    LDS_WAIT();
    const int c = lane & 7;
#pragma unroll
    for (int j = 0; j < 4; ++j) { const int nn = (lane >> 3) + 8 * j; const LAS float* s = scr + (8 * c) * 33 + nn; f16x8 o;
#pragma unroll
        for (int e = 0; e < 8; ++e) o[e] = (f16)s[e * 33];
        *(f16x8*)(WT + (size_t)(row_off + n0 + nn) * K + k0 + 8 * c) = o; }
    LDS_WAIT();
}
__device__ __forceinline__ void sincos_d(double x, double& s, double& c) {
    const double twopi = 6.283185307179586476925287, inv = 0.15915494309189533576888;
    const double k = rint(x * inv); double r = fma(-k, twopi, x); r = fma(-k, -2.4492935982947064e-16, r);
    const double r2 = r * r; double ts = 1.0, tc = 1.0;
#pragma unroll
    for (int i = 27; i >= 3; i -= 2) ts = 1.0 - ts * r2 / (double)(i * (i - 1));
#pragma unroll
    for (int i = 26; i >= 2; i -= 2) tc = 1.0 - tc * r2 / (double)(i * (i - 1));
    s = r * ts; c = tc;
}
__device__ __forceinline__ void resnorm_row(const float* y, const float* gpost, const float* xin, float* xout, int mode, const float* gnext, f16* o16, float* o32, int row, int lane) {
    f32x4 v[8];
    const f32x4* xr = (const f32x4*)(xin + (size_t)row * DM) + lane;
#pragma unroll
    for (int j = 0; j < 8; ++j) v[j] = xr[64 * j];
    if (y) {
        const f32x4* yr = (const f32x4*)(y + (size_t)row * DM) + lane; f32x4 w[8]; float s = 0.f;
#pragma unroll
        for (int j = 0; j < 8; ++j) { w[j] = yr[64 * j]; s += (w[j][0] * w[j][0] + w[j][1] * w[j][1]) + (w[j][2] * w[j][2] + w[j][3] * w[j][3]); }
        const float r1 = 1.0f / sqrtf(wave_sum(s) * (1.0f / DM) + EPS);
#pragma unroll
        for (int j = 0; j < 8; ++j) { const f32x4 gp = *((const f32x4*)gpost + lane + 64 * j); v[j] = v[j] + w[j] * r1 * gp; }
    }
    f32x4* xo = (f32x4*)(xout + (size_t)row * DM) + lane;
#pragma unroll
    for (int j = 0; j < 8; ++j) xo[64 * j] = v[j];
    if (mode == 0) return;
    float s2 = 0.f;
#pragma unroll
    for (int j = 0; j < 8; ++j) s2 += (v[j][0] * v[j][0] + v[j][1] * v[j][1]) + (v[j][2] * v[j][2] + v[j][3] * v[j][3]);
    const float r2 = 1.0f / sqrtf(wave_sum(s2) * (1.0f / DM) + EPS);
    if (mode == 1) {
#pragma unroll
        for (int j = 0; j < 8; ++j) *((f16x4*)(o16 + (size_t)row * DM) + lane + 64 * j) = cvt4(v[j] * r2);
    } else if (mode == 2) {
        const int b = row >> 12, t = row & 4095;
#pragma unroll
        for (int j = 0; j < 8; ++j) { const int col = 4 * lane + 256 * j; const f32x4 gn = *((const f32x4*)gnext + lane + 64 * j);
            *(f16x4*)(o16 + ((size_t)((b * NG + (col >> 4)) * SEQ + t)) * 16 + (col & 15)) = cvt4(v[j] * r2 * gn); }
    } else {
#pragma unroll
        for (int j = 0; j < 8; ++j) { const f32x4 gn = *((const f32x4*)gnext + lane + 64 * j); *((f32x4*)(o32 + (size_t)row * DM) + lane + 64 * j) = v[j] * r2 * gn; }
    }
}
__device__ __forceinline__ void ph_prologue(const Params& p, LAS unsigned char* lds, int vcu, int G, int tid) {
    const int lane = tid & 63, wave = tid >> 6, gw = vcu * 8 + wave, NGW = G * 8;
    unsigned char* ws = p.ws;
    LAS float* scr = (LAS float*)(lds + wave * 16384);
    {
        constexpr int I_GLU = 32 * 64, I_UP = 32 * 256, I_DN = 128 * 64, I_KV = 32 * 96, I_QG = 32 * 72, I_WO = 32 * 64, I_C1 = 32 * 8, I_C2 = 4 * 4;
        constexpr int NIT = 2 * I_GLU + 4 * I_UP + 4 * I_DN + I_KV + 2 * I_QG + 2 * I_WO + 4 * I_C1 + 2 * I_C2;
        for (int it = gw; it < NIT; it += NGW) {
            int r = it;
            if (r < 2 * I_GLU) { const int l = r / I_GLU; transpose_item(p.in[17] + (size_t)l * DM * DM, DM, DM, DM, (f16*)(ws + WS_WGLU) + (size_t)l * DM * DM, 0, nullptr, scr, r % I_GLU, lane); continue; } r -= 2 * I_GLU;
            if (r < 4 * I_UP) { const int l = r / I_UP; transpose_item(p.in[33] + (size_t)l * DM * FF, DM, FF, FF, (f16*)(ws + WS_WUP) + (size_t)l * DM * FF, 0, p.in[32] + l * DM, scr, r % I_UP, lane); continue; } r -= 4 * I_UP;
            if (r < 4 * I_DN) { const int l = r / I_DN; transpose_item(p.in[34] + (size_t)l * DM * FF, FF, DM, DM, (f16*)(ws + WS_WDN) + (size_t)l * DM * FF, 0, nullptr, scr, r % I_DN, lane); continue; } r -= 4 * I_DN;
            if (r < I_KV) { transpose_item(p.in[21], DM, NKV, NKV, (f16*)(ws + WS_WKVQG), 0, p.in[20], scr, r, lane); continue; } r -= I_KV;
            if (r < I_QG) { transpose_item(p.in[29], DM, NQG, NQGP, (f16*)(ws + WS_WKVQG), NKV, p.in[28], scr, r, lane); continue; } r -= I_QG;
            if (r < I_QG) { transpose_item(p.in[29] + (size_t)DM * NQG, DM, NQG, NQGP, (f16*)(ws + WS_WQG1), 0, p.in[28] + DM, scr, r, lane); continue; } r -= I_QG;
            if (r < 2 * I_WO) { const int l = r / I_WO; transpose_item(p.in[30] + (size_t)l * DM * DM, DM, DM, DM, (f16*)(ws + WS_WO) + (size_t)l * DM * DM, 0, nullptr, scr, r % I_WO, lane); continue; } r -= 2 * I_WO;
            if (r < 4 * I_C1) { const int q = r / I_C1, kv = q >> 1, j = q & 1; transpose_item(p.in[kv ? 25 : 22] + (size_t)j * 2048 * 256, 2048, 256, 256, (f16*)(ws + WS_CW1) + (size_t)kv * 512 * 2048, j * 256, nullptr, scr, r % I_C1, lane); continue; } r -= 4 * I_C1;
            { const int kv = r / I_C2; transpose_item(p.in[kv ? 27 : 24], 256, 128, 128, (f16*)(ws + WS_CW2) + (size_t)kv * 128 * 256, 0, nullptr, scr, r % I_C2, lane); }
        }
    }
    const int gt = vcu * 512 + tid, NGT = G * 512;
    for (int it = gt; it < 2 * NG * NST; it += NGT) {
        const int l = it / (NG * NST), g = (it / NST) % NG, pp = it % NST;
        const double dt = exp((double)p.in[11][l * NG + g]);
        const double lr = (double)p.in[9][it], li = (double)p.in[10][it];
        const double mag = exp(lr * dt); double sn, cs; sincos_d(li * dt, sn, cs);
        const double are = mag * cs, aim = mag * sn, den = lr * lr + li * li, nr = are - 1.0;
        const double fre = (nr * lr + aim * li) / den, fim = (aim * lr - nr * li) / den;
        float* AT = (float*)(ws + WS_AT); AT[2 * it] = (float)are; AT[2 * it + 1] = (float)aim;
        if (pp == 0) ((float*)(ws + WS_DT))[l * NG + g] = (float)dt;
        const float* bre = p.in[12] + (size_t)it * 16; const float* bim = p.in[13] + (size_t)it * 16;
        float* BBF = (float*)(ws + WS_BBF) + (size_t)it * 32;
        f16* BST = (f16*)(ws + WS_BST) + (size_t)(l * NG + g) * 128 * 16;
        const double idt = 1.0 / dt;
#pragma unroll
        for (int i = 0; i < 16; ++i) { const double br = bre[i], bi = bim[i]; const double xr = fre * br - fim * bi, xi = fre * bi + fim * br;
            BBF[i] = (float)xr; BBF[16 + i] = (float)xi; BST[pp * 16 + i] = (f16)(float)(xr * idt); BST[(64 + pp) * 16 + i] = (f16)(float)(xi * idt); }
        f16* CCT = (f16*)(ws + WS_CCT) + (size_t)(l * NG + g) * 16 * 128;
        const float* cre = p.in[14] + (size_t)(l * NG + g) * 16 * 64; const float* cim = p.in[15] + (size_t)(l * NG + g) * 16 * 64;
#pragma unroll
        for (int j = 0; j < 16; ++j) { CCT[j * 128 + pp] = (f16)cre[j * 64 + pp]; CCT[j * 128 + 64 + pp] = (f16)(-cim[j * 64 + pp]); }
    }
    for (int it = gt; it < 4100 * 16; it += NGT) {
        const int pi = it >> 4, f = it & 15; const int pos = pi < 4096 ? pi : PAST + (pi - 4096);
        const float ang = (float)pos * p.inv_freq[f]; double sn, cs; sincos_d((double)ang, sn, cs);
        float* R = (float*)(ws + WS_ROPE) + (size_t)pi * 32; R[f] = (float)cs; R[16 + f] = (float)sn;
    }
    for (int it = gw; it < 512; it += NGW) {
        const int kv = it >> 8, h = it & 255; const float* pe = p.in[kv ? 26 : 23]; const float* w1 = p.in[kv ? 25 : 22];
        float s = 0.f;
        for (int i = lane; i < 4096; i += 64) s += pe[i] * w1[(size_t)i * 256 + h];
        s = wave_sum(s);
        if (lane == 0) ((float*)(ws + WS_PE))[it] = s;
    }
    {
        f16* RCS = (f16*)(ws + WS_RC) + RC_P_ELEMS; const int* pt = (const int*)p.in[7];
        for (int it = gw; it < NBS * PAST; it += NGW) {
            const int b = it >> 14, pos = it & (PAST - 1); const int page = pt[b * NPAGES + (pos >> 7)];
            const f32x4* src = (const f32x4*)(p.in[2] + ((size_t)page * PAGE + (pos & 127)) * 1024) + lane;
#pragma unroll
            for (int j = 0; j < 4; ++j) { const f32x4 v = src[64 * j]; const int e = 4 * lane + 256 * j, kv = e >> 9, g = (e >> 7) & 3, d = e & 127;
                *(f16x4*)(RCS + ((size_t)(((kv * 8 + b) * 4 + g)) * PAST + pos) * 128 + d) = cvt4(v); }
        }
    }
    for (int it = gw; it < NBS * 508; it += NGW) {
        const int b = it / 508, r = it % 508;
        const f32x4* src = (const f32x4*)(p.in[4] + ((size_t)(b * 512 + r + 4)) * 1024) + lane; f32x4* dst = (f32x4*)(p.out + O_SWAS + ((size_t)(b * 512 + r)) * 1024) + lane;
#pragma unroll
        for (int j = 0; j < 4; ++j) dst[64 * j] = src[64 * j];
    }
    for (int m = gw; m < MP + MS; m += NGW) {
        if (m < MP) resnorm_row(nullptr, nullptr, p.in[0], (float*)(ws + WS_X), 2, p.in[8], (f16*)(ws + WS_A0), nullptr, m, lane);
        else resnorm_row(nullptr, nullptr, p.in[1], (float*)(ws + WS_XS), 3, p.in[8], nullptr, (float*)(ws + WS_XNS), m - MP, lane);
    }
}
__device__ __forceinline__ void s5_prompt_unit(LAS unsigned char* lds, int l, int b, int g, const Params& p, int tid) {
    const int lane = tid & 63, w = tid >> 6, fr = lane & 15, q = lane >> 4;
    unsigned char* ws = p.ws;
    LAS float* bu = (LAS float*)(lds + w * 12800);
    LAS f16* hb = (LAS f16*)(lds + w * 12800 + 8448);
    LAS float* carry = (LAS float*)(lds + 102400);
    const f16* xg = (const f16*)(ws + WS_A0) + ((size_t)(b * NG + g) * SEQ) * 16;
    const f16* BST = (const f16*)(ws + WS_BST) + (size_t)(l * NG + g) * 128 * 16;
    const f16* CCT = (const f16*)(ws + WS_CCT) + (size_t)(l * NG + g) * 16 * 128;
    const f16x8 z8 = {0, 0, 0, 0, 0, 0, 0, 0};
    f16x8 Bs[8], Cc[4];
#pragma unroll
    for (int nt = 0; nt < 8; ++nt) Bs[nt] = (q < 2) ? *(const f16x8*)(BST + (nt * 16 + fr) * 16 + 8 * q) : z8;
#pragma unroll
    for (int s = 0; s < 4; ++s) Cc[s] = *(const f16x8*)(CCT + fr * 128 + 32 * s + 8 * q);
    const float* AT = (const float*)(ws + WS_AT) + (size_t)((l * NG + g) * NST + lane) * 2;
    const float ar = AT[0], ai = AT[1];
    const float dt = ((const float*)(ws + WS_DT))[l * NG + g];
    const f32x4 dsk = *(const f32x4*)(p.in[16] + (size_t)l * DM + g * 16 + 4 * q);
    float hr = 0.f, hi = 0.f;
    const f32x4 z4 = {0.f, 0.f, 0.f, 0.f};
    for (int sc = 0; sc < 32; ++sc) {
        const int t0 = 512 * w + 16 * sc;
        const f16x8 ub = (q < 2) ? *(const f16x8*)(xg + (size_t)(t0 + fr) * 16 + 8 * q) : z8;
#pragma unroll
        for (int nt = 0; nt < 8; ++nt) { const f32x4 d = __builtin_amdgcn_mfma_f32_16x16x32_f16(Bs[nt], ub, z4, 0, 0, 0); *(LAS f32x4*)(bu + fr * 132 + nt * 16 + 4 * q) = d; }
        LDS_WAIT();
#pragma unroll
        for (int t = 0; t < 16; ++t) { const float br = bu[t * 132 + lane], bi = bu[t * 132 + 64 + lane]; const float nr = ar * hr - ai * hi + br, ni = ar * hi + ai * hr + bi; hr = nr; hi = ni; }
        LDS_WAIT();
    }
    carry[(w * 64 + lane) * 2] = hr; carry[(w * 64 + lane) * 2 + 1] = hi;
    __syncthreads();
    float pr = ar, pi = ai;
#pragma unroll
    for (int i = 0; i < 9; ++i) { const float nr = pr * pr - pi * pi, ni = 2.f * pr * pi; pr = nr; pi = ni; }
    hr = 0.f; hi = 0.f;
    for (int v = 0; v < w; ++v) { const float sr = carry[(v * 64 + lane) * 2], si = carry[(v * 64 + lane) * 2 + 1]; const float nr = pr * hr - pi * hi + sr, ni = pr * hi + pi * hr + si; hr = nr; hi = ni; }
    f16* yact = (f16*)(ws + WS_A1);
    for (int sc = 0; sc < 32; ++sc) {
        const int t0 = 512 * w + 16 * sc;
        const f16x8 ub = (q < 2) ? *(const f16x8*)(xg + (size_t)(t0 + fr) * 16 + 8 * q) : z8;
        const f16x4 xn4 = *(const f16x4*)(xg + (size_t)(t0 + fr) * 16 + 4 * q);
#pragma unroll
        for (int nt = 0; nt < 8; ++nt) { const f32x4 d = __builtin_amdgcn_mfma_f32_16x16x32_f16(Bs[nt], ub, z4, 0, 0, 0); *(LAS f32x4*)(bu + fr * 132 + nt * 16 + 4 * q) = d; }
        LDS_WAIT();
#pragma unroll
        for (int t = 0; t < 16; ++t) { const float br = bu[t * 132 + lane], bi = bu[t * 132 + 64 + lane]; const float nr = ar * hr - ai * hi + br, ni = ar * hi + ai * hr + bi; hr = nr; hi = ni;
            hb[t * 136 + lane] = (f16)hr; hb[t * 136 + 64 + lane] = (f16)hi; }
        LDS_WAIT();
        f32x4 acc = z4;
#pragma unroll
        for (int s = 0; s < 4; ++s) { const f16x8 hB = *(const LAS f16x8*)(hb + fr * 136 + 32 * s + 8 * q); acc = __builtin_amdgcn_mfma_f32_16x16x32_f16(Cc[s], hB, acc, 0, 0, 0); }
        f16x4 o;
#pragma unroll
        for (int r = 0; r < 4; ++r) o[r] = (f16)gelu_tanh(dt * acc[r] + dsk[r] * (float)xn4[r]);
        *(f16x4*)(yact + (size_t)(b * SEQ + t0 + fr) * DM + g * 16 + 4 * q) = o;
        LDS_WAIT();
    }
    if (w == 7) { const size_t o = (size_t)((l * NBP + b) * NG + g) * NST + lane; p.out[O_REP + o] = dt * hr; p.out[O_IMP + o] = dt * hi; }
    __syncthreads();
}
__device__ __forceinline__ void s5_sample_wave(int l, int b, int g, const Params& p, int lane) {
    unsigned char* ws = p.ws;
    const size_t sidx = (size_t)((l * NBS + b) * NG + g) * NST + lane;
    float hr = p.in[5][sidx], hi = p.in[6][sidx];
    const float* AT = (const float*)(ws + WS_AT) + (size_t)((l * NG + g) * NST + lane) * 2; const float ar = AT[0], ai = AT[1];
    const float* BBF = (const float*)(ws + WS_BBF) + (size_t)((l * NG + g) * NST + lane) * 32;
    float bre[16], bim[16];
#pragma unroll
    for (int i = 0; i < 16; ++i) { bre[i] = BBF[i]; bim[i] = BBF[16 + i]; }
    const float* cre = p.in[14] + (size_t)(l * NG + g) * 16 * 64 + lane; const float* cim = p.in[15] + (size_t)(l * NG + g) * 16 * 64 + lane;
    const float dsk = (lane < 16) ? p.in[16][(size_t)l * DM + g * 16 + lane] : 0.f;
    for (int i = 0; i < LS; ++i) {
        const float* xn = (const float*)(ws + WS_XNS) + (size_t)(b * LS + i) * DM + g * 16;
        float br = 0.f, bi = 0.f;
#pragma unroll
        for (int k = 0; k < 16; ++k) { const float u = xn[k]; br += bre[k] * u; bi += bim[k] * u; }
        const float nr = ar * hr - ai * hi + br, ni = ar * hi + ai * hr + bi; hr = nr; hi = ni;
        float yv = 0.f;
#pragma unroll
        for (int j = 0; j < 16; ++j) { const float s = wave_sum(cre[j * 64] * hr - cim[j * 64] * hi); if (lane == j) yv = s; }
        if (lane < 16) { const float y = gelu_tanh(yv + dsk * xn[lane]); ((f16*)(ws + WS_AS1))[(size_t)(b * LS + i) * DM + g * 16 + lane] = (f16)y; }
    }
    p.out[O_RES + sidx] = hr; p.out[O_IMS + sidx] = hi;
}
template <int EPI>
__device__ __forceinline__ void sgemm_phase(LAS unsigned char* lds, const f16* Wt, int N, int K, const f16* act, const Params& p, int L, int nkvcols, int vcu, int G, int tid) {
    const int lane = tid & 63, w = tid >> 6, c = lane & 31, h = lane >> 5;
    LAS float* red = (LAS float*)lds;
    LAS float* tile = (LAS float*)(lds + 8 * 32 * 33 * 4);
    unsigned char* ws = p.ws;
    const int kw = K >> 3, k0 = w * kw;
    for (int u = vcu; u < N / 32; u += G) {
        const int n0 = 32 * u;
        f32x16 acc;
#pragma unroll
        for (int r = 0; r < 16; ++r) acc[r] = 0.f;
        const f16* wrow = Wt + (size_t)(n0 + c) * K + k0 + 8 * h; const f16* arow = act + (size_t)c * K + k0 + 8 * h;
#pragma unroll 4
        for (int ks = 0; ks < kw; ks += 16) { const f16x8 a = *(const f16x8*)(wrow + ks), bb = *(const f16x8*)(arow + ks); acc = __builtin_amdgcn_mfma_f32_32x32x16_f16(a, bb, acc, 0, 0, 0); }
#pragma unroll
        for (int r = 0; r < 16; ++r) red[(w * 32 + (r & 3) + 8 * (r >> 2) + 4 * h) * 33 + c] = acc[r];
        __syncthreads();
        const int tok = tid >> 4, nl = (tid & 15) * 2;
        float v0 = 0.f, v1 = 0.f;
#pragma unroll
        for (int ww = 0; ww < 8; ++ww) { v0 += red[(ww * 32 + nl) * 33 + tok]; v1 += red[(ww * 32 + nl + 1) * 33 + tok]; }
        tile[tok * 33 + nl] = v0; tile[tok * 33 + nl + 1] = v1;
        __syncthreads();
#pragma unroll
        for (int e = 0; e < 2; ++e) {
            const int n = n0 + nl + e; const float v = e ? v1 : v0;
            if (EPI == 0) { const float y = (float)((const f16*)(ws + WS_AS1))[(size_t)tok * DM + n]; ((float*)(ws + WS_YS))[(size_t)tok * DM + n] = y * sigmoidf_(v + p.in[18][(size_t)L * DM + n]); }
            else if (EPI == 1) { const float a = fmaxf(v, 0.f); ((f16*)(ws + WS_HS))[(size_t)tok * FF + n] = (f16)(a * a); }
            else if (EPI == 2) { ((float*)(ws + WS_YS))[(size_t)tok * DM + n] = v; }
            else {
                const int d = n & 127, bq = tok >> 2, ii = tok & 3;
                const float* rp = (const float*)(ws + WS_ROPE) + (size_t)(4096 + ii) * 32;
                float vr = v;
                if (d < 32) { const float cs = rp[d & 15], sn = rp[16 + (d & 15)]; const float xp = tile[tok * 33 + ((nl + e) ^ 16)]; vr = (d < 16) ? (v * cs - xp * sn) : (v * cs + xp * sn); }
                if (n < nkvcols) {
                    const int hh = n >> 7, br = hh >> 3, kv = (hh >> 2) & 1, g = hh & 3, cc = kv * 512 + g * 128 + d;
                    const float o = (br >= 1 && kv == 0) ? vr : v;
                    if (br == 0) p.out[O_CMPS + (size_t)tok * 1024 + cc] = o;
                    else if (br == 1) p.out[O_SLCS + (size_t)tok * 1024 + cc] = o;
                    else p.out[O_SWAS + ((size_t)(bq * 512 + 508 + ii)) * 1024 + cc] = o;
                } else {
                    const int cq = n - nkvcols;
                    if (cq < 2048) { ((float*)(ws + WS_QNS))[(size_t)tok * DM + cq] = v * QSCALE; ((float*)(ws + WS_QRS))[(size_t)tok * DM + cq] = vr * QSCALE; }
                    else if (cq < NQG) ((float*)(ws + WS_GATESS))[(size_t)tok * 48 + cq - 2048] = sigmoidf_(v);
                }
            }
        }
        __syncthreads();
    }
}

__device__ __forceinline__ void cmp2_unit(LAS unsigned char* lds, int unit, const Params& p, int tid) {
    unsigned char* ws = p.ws;
    const int lane = tid & 63, w = tid >> 6, fr = lane & 15, q = lane >> 4;
    int mi, part, nvalid, R0, kv, b, g; const bool prompt = unit < 32;
    if (prompt) { mi = unit >> 1; part = unit & 1; nvalid = 255; R0 = mi * 256; kv = mi >> 3; b = (mi >> 2) & 1; g = mi & 3; }
    else { const int us = unit - 32; mi = us >> 3; part = us & 7; nvalid = 1023; R0 = 4096 + mi * 1024; kv = mi >> 5; b = (mi >> 2) & 7; g = mi & 3; }
    const int n0 = part * 128;
    LAS f16* At = (LAS f16*)lds;
    LAS f16* Wt = (LAS f16*)(lds + 67584);
    const float* PROJ = (const float*)(ws + WS_PROJ); const float* PE = (const float*)(ws + WS_PE) + kv * 256;
    for (int idx = tid; idx < 128 * 64; idx += 512) {
        const int row = idx >> 6, h4 = (idx & 63) * 4, n = n0 + row; f16x4 o = {0, 0, 0, 0};
        if (n < nvalid) { const f32x4 a = *(const f32x4*)(PROJ + (size_t)(R0 + n) * 512 + h4), bb = *(const f32x4*)(PROJ + (size_t)(R0 + n + 1) * 512 + 256 + h4), pe = *(const f32x4*)(PE + h4);
#pragma unroll
            for (int i = 0; i < 4; ++i) o[i] = (f16)gelu_tanh(a[i] + bb[i] + pe[i]); }
        *(LAS f16x4*)(At + row * 264 + h4) = o;
    }
    const f16* W2 = (const f16*)(ws + WS_CW2) + (size_t)kv * 128 * 256;
    for (int idx = tid; idx < 128 * 32; idx += 512) { const int d = idx >> 5, c8 = (idx & 31) * 8; *(LAS f16x8*)(Wt + d * 264 + c8) = *(const f16x8*)(W2 + d * 256 + c8); }
    __syncthreads();
    f32x4 acc[8];
#pragma unroll
    for (int dt = 0; dt < 8; ++dt) acc[dt] = (f32x4){0.f, 0.f, 0.f, 0.f};
#pragma unroll
    for (int s = 0; s < 8; ++s) { const f16x8 bop = *(const LAS f16x8*)(At + (16 * w + fr) * 264 + 32 * s + 8 * q);
#pragma unroll
        for (int dt = 0; dt < 8; ++dt) { const f16x8 aop = *(const LAS f16x8*)(Wt + (16 * dt + fr) * 264 + 32 * s + 8 * q); acc[dt] = __builtin_amdgcn_mfma_f32_16x16x32_f16(aop, bop, acc[dt], 0, 0, 0); } }
    const int n = n0 + 16 * w + fr;
    if (prompt) {
        if (kv == 0) { f16* o = (f16*)(ws + WS_KC) + ((size_t)((b * 4 + g) * 256 + n)) * 128 + 4 * q;
#pragma unroll
            for (int dt = 0; dt < 8; ++dt) *(f16x4*)(o + 16 * dt) = cvt4(acc[dt]); }
        else { f16* o = (f16*)(ws + WS_VCT) + ((size_t)(b * 4 + g) * 128) * 256 + n;
#pragma unroll
            for (int dt = 0; dt < 8; ++dt)
#pragma unroll
                for (int r = 0; r < 4; ++r) o[(size_t)(16 * dt + 4 * q + r) * 256] = (f16)acc[dt][r]; }
    } else {
        f16* o = (f16*)(ws + (kv ? WS_VCS : WS_KCS)) + ((size_t)((b * 4 + g) * 1024 + n)) * 128 + 4 * q;
#pragma unroll
        for (int dt = 0; dt < 8; ++dt) *(f16x4*)(o + 16 * dt) = cvt4(acc[dt]);
    }
    __syncthreads();
}
constexpr int AT_KB = 0, AT_VB = 32768, AT_VSZ = 18432, AT_PSUM = 69632, AT_SELM = 135168;
struct AStage { u32x4 k0, k1, v0, v1; };
template <bool HASV>
__device__ __forceinline__ void a_load(AStage& s, const f16* Kb, const f16* Vt, int vstride, int tid) {
    const int p0 = tid, p1 = tid + 512;
    s.k0 = *(const u32x4*)(Kb + (p0 >> 4) * 128 + (p0 & 15) * 8); s.k1 = *(const u32x4*)(Kb + (p1 >> 4) * 128 + (p1 & 15) * 8);
    if (HASV) { s.v0 = *(const u32x4*)(Vt + (size_t)(p0 >> 3) * vstride + (p0 & 7) * 8); s.v1 = *(const u32x4*)(Vt + (size_t)(p1 >> 3) * vstride + (p1 & 7) * 8); }
}
template <bool HASV>
__device__ __forceinline__ void a_store(const AStage& s, LAS unsigned char* kb, LAS unsigned char* vb, int tid) {
    const int p0 = tid, p1 = tid + 512;
    { const int row = p0 >> 4, ch = p0 & 15; *(LAS u32x4*)(kb + row * 256 + ((ch ^ (row & 7)) << 4)) = s.k0; }
    { const int row = p1 >> 4, ch = p1 & 15; *(LAS u32x4*)(kb + row * 256 + ((ch ^ (row & 7)) << 4)) = s.k1; }
    if (HASV) { *(LAS u32x4*)(vb + (p0 >> 3) * 144 + (p0 & 7) * 16) = s.v0; *(LAS u32x4*)(vb + (p1 >> 3) * 144 + (p1 & 7) * 16) = s.v1; }
}
template <int BR>
__device__ __forceinline__ void flash_loop(unsigned long long tmask, const f16* Kbase, const f16* Vbase, int vstride, LAS unsigned char* lds, const f16x8 (&qf)[8], f32x16 (&acc)[4],
                                           float& m, float& l, float inv_l, int cur, int tk, int vmax, unsigned sel_lo, unsigned sel_hi, int tid) {
    if (tmask == 0ull) return;
    const int lane = tid & 63, c = lane & 31, h = lane >> 5;
    const float NEG = -__builtin_inff();
    int j = __builtin_ctzll(tmask); tmask &= tmask - 1ull;
    AStage st;
    a_load<BR != 0>(st, Kbase + (size_t)j * 64 * 128, Vbase + (size_t)j * 64, vstride, tid);
    a_store<BR != 0>(st, lds + AT_KB, lds + AT_VB, tid);
    __syncthreads();
    int bi = 0;
    for (;;) {
        int jn = -1;
        if (tmask != 0ull) { jn = __builtin_ctzll(tmask); tmask &= tmask - 1ull; a_load<BR != 0>(st, Kbase + (size_t)jn * 64 * 128, Vbase + (size_t)jn * 64, vstride, tid); }
        const LAS unsigned char* kb = lds + AT_KB + bi * 16384; const LAS unsigned char* vb = lds + AT_VB + bi * AT_VSZ;
        int lo = 0, hi = 63;
        if (BR <= 1) { hi = vmax - 64 * j; }
        else if (BR == 2) { const bool rs = j < 32 ? ((sel_lo >> j) & 1u) : ((sel_hi >> (j - 32)) & 1u); if (!rs) { lo = 1; hi = 0; } else if (j == cur) hi = tk; }
        else { if (j == cur) hi = tk; else if (j == cur - 8) lo = tk + 1; }
        const bool need_mask = !__all(lo == 0 && hi >= 63);
#pragma unroll 1
        for (int hf = 0; hf < 2; ++hf) {
            f32x16 pp;
#pragma unroll
            for (int r = 0; r < 16; ++r) pp[r] = 0.f;
#pragma unroll
            for (int s = 0; s < 8; ++s) {
                const f16x8 a0 = *(const LAS f16x8*)(kb + (c + 32 * hf) * 256 + (((2 * s + h) ^ (c & 7)) << 4));
                pp = __builtin_amdgcn_mfma_f32_32x32x16_f16(a0, qf[s], pp, 0, 0, 0);
            }
            if (need_mask) {
#pragma unroll
                for (int r = 0; r < 16; ++r) { const int k = (r & 3) + 8 * (r >> 2) + 4 * h + 32 * hf; if (k < lo || k > hi) pp[r] = NEG; }
            }
            if (BR == 1) {
                const float mb = m * LOG2E;
#pragma unroll
                for (int r = 0; r < 16; ++r) pp[r] = __builtin_amdgcn_exp2f(pp[r] * LOG2E - mb) * inv_l;
                LAS float* ps = (LAS float*)(lds + AT_PSUM) + tk * 256 + 64 * j + 32 * hf;
#pragma unroll
                for (int r = 0; r < 16; ++r) { float a = pp[r]; a += __shfl_xor(a, 1); a += __shfl_xor(a, 2);
                    if ((c & 3) == 0) ps[(r & 3) + 8 * (r >> 2) + 4 * h] = a; }
            } else {
                float mx = pp[0];
#pragma unroll
                for (int r = 1; r < 16; ++r) mx = fmaxf(mx, pp[r]);
                mx = fmaxf(mx, __shfl_xor(mx, 32));
                const float mn = fmaxf(m, mx), alpha = __builtin_amdgcn_exp2f((m - mn) * LOG2E), mb = mn * LOG2E;
                m = mn;
                float rs = 0.f;
#pragma unroll
                for (int r = 0; r < 16; ++r) { pp[r] = __builtin_amdgcn_exp2f(pp[r] * LOG2E - mb); rs += pp[r]; }
                rs += __shfl_xor(rs, 32);
                l = l * alpha + rs;
                if (BR >= 2) {
                    if (!__all(alpha == 1.0f)) {
#pragma unroll
                        for (int dt = 0; dt < 4; ++dt)
#pragma unroll
                            for (int r = 0; r < 16; ++r) acc[dt][r] *= alpha;
                    }
                }
            }
            if (BR >= 1) {
                f16x8 pk[2];
#pragma unroll
                for (int e = 0; e < 8; ++e) { pk[0][e] = (f16)pp[e]; pk[1][e] = (f16)pp[8 + e]; }
#pragma unroll
                for (int dt = 0; dt < 4; ++dt)
#pragma unroll
                    for (int s2 = 0; s2 < 2; ++s2) {
                        const int s = 2 * hf + s2;
                        const f16x4 vlo = *(const LAS f16x4*)(vb + (32 * dt + c) * 144 + (16 * s + 4 * h) * 2);
                        const f16x4 vhi = *(const LAS f16x4*)(vb + (32 * dt + c) * 144 + (16 * s + 8 + 4 * h) * 2);
                        f16x8 a; a[0] = vlo[0]; a[1] = vlo[1]; a[2] = vlo[2]; a[3] = vlo[3]; a[4] = vhi[0]; a[5] = vhi[1]; a[6] = vhi[2]; a[7] = vhi[3];
                        acc[dt] = __builtin_amdgcn_mfma_f32_32x32x16_f16(a, pk[s2], acc[dt], 0, 0, 0);
                    }
            }
        }
        if (jn >= 0) a_store<BR != 0>(st, lds + AT_KB + (bi ^ 1) * 16384, lds + AT_VB + (bi ^ 1) * AT_VSZ, tid);
        __syncthreads();
        if (jn < 0) break;
        j = jn; bi ^= 1;
    }
}
__device__ __forceinline__ void out16_update(LAS unsigned char* reg, const f32x16 (&acc)[4], float sc, bool first, int lane) {
#pragma unroll
    for (int dt = 0; dt < 4; ++dt)
#pragma unroll
        for (int hf = 0; hf < 2; ++hf) {
            LAS f16x8* ptr = (LAS f16x8*)(reg + ((dt * 2 + hf) * 64 + lane) * 16);
            f16x8 o;
            if (first) {
#pragma unroll
                for (int e = 0; e < 8; ++e) o[e] = (f16)(acc[dt][8 * hf + e] * sc);
            } else {
                const f16x8 pv = *ptr;
#pragma unroll
                for (int e = 0; e < 8; ++e) o[e] = (f16)((float)pv[e] + acc[dt][8 * hf + e] * sc);
            }
            *ptr = o;
        }
}
__device__ __forceinline__ void attn_prompt_tile(LAS unsigned char* lds, int b, int g, int cur, const Params& p, int tid) {
    unsigned char* ws = p.ws;
    const int lane = tid & 63, w = tid >> 6, c = lane & 31, h = lane >> 5;
    const int tk = 8 * w + (c >> 2), t = 64 * cur + tk, hd = 4 * g + (c & 3);
    const size_t row = (size_t)b * SEQ + t;
    LAS unsigned char* oreg = lds + AT_PSUM + w * 8192;
    f32x16 acc[4];
    f16x8 qf[8];
    { const f16* qp = (const f16*)(ws + WS_QN) + row * DM + hd * 128 + 8 * h;
#pragma unroll
      for (int s = 0; s < 8; ++s) qf[s] = *(const f16x8*)(qp + 16 * s); }
    const int ntc = (4 * cur + 2) / 64 + 1;
    const f16* Kc = (const f16*)(ws + WS_KC) + (size_t)(b * 4 + g) * 256 * 128; const f16* Vc = (const f16*)(ws + WS_VCT) + (size_t)(b * 4 + g) * 128 * 256;
    const unsigned long long cmask = (1ull << ntc) - 1ull;
    float m = -1e30f, l = 0.f;
#pragma unroll
    for (int dt = 0; dt < 4; ++dt)
#pragma unroll
        for (int r = 0; r < 16; ++r) acc[dt][r] = 0.f;
    { const int vmax = t >= 31 ? ((t - 31) >> 4) : -1;
      flash_loop<0>(cmask, Kc, Vc, 256, lds, qf, acc, m, l, 0.f, cur, tk, vmax, 0u, 0u, tid);
      const float inv_l = l > 0.f ? 1.0f / l : 0.f;
      flash_loop<1>(cmask, Kc, Vc, 256, lds, qf, acc, m, l, inv_l, cur, tk, vmax, 0u, 0u, tid); }
    {
        const LAS float* ps = (const LAS float*)(lds + AT_PSUM);
        LAS unsigned* selm = (LAS unsigned*)(lds + AT_SELM);
        const int jj = lane;
        for (int k = 0; k < 8; ++k) {
            const int tkk = 8 * w + k; float imp = 0.f;
#pragma unroll
            for (int i = 4 * jj - 1; i <= 4 * jj + 3; ++i) if (i >= 0 && i < 64 * ntc && i <= 254) imp += ps[tkk * 256 + i];
            const bool elig = jj <= cur, forced = (jj == 0) || (jj == cur) || (jj == cur - 1);
            const float val = elig ? (forced ? 1.0e4f : imp) : -__builtin_inff();
            int rank = 0;
            for (int kk = 0; kk < 64; ++kk) { const float vk = __shfl(val, kk); rank += ((vk > val) || (vk == val && kk < jj)) ? 1 : 0; }
            const unsigned long long mk = __ballot(elig && rank < 16);
            if (lane == 0) { selm[2 * tkk] = (unsigned)mk; selm[2 * tkk + 1] = (unsigned)(mk >> 32); }
        }
    }
    { const float g_c = ((const float*)(ws + WS_GATES))[row * 48 + hd * 3 + 0];
      LDS_WAIT();
      out16_update(oreg, acc, g_c, true, lane); }
    __syncthreads();
    unsigned sel_lo, sel_hi; unsigned long long umask;
    { const LAS unsigned* selm = (const LAS unsigned*)(lds + AT_SELM);
      unsigned ulo = selm[2 * lane], uhi = selm[2 * lane + 1];
#pragma unroll
      for (int o = 1; o < 64; o <<= 1) { ulo |= __shfl_xor(ulo, o); uhi |= __shfl_xor(uhi, o); }
      umask = ((unsigned long long)(unsigned)__builtin_amdgcn_readfirstlane(uhi) << 32) | (unsigned)__builtin_amdgcn_readfirstlane(ulo);
      sel_lo = selm[2 * tk]; sel_hi = selm[2 * tk + 1]; }
    { const f16* qp = (const f16*)(ws + WS_QR) + row * DM + hd * 128 + 8 * h;
#pragma unroll
      for (int s = 0; s < 8; ++s) qf[s] = *(const f16x8*)(qp + 16 * s); }
    m = -1e30f; l = 0.f;
#pragma unroll
    for (int dt = 0; dt < 4; ++dt)
#pragma unroll
        for (int r = 0; r < 16; ++r) acc[dt][r] = 0.f;
    flash_loop<2>(umask, (const f16*)(ws + WS_KS) + (size_t)(b * 4 + g) * SEQ * 128, (const f16*)(ws + WS_VST) + (size_t)(b * 4 + g) * 128 * SEQ, SEQ, lds, qf, acc, m, l, 0.f, cur, tk, 0, sel_lo, sel_hi, tid);
    { const float g_s = ((const float*)(ws + WS_GATES))[row * 48 + hd * 3 + 1];
      out16_update(oreg, acc, l > 0.f ? g_s / l : 0.f, false, lane); }
    m = -1e30f; l = 0.f;
#pragma unroll
    for (int dt = 0; dt < 4; ++dt)
#pragma unroll
        for (int r = 0; r < 16; ++r) acc[dt][r] = 0.f;
    { const int jlo = cur >= 8 ? cur - 8 : 0; const unsigned long long wmask = ((cur == 63 ? ~0ull : ((1ull << (cur + 1)) - 1ull))) & ~((1ull << jlo) - 1ull);
      flash_loop<3>(wmask, (const f16*)(ws + WS_KW) + (size_t)(b * 4 + g) * SEQ * 128, (const f16*)(ws + WS_VWT) + (size_t)(b * 4 + g) * 128 * SEQ, SEQ, lds, qf, acc, m, l, 0.f, cur, tk, 0, 0u, 0u, tid); }
    { const float g_w = ((const float*)(ws + WS_GATES))[row * 48 + hd * 3 + 2]; const float sc = l > 0.f ? g_w / l : 0.f;
      f16* op = (f16*)(ws + WS_A1) + row * DM + hd * 128 + 4 * h;
#pragma unroll
      for (int dt = 0; dt < 4; ++dt)
#pragma unroll
          for (int hf = 0; hf < 2; ++hf) {
              const f16x8 pv = *(const LAS f16x8*)(oreg + ((dt * 2 + hf) * 64 + lane) * 16);
              f16x4 o0, o1;
#pragma unroll
              for (int e = 0; e < 4; ++e) { o0[e] = (f16)((float)pv[e] + acc[dt][8 * hf + e] * sc); o1[e] = (f16)((float)pv[4 + e] + acc[dt][8 * hf + 4 + e] * sc); }
              *(f16x4*)(op + 32 * dt + 16 * hf) = o0; *(f16x4*)(op + 32 * dt + 16 * hf + 8) = o1;
          } }
    LDS_WAIT();
    __syncthreads();
}
__device__ __forceinline__ float reduce4(float v0, float v1, float v2, float v3, int lane) {
    const bool up = (lane & 32) != 0;
    float a0 = up ? v2 : v0, a1 = up ? v3 : v1; const float b0 = up ? v0 : v2, b1 = up ? v1 : v3;
    a0 += __shfl_xor(b0, 32); a1 += __shfl_xor(b1, 32);
    const bool up2 = (lane & 16) != 0;
    float c0 = up2 ? a1 : a0; const float d0 = up2 ? a0 : a1;
    c0 += __shfl_xor(d0, 16);
    c0 += __shfl_xor(c0, 8); c0 += __shfl_xor(c0, 4); c0 += __shfl_xor(c0, 2); c0 += __shfl_xor(c0, 1);
    return c0;
}
__device__ __forceinline__ void softmax4(LAS float* sc, int n, int tid) {
    const int lane = tid & 63, w = tid >> 6;
    if (w < 4) {
        LAS float* s = sc + w * 1024; float mx = -__builtin_inff();
        for (int i = lane; i < n; i += 64) mx = fmaxf(mx, s[i]);
        mx = wave_max(mx); if (!(mx > -__builtin_inff())) mx = 0.f;
        float sum = 0.f;
        for (int i = lane; i < n; i += 64) { const float e = __expf(s[i] - mx); s[i] = e; sum += e; }
        sum = wave_sum(sum); const float inv = sum > 0.f ? 1.0f / sum : 1.0f;
        for (int i = lane; i < n; i += 64) s[i] *= inv;
    }
    __syncthreads();
}
__device__ __forceinline__ void attn_sample_unit(LAS unsigned char* lds, int unit, const Params& p, int tid) {
    unsigned char* ws = p.ws;
    const int lane = tid & 63, w = tid >> 6;
    const int b = unit >> 4, g = (unit >> 2) & 3, ii = unit & 3, tok = b * LS + ii, t = PAST + ii;
    LAS float* sc = (LAS float*)lds;
    LAS float* val = (LAS float*)(lds + 16384);
    LAS int* list = (LAS int*)(lds + 16384 + 1056);
    const int* pt = (const int*)p.in[7] + b * NPAGES;
    float qn[4][2], qr[4][2];
#pragma unroll
    for (int hh = 0; hh < 4; ++hh) { const f32x2 a = *(const f32x2*)((const float*)(ws + WS_QNS) + (size_t)tok * DM + (4 * g + hh) * 128 + 2 * lane), bb = *(const f32x2*)((const float*)(ws + WS_QRS) + (size_t)tok * DM + (4 * g + hh) * 128 + 2 * lane);
        qn[hh][0] = a[0]; qn[hh][1] = a[1]; qr[hh][0] = bb[0]; qr[hh][1] = bb[1]; }
    const int hh_t = tid >> 7, d_t = tid & 127;
    const float* gt = (const float*)(ws + WS_GATESS) + (size_t)tok * 48 + (4 * g + hh_t) * 3;
    const float g_c = gt[0], g_s = gt[1], g_w = gt[2];
    float o_tot = 0.f;
    const f16* Kc = (const f16*)(ws + WS_KCS) + (size_t)(b * 4 + g) * 1024 * 128; const f16* Vc = (const f16*)(ws + WS_VCS) + (size_t)(b * 4 + g) * 1024 * 128;
    for (int n = w; n < 1023; n += 8) {
        const f16x2 k2 = *(const f16x2*)(Kc + (size_t)n * 128 + 2 * lane); const float k0 = (float)k2[0], k1 = (float)k2[1];
        const float r = reduce4(k0 * qn[0][0] + k1 * qn[0][1], k0 * qn[1][0] + k1 * qn[1][1], k0 * qn[2][0] + k1 * qn[2][1], k0 * qn[3][0] + k1 * qn[3][1], lane);
        if ((lane & 15) == 0) sc[(lane >> 4) * 1024 + n] = r;
    }
    __syncthreads();
    softmax4(sc, 1023, tid);
    if (tid < 257) {
        const int j = tid; float imp = 0.f;
        for (int i = 4 * j - 1; i <= 4 * j + 3; ++i) if (i >= 0 && i <= 1022) imp += (sc[i] + sc[1024 + i]) + (sc[2048 + i] + sc[3072 + i]);
        val[j] = (j == 0 || j >= 255) ? 1.0e4f : imp;
    }
    __syncthreads();
    if (tid < 257) {
        const int j = tid; const float v = val[j]; int rank = 0;
        for (int k = 0; k < 257; ++k) { const float vk = val[k]; rank += ((vk > v) || (vk == v && k < j)) ? 1 : 0; }
        if (rank < 16) list[rank] = j;
    }
    { float o = 0.f;
      for (int n = 0; n < 1023; ++n) o += sc[hh_t * 1024 + n] * (float)Vc[(size_t)n * 128 + d_t];
      o_tot += g_c * o; }
    __syncthreads();
    for (int kx = w; kx < 1024; kx += 8) {
        const int blk = list[kx >> 6], kk = kx & 63, kp = 64 * blk + kk;
        float r = -__builtin_inff();
        if (kp <= t) {
            const float* kr = (blk < 256) ? p.in[3] + (((size_t)pt[blk >> 1] * PAGE + (blk & 1) * 64 + kk) * 2) * 512 + g * 128 : p.out + O_SLCS + (size_t)(b * LS + kk) * 1024 + g * 128;
            const f32x2 k2 = *(const f32x2*)(kr + 2 * lane);
            r = reduce4(k2[0] * qr[0][0] + k2[1] * qr[0][1], k2[0] * qr[1][0] + k2[1] * qr[1][1], k2[0] * qr[2][0] + k2[1] * qr[2][1], k2[0] * qr[3][0] + k2[1] * qr[3][1], lane);
        }
        if ((lane & 15) == 0) sc[(lane >> 4) * 1024 + kx] = r;
    }
    __syncthreads();
    softmax4(sc, 1024, tid);
    { float o = 0.f;
      for (int s = 0; s < 16; ++s) { const int blk = list[s];
          const float* vr = (blk < 256) ? p.in[3] + (((size_t)pt[blk >> 1] * PAGE + (blk & 1) * 64) * 2 + 1) * 512 + g * 128 + d_t : p.out + O_SLCS + (size_t)(b * LS) * 1024 + 512 + g * 128 + d_t;
          const int nk = (blk < 256) ? 64 : (ii + 1);
          for (int kk = 0; kk < nk; ++kk) o += sc[hh_t * 1024 + s * 64 + kk] * vr[(size_t)kk * 1024]; }
      o_tot += g_s * o; }
    __syncthreads();
    for (int kx = w; kx < 512; kx += 8) {
        const int pos = t - 511 + kx;
        const float* kr = (pos < PAST) ? p.in[4] + ((size_t)(b * 512 + pos - (PAST - 512)) * 2) * 512 + g * 128 : p.out + O_SWAS + ((size_t)(b * 512 + 508 + pos - PAST)) * 1024 + g * 128;
        const f32x2 k2 = *(const f32x2*)(kr + 2 * lane);
        const float r = reduce4(k2[0] * qr[0][0] + k2[1] * qr[0][1], k2[0] * qr[1][0] + k2[1] * qr[1][1], k2[0] * qr[2][0] + k2[1] * qr[2][1], k2[0] * qr[3][0] + k2[1] * qr[3][1], lane);
        if ((lane & 15) == 0) sc[(lane >> 4) * 1024 + kx] = r;
    }
    __syncthreads();
    softmax4(sc, 512, tid);
    { float o = 0.f;
      for (int kx = 0; kx < 512; ++kx) { const int pos = t - 511 + kx;
          const float* vr = (pos < PAST) ? p.in[4] + ((size_t)(b * 512 + pos - (PAST - 512)) * 2 + 1) * 512 + g * 128 : p.out + O_SWAS + ((size_t)(b * 512 + 508 + pos - PAST)) * 1024 + 512 + g * 128;
          o += sc[hh_t * 1024 + kx] * vr[d_t]; }
      o_tot += g_w * o; }
    ((f16*)(ws + WS_AS1))[(size_t)tok * DM + (4 * g + hh_t) * 128 + d_t] = (f16)o_tot;
    __syncthreads();
}
constexpr int NPHASE = 37;
__host__ __device__ inline bool phase_active(int ph) {
    if (ph == 0) return true;
    const int L = (ph - 1) / 9, s = (ph - 1) % 9;
    if (s == 1) return L <= 2;
    if (s == 2) return L == 2;
    if (s == 3 || s == 4) return L >= 2;
    return true;
}
#define IN(k) (lo <= (k) && (k) < hi)
#define SEAM(k) do { if (use_bar && (k) + 1 < hi) xcd_barrier(bar); } while (0)
template <int L>
__device__ __forceinline__ void layer_phases(const Params& p, LAS unsigned char* lds, const XcdBarrier& bar, const bool use_bar, const int lo, const int hi, const int tid, const int G, const int bx, const int vcu) {
    unsigned char* const ws = p.ws;
    const int lane = tid & 63, wave = tid >> 6;
    const int gw = vcu * 8 + wave, NGW = G * 8;
    constexpr int base = 1 + 9 * L;
    if (IN(base + 0)) {
        if constexpr (L < 2) {
            for (int u = vcu; u < NBP * NG; u += G) s5_prompt_unit(lds, L, u >> 7, u & 127, p, tid);
            for (int u = gw; u < NBS * NG; u += NGW) s5_sample_wave(L, u >> 7, u & 127, p, lane);
        } else {
            constexpr int N = (L == 2) ? (NKV + NQGP) : NQGP; const f16* Wt = (const f16*)(ws + (L == 2 ? WS_WKVQG : WS_WQG1));
            pg8::Gemm g{(const f16*)(ws + WS_A0), Wt, MP, N, DM}; pg8::StaticOrder S; S.init(MP, N, G, bx);
            pg8::EpiProj E{L == 2 ? 12 : 0, p.out, (f16*)(ws + WS_RC), (f16*)(ws + WS_KS), (f16*)(ws + WS_VST), (f16*)(ws + WS_KW), (f16*)(ws + WS_VWT), (f16*)(ws + WS_QN), (f16*)(ws + WS_QR), (float*)(ws + WS_GATES), (const float*)(ws + WS_ROPE)};
            pg8::gemm_phase<pg8::EpiProj, pg8::StaticOrder>(lds, g, S, E, nullptr);
            sgemm_phase<3>(lds, Wt, N, DM, (const f16*)(ws + WS_AS0), p, L, L == 2 ? NKV : 0, vcu, G, tid);
        }
        SEAM(base + 0);
    }
    if constexpr (L <= 2) {
        if (IN(base + 1)) {
            if constexpr (L < 2) {
                const f16* Wt = (const f16*)(ws + WS_WGLU) + (size_t)L * DM * DM;
                pg8::Gemm g{(const f16*)(ws + WS_A1), Wt, MP, DM, DM}; pg8::StaticOrder S; S.init(MP, DM, G, bx);
                pg8::EpiGLU E{(float*)(ws + WS_Y), (const f16*)(ws + WS_A1), p.in[18] + (size_t)L * DM};
                pg8::gemm_phase<pg8::EpiGLU, pg8::StaticOrder>(lds, g, S, E, nullptr);
                sgemm_phase<0>(lds, Wt, DM, DM, (const f16*)(ws + WS_AS1), p, L, 0, vcu, G, tid);
            } else {
                pg8::Gemm g{(const f16*)(ws + WS_RC), (const f16*)(ws + WS_CW1), 272 * 256, 1024, 2048}; pg8::CmpOrder S{G, bx};
                pg8::EpiF32 E{(float*)(ws + WS_PROJ), 512, 1};
                pg8::gemm_phase<pg8::EpiF32, pg8::CmpOrder>(lds, g, S, E, nullptr);
            }
            SEAM(base + 1);
        }
    }
    if constexpr (L == 2) {
        if (IN(base + 2)) {
            for (int u = vcu; u < 544; u += G) cmp2_unit(lds, u, p, tid);
            SEAM(base + 2);
        }
    }
    if constexpr (L >= 2) {
        if (IN(base + 3)) {
            for (int u = vcu; u < 256; u += G) { const int bg = u >> 5, pr = u & 31; attn_prompt_tile(lds, bg >> 2, bg & 3, pr, p, tid); attn_prompt_tile(lds, bg >> 2, bg & 3, 63 - pr, p, tid); }
            for (int u = G - 1 - vcu; u < 128; u += G) attn_sample_unit(lds, u, p, tid);
            SEAM(base + 3);
        }
        if (IN(base + 4)) {
            const f16* Wt = (const f16*)(ws + WS_WO) + (size_t)(L - 2) * DM * DM;
            pg8::Gemm g{(const f16*)(ws + WS_A1), Wt, MP, DM, DM}; pg8::StaticOrder S; S.init(MP, DM, G, bx);
            pg8::EpiF32 E{(float*)(ws + WS_Y), DM, 0x7fffffff};
            pg8::gemm_phase<pg8::EpiF32, pg8::StaticOrder>(lds, g, S, E, nullptr);
            sgemm_phase<2>(lds, Wt, DM, DM, (const f16*)(ws + WS_AS1), p, L, 0, vcu, G, tid);
            SEAM(base + 4);
        }
    }
    if (IN(base + 5)) {
        const float* gpost = (L < 2) ? p.in[19] + (size_t)L * DM : p.in[31] + (size_t)(L - 2) * DM;
        for (int m = gw; m < MP + MS; m += NGW) {
            if (m < MP) resnorm_row((const float*)(ws + WS_Y), gpost, (const float*)(ws + WS_X), (float*)(ws + WS_X), 1, nullptr, (f16*)(ws + WS_A0), nullptr, m, lane);
            else resnorm_row((const float*)(ws + WS_YS), gpost, (const float*)(ws + WS_XS), (float*)(ws + WS_XS), 1, nullptr, (f16*)(ws + WS_AS0), nullptr, m - MP, lane);
        }
        SEAM(base + 5);
    }
    if (IN(base + 6)) {
        const f16* Wt = (const f16*)(ws + WS_WUP) + (size_t)L * DM * FF;
        pg8::Gemm g{(const f16*)(ws + WS_A0), Wt, MP, FF, DM}; pg8::StaticOrder S; S.init(MP, FF, G, bx);
        pg8::EpiRelu2 E{(f16*)(ws + WS_H), FF};
        pg8::gemm_phase<pg8::EpiRelu2, pg8::StaticOrder>(lds, g, S, E, nullptr);
        sgemm_phase<1>(lds, Wt, FF, DM, (const f16*)(ws + WS_AS0), p, L, 0, vcu, G, tid);
        SEAM(base + 6);
    }
    if (IN(base + 7)) {
        const f16* Wt = (const f16*)(ws + WS_WDN) + (size_t)L * DM * FF;
        pg8::Gemm g{(const f16*)(ws + WS_H), Wt, MP, DM, FF}; pg8::StaticOrder S; S.init(MP, DM, G, bx);
        pg8::EpiF32 E{(float*)(ws + WS_Y), DM, 0x7fffffff};
        pg8::gemm_phase<pg8::EpiF32, pg8::StaticOrder>(lds, g, S, E, nullptr);
        sgemm_phase<2>(lds, Wt, DM, FF, (const f16*)(ws + WS_HS), p, L, 0, vcu, G, tid);
        SEAM(base + 7);
    }
    if (IN(base + 8)) {
        const float* gpost = p.in[35] + (size_t)L * DM;
        for (int m = gw; m < MP + MS; m += NGW) {
            if (m < MP) {
                if constexpr (L == 0) resnorm_row((const float*)(ws + WS_Y), gpost, (const float*)(ws + WS_X), (float*)(ws + WS_X), 2, p.in[8] + DM, (f16*)(ws + WS_A0), nullptr, m, lane);
                else if constexpr (L < 3) resnorm_row((const float*)(ws + WS_Y), gpost, (const float*)(ws + WS_X), (float*)(ws + WS_X), 1, nullptr, (f16*)(ws + WS_A0), nullptr, m, lane);
                else resnorm_row((const float*)(ws + WS_Y), gpost, (const float*)(ws + WS_X), p.out + O_YP, 0, nullptr, nullptr, nullptr, m, lane);
            } else {
                if constexpr (L == 0) resnorm_row((const float*)(ws + WS_YS), gpost, (const float*)(ws + WS_XS), (float*)(ws + WS_XS), 3, p.in[8] + DM, nullptr, (float*)(ws + WS_XNS), m - MP, lane);
                else if constexpr (L < 3) resnorm_row((const float*)(ws + WS_YS), gpost, (const float*)(ws + WS_XS), (float*)(ws + WS_XS), 1, nullptr, (f16*)(ws + WS_AS0), nullptr, m - MP, lane);
                else resnorm_row((const float*)(ws + WS_YS), gpost, (const float*)(ws + WS_XS), p.out + O_YS, 0, nullptr, nullptr, nullptr, m - MP, lane);
            }
        }
        SEAM(base + 8);
    }
}
__global__ void __launch_bounds__(512, 2) mk_fwd(Params p) {
    extern __shared__ __attribute__((aligned(16))) unsigned char lds_raw[];
    LAS unsigned char* lds = (LAS unsigned char*)lds_raw;
    const int tid = threadIdx.x;
    const int G = gridDim.x, bx = blockIdx.x, vcu = (G % 8 == 0) ? (bx % 8) * (G / 8) + bx / 8 : bx;
    if (tid < 4) ((LAS unsigned*)(lds + LDS_XB))[tid] = 0u;
    __syncthreads();
    const int lo = p.ph_lo, hi = p.ph_hi;
    const bool use_bar = (hi - lo) > 1;
    XcdBarrier bar; bar.bar = (unsigned*)(p.ws + WS_CTL) + CW_BAR; bar.x = 0; bar.st = (volatile LAS unsigned*)(lds + LDS_XB);
    if (use_bar) bar = xcd_barrier_post((unsigned*)(p.ws + WS_CTL) + CW_BAR, (volatile LAS unsigned*)(lds + LDS_XB));
    if (IN(0)) { ph_prologue(p, lds, vcu, G, tid); SEAM(0); }
    layer_phases<0>(p, lds, bar, use_bar, lo, hi, tid, G, bx, vcu);
    layer_phases<1>(p, lds, bar, use_bar, lo, hi, tid, G, bx, vcu);
    layer_phases<2>(p, lds, bar, use_bar, lo, hi, tid, G, bx, vcu);
    layer_phases<3>(p, lds, bar, use_bar, lo, hi, tid, G, bx, vcu);
}
#undef IN
#undef SEAM

#ifndef MK_MULTI_LAUNCH
#define MK_MULTI_LAUNCH 0
#endif
extern "C" void kernel_launch(void* const* d_in, const int* in_sizes, int n_in, void* d_out, int out_size, void* d_ws, size_t ws_size, hipStream_t stream) {
    static int grid = 0;
    if (grid == 0) {
        if (n_in != 36 || (size_t)out_size != O_END || ws_size < WS_END) { fprintf(stderr, "kernel_launch: unexpected shapes: n_in %d out %d ws %zu (need %zu)\n", n_in, out_size, ws_size, (size_t)WS_END); grid = -1; return; }
        int dev = 0, cus = 0, per_cu = 0;
        if (hipGetDevice(&dev) != hipSuccess || hipDeviceGetAttribute(&cus, hipDeviceAttributeMultiprocessorCount, dev) != hipSuccess) { grid = -1; return; }
        if (hipFuncSetAttribute((const void*)mk_fwd, hipFuncAttributeMaxDynamicSharedMemorySize, LDS_BYTES) != hipSuccess) { fprintf(stderr, "kernel_launch: hipFuncSetAttribute failed\n"); grid = -1; return; }
        if (hipOccupancyMaxActiveBlocksPerMultiprocessor(&per_cu, (const void*)mk_fwd, 512, LDS_BYTES) != hipSuccess || per_cu < 1) fprintf(stderr, "kernel_launch: occupancy query reports %d\n", per_cu);
        (void)hipGetLastError();
        grid = cus;
    }
    if (grid < 0) return;
    (void)hipMemsetAsync((char*)d_ws + WS_CTL, 0, CTL_BYTES, stream);
    Params P{};
    for (int i = 0; i < 36; ++i) P.in[i] = (const float*)d_in[i];
    P.out = (float*)d_out; P.ws = (unsigned char*)d_ws;
    for (int i = 0; i < 16; ++i) P.inv_freq[i] = powf(500000.0f, -(float)i / 16.0f);
#if MK_MULTI_LAUNCH
    for (int ph = 0; ph < NPHASE; ++ph) { if (!phase_active(ph)) continue; P.ph_lo = ph; P.ph_hi = ph + 1; hipLaunchKernelGGL(mk_fwd, dim3(grid), dim3(512), LDS_BYTES, stream, P); }
#else
    P.ph_lo = 0; P.ph_hi = NPHASE;
    hipLaunchKernelGGL(mk_fwd, dim3(grid), dim3(512), LDS_BYTES, stream, P);
#endif
    const hipError_t le = hipPeekAtLastError();
    if (le != hipSuccess) fprintf(stderr, "kernel_launch: launch failed: %s\n", hipGetErrorName(le));
}
```

```cpp
#define SQ0 52
#include <hip/hip_runtime.h>
#include <cstdio>
#include <cmath>

#define LAS __attribute__((address_space(3)))
#define GAS __attribute__((address_space(1)))
typedef _Float16 f16;
typedef f16 f16x8 __attribute__((ext_vector_type(8)));
typedef f16 f16x4 __attribute__((ext_vector_type(4)));
typedef f16 f16x2 __attribute__((ext_vector_type(2)));
typedef float f32x2 __attribute__((ext_vector_type(2)));
typedef float f32x4 __attribute__((ext_vector_type(4)));
typedef float f32x16 __attribute__((ext_vector_type(16)));
typedef unsigned u32x4 __attribute__((ext_vector_type(4)));
typedef unsigned u32x2 __attribute__((ext_vector_type(2)));
#define LDS_WAIT() asm volatile("s_waitcnt lgkmcnt(0)" ::: "memory")
#define VM_WAIT() asm volatile("s_waitcnt vmcnt(0)" ::: "memory")

constexpr int DM = 2048, FF = 8192, SEQ = 4096, NBP = 2, MP = NBP * SEQ;
constexpr int NBS = 8, LS = 4, MS = NBS * LS;
constexpr int PAST = 16384, NPAGES = 128, PAGE = 128;
constexpr int NG = 128, NST = 64;
constexpr int NQG = 2096, NQGP = 2304, NKV = 3072;
constexpr float EPS = 1e-6f;
constexpr float QSCALE = 0.08838834764831845f;
constexpr float LOG2E = 1.4426950408889634f;

constexpr size_t O_YP = 0, O_YS = O_YP + (size_t)MP * DM, O_CMPP = O_YS + (size_t)MS * DM, O_CMPS = O_CMPP + (size_t)MP * 1024,
                 O_SLCP = O_CMPS + (size_t)MS * 1024, O_SLCS = O_SLCP + (size_t)MP * 1024, O_SWAP = O_SLCS + (size_t)MS * 1024,
                 O_SWAS = O_SWAP + (size_t)NBP * 512 * 1024, O_REP = O_SWAS + (size_t)NBS * 512 * 1024, O_IMP = O_REP + 2 * NBP * NG * NST,
                 O_RES = O_IMP + 2 * NBP * NG * NST, O_IMS = O_RES + 2 * NBS * NG * NST, O_END = O_IMS + 2 * NBS * NG * NST;

constexpr size_t al256(size_t x) { return (x + 255) & ~(size_t)255; }
constexpr size_t WS_CTL = 0, CTL_BYTES = 1u << 20;
constexpr size_t WS_WGLU = WS_CTL + CTL_BYTES;
constexpr size_t WS_WUP = WS_WGLU + (size_t)2 * DM * DM * 2;
constexpr size_t WS_WDN = WS_WUP + (size_t)4 * FF * DM * 2;
constexpr size_t WS_WKVQG = WS_WDN + (size_t)4 * FF * DM * 2;
constexpr size_t WS_WQG1 = WS_WKVQG + (size_t)(NKV + NQGP) * DM * 2;
constexpr size_t WS_WO = WS_WQG1 + (size_t)NQGP * DM * 2;
constexpr size_t WS_CW1 = WS_WO + (size_t)2 * DM * DM * 2;
constexpr size_t WS_CW2 = WS_CW1 + (size_t)2 * 512 * 2048 * 2;
constexpr size_t WS_BST = WS_CW2 + (size_t)2 * 128 * 256 * 2;
constexpr size_t WS_CCT = WS_BST + (size_t)2 * NG * 128 * 16 * 2;
constexpr size_t WS_AT = WS_CCT + (size_t)2 * NG * 16 * 128 * 2;
constexpr size_t WS_BBF = WS_AT + (size_t)2 * NG * NST * 2 * 4;
constexpr size_t WS_DT = WS_BBF + (size_t)2 * NG * NST * 32 * 4;
constexpr size_t WS_ROPE = WS_DT + 1024;
constexpr size_t WS_PE = al256(WS_ROPE + (size_t)4100 * 32 * 4);
constexpr size_t WS_X = WS_PE + 2048;
constexpr size_t WS_Y = WS_X + (size_t)MP * DM * 4;
constexpr size_t WS_A0 = WS_Y + (size_t)MP * DM * 4;
constexpr size_t WS_A1 = WS_A0 + (size_t)MP * DM * 2;
constexpr size_t WS_H = WS_A1 + (size_t)MP * DM * 2;
constexpr size_t WS_QN = WS_H + (size_t)MP * FF * 2;
constexpr size_t WS_QR = WS_QN + (size_t)MP * DM * 2;
constexpr size_t WS_GATES = WS_QR + (size_t)MP * DM * 2;
constexpr size_t WS_RC = WS_GATES + (size_t)MP * 48 * 4;
constexpr size_t RC_P_ELEMS = (size_t)2 * 2 * 4 * 4096 * 128, RC_S_ELEMS = (size_t)2 * 8 * 4 * 16384 * 128;
constexpr size_t WS_KS = WS_RC + (RC_P_ELEMS + RC_S_ELEMS) * 2;
constexpr size_t KVB = (size_t)2 * 4 * 4096 * 128 * 2;
constexpr size_t WS_VST = WS_KS + KVB, WS_KW = WS_VST + KVB, WS_VWT = WS_KW + KVB;
constexpr size_t WS_PROJ = WS_VWT + KVB;
constexpr size_t WS_KC = WS_PROJ + (size_t)(4096 + 65536) * 512 * 4;
constexpr size_t WS_VCT = WS_KC + (size_t)8 * 256 * 128 * 2;
constexpr size_t WS_KCS = WS_VCT + (size_t)8 * 256 * 128 * 2;
constexpr size_t WS_VCS = WS_KCS + (size_t)32 * 1024 * 128 * 2;
constexpr size_t WS_XS = WS_VCS + (size_t)32 * 1024 * 128 * 2;
constexpr size_t WS_YS = WS_XS + (size_t)MS * DM * 4;
constexpr size_t WS_XNS = WS_YS + (size_t)MS * DM * 4;
constexpr size_t WS_AS0 = WS_XNS + (size_t)MS * DM * 4;
constexpr size_t WS_AS1 = WS_AS0 + (size_t)MS * DM * 2;
constexpr size_t WS_HS = WS_AS1 + (size_t)MS * DM * 2;
constexpr size_t WS_QNS = WS_HS + (size_t)MS * FF * 2;
constexpr size_t WS_QRS = WS_QNS + (size_t)MS * DM * 4;
constexpr size_t WS_GATESS = WS_QRS + (size_t)MS * DM * 4;
constexpr size_t WS_MI = al256(WS_GATESS + (size_t)MS * 48 * 4);
constexpr size_t WS_W1 = WS_MI + (size_t)2 * NG * 128 * 256 * 2;
constexpr size_t WS_KT = WS_W1 + (size_t)2 * NG * 256 * 128 * 2;
constexpr size_t WS_RS = WS_KT + (size_t)2 * NG * 4096 * 2;
constexpr size_t WS_END = WS_RS + (size_t)MP * 4;
constexpr int CW_BAR = 4096;

constexpr int LDS_BYTES = 155648;
constexpr int LDS_XB = 155632;

struct Params {
    const float* in[36];
    float* out;
    unsigned char* ws;
    float inv_freq[16];
    int ph_lo, ph_hi;
};

#define DPP_F(v, ctrl) __builtin_bit_cast(float, __builtin_amdgcn_update_dpp(__builtin_bit_cast(int, v), __builtin_bit_cast(int, v), ctrl, 0xf, 0xf, false))
__device__ __forceinline__ float wave_sum(float v) {
    v += __builtin_bit_cast(float, __builtin_amdgcn_update_dpp(0, __builtin_bit_cast(int, v), 0x111, 0xf, 0xf, false));
    v += __builtin_bit_cast(float, __builtin_amdgcn_update_dpp(0, __builtin_bit_cast(int, v), 0x112, 0xf, 0xf, false));
    v += __builtin_bit_cast(float, __builtin_amdgcn_update_dpp(0, __builtin_bit_cast(int, v), 0x114, 0xf, 0xf, false));
    v += __builtin_bit_cast(float, __builtin_amdgcn_update_dpp(0, __builtin_bit_cast(int, v), 0x118, 0xf, 0xf, false));
    v += __builtin_bit_cast(float, __builtin_amdgcn_update_dpp(0, __builtin_bit_cast(int, v), 0x142, 0xa, 0xf, false));
    v += __builtin_bit_cast(float, __builtin_amdgcn_update_dpp(0, __builtin_bit_cast(int, v), 0x143, 0xc, 0xf, false));
    return __builtin_bit_cast(float, __builtin_amdgcn_readlane(__builtin_bit_cast(int, v), 63));
}
__device__ __forceinline__ float wave_max(float v) {
    v = fmaxf(v, DPP_F(v, 0x111)); v = fmaxf(v, DPP_F(v, 0x112)); v = fmaxf(v, DPP_F(v, 0x114)); v = fmaxf(v, DPP_F(v, 0x118));
    v = fmaxf(v, __builtin_bit_cast(float, __builtin_amdgcn_update_dpp(__builtin_bit_cast(int, v), __builtin_bit_cast(int, v), 0x142, 0xa, 0xf, false)));
    v = fmaxf(v, __builtin_bit_cast(float, __builtin_amdgcn_update_dpp(__builtin_bit_cast(int, v), __builtin_bit_cast(int, v), 0x143, 0xc, 0xf, false)));
    return __builtin_bit_cast(float, __builtin_amdgcn_readlane(__builtin_bit_cast(int, v), 63));
}
__device__ __forceinline__ float sigmoidf_(float x) { return __builtin_amdgcn_rcpf(1.0f + __expf(-x)); }
__device__ __forceinline__ float gelu_tanh(float y) { const float z = 0.7978845608028654f * (y + 0.044715f * y * y * y); return y * __builtin_amdgcn_rcpf(1.0f + __expf(-2.0f * z)); }

__device__ __forceinline__ f16x4 cvt4(const f32x4 v) { f16x4 r; r[0] = (f16)v[0]; r[1] = (f16)v[1]; r[2] = (f16)v[2]; r[3] = (f16)v[3]; return r; }
#ifndef WT_STORES
#define WT_STORES 0
#endif
struct WtBuf { __amdgpu_buffer_rsrc_t r; unsigned char* base; };
__device__ __forceinline__ WtBuf wt_make(void* base, unsigned nbytes) {
    const unsigned long long u = (unsigned long long)base;
    const unsigned lo = (unsigned)__builtin_amdgcn_readfirstlane((int)(unsigned)u), hi = (unsigned)__builtin_amdgcn_readfirstlane((int)(unsigned)(u >> 32));
    unsigned char* b = (unsigned char*)(((unsigned long long)hi << 32) | lo);
    WtBuf w; w.r = __builtin_amdgcn_make_buffer_rsrc(b, 0, (int)nbytes, 0x00020000); w.base = b; return w;
}
__device__ __forceinline__ void wt_st16(const WtBuf& w, unsigned off, f16x8 v) { if (WT_STORES) __builtin_amdgcn_raw_buffer_store_b128(__builtin_bit_cast(u32x4, v), w.r, (int)off, 0, 16); else *(f16x8*)(w.base + off) = v; }
__device__ __forceinline__ void wt_st8(const WtBuf& w, unsigned off, f16x4 v) { if (WT_STORES) __builtin_amdgcn_raw_buffer_store_b64(__builtin_bit_cast(u32x2, v), w.r, (int)off, 0, 16); else *(f16x4*)(w.base + off) = v; }
#define XB_TMO      128
#define XB_XCNT(j)  (256  + 64 * (j))
#define XB_XSUB(j)  (1280 + 64 * (j))
#define XB_XGEN(j)  (2304 + 64 * (j))
#define XB_TOP      3328
#define XB_TOPGEN   3392
#define XCD_BAR_WORDS 3456
#define XB_SPIN_CAP (1u << 22)
__device__ __forceinline__ unsigned xb_ld(unsigned* p)              { return __hip_atomic_load(p, __ATOMIC_RELAXED, __HIP_MEMORY_SCOPE_AGENT); }
__device__ __forceinline__ unsigned xb_add(unsigned* p, unsigned v) { return __hip_atomic_fetch_add(p, v, __ATOMIC_RELAXED, __HIP_MEMORY_SCOPE_AGENT); }
__device__ __forceinline__ unsigned xb_xcc_id() { return (unsigned)__builtin_amdgcn_s_getreg((3 << 11) | 20) & 0xFu; }
#define XB_SPIN(cond, bar) do { unsigned _sp = 0; while (cond) { __builtin_amdgcn_s_sleep(1); \
    if ((++_sp & 255u) == 0u) { if (xb_ld(&(bar)[XB_TMO])) break; if (_sp > XB_SPIN_CAP) { atomicAdd(&(bar)[XB_TMO], 1u); break; } } } } while (0)
struct XcdBarrier { unsigned* bar; unsigned x; volatile LAS unsigned* st; };
__device__ __forceinline__ XcdBarrier xcd_barrier_post(unsigned* bar, volatile LAS unsigned* st) {
    XcdBarrier b; b.bar = bar; b.x = xb_xcc_id(); b.st = st;
    if (threadIdx.x == 0) (void)xb_add(&bar[XB_XCNT(b.x)], 1u);
    return b;
}
__device__ __forceinline__ void xcd_barrier_complete(unsigned* bar, unsigned x, unsigned& nloc, unsigned& nx) {
    const unsigned G = gridDim.x * gridDim.y * gridDim.z;
    unsigned sum, cnt, mine, sp = 0u;
    for (;;) {
        sum = 0u; cnt = 0u; mine = 0u;
#pragma unroll
        for (unsigned j = 0; j < 16; ++j) { const unsigned c = xb_ld(&bar[XB_XCNT(j)]); sum += c; cnt += (c > 0u) ? 1u : 0u; mine = (j == x) ? c : mine; }
        if (sum == G) break;
        __builtin_amdgcn_s_sleep(1);
        if ((++sp & 255u) == 0u) { if (xb_ld(&bar[XB_TMO])) break; if (sp > XB_SPIN_CAP) { atomicAdd(&bar[XB_TMO], 1u); break; } }
    }
    nloc = mine > 0u ? mine : 1u; nx = cnt > 0u ? cnt : 1u;
}
__device__ __forceinline__ void xcd_barrier(const XcdBarrier& b) {
    asm volatile("s_waitcnt vmcnt(0)" ::: "memory");
    __syncthreads();
    if (threadIdx.x == 0) {
        unsigned* bar = b.bar;
        __builtin_amdgcn_s_waitcnt(0);
        unsigned nloc = b.st[0], nx = b.st[1];
        if (nloc == 0u) { xcd_barrier_complete(bar, b.x, nloc, nx); b.st[0] = nloc; b.st[1] = nx; }
        const unsigned old = xb_add(&bar[XB_XSUB(b.x)], 1u);
        const unsigned gen = old / nloc;
        if (old + 1u == (gen + 1u) * nloc) {
            __builtin_amdgcn_fence(__ATOMIC_RELEASE, "agent");
            asm volatile("s_waitcnt vmcnt(0)" ::: "memory");
            const unsigned og = xb_add(&bar[XB_TOP], 1u);
            const unsigned tg = og / nx;
            if (og + 1u == (tg + 1u) * nx) xb_add(&bar[XB_TOPGEN], 1u);
            else XB_SPIN(xb_ld(&bar[XB_TOPGEN]) == tg, bar);
            __builtin_amdgcn_fence(__ATOMIC_ACQUIRE, "agent");
            xb_add(&bar[XB_XGEN(b.x)], 1u);
            asm volatile("s_waitcnt vmcnt(0)" ::: "memory");
        } else {
            XB_SPIN(xb_ld(&bar[XB_XGEN(b.x)]) == gen, bar);
            __builtin_amdgcn_fence(__ATOMIC_ACQUIRE, "agent");
            asm volatile("s_waitcnt vmcnt(0)" ::: "memory");
        }
    }
    __syncthreads();
}
#ifndef PG8_WGM
#define PG8_WGM 2
#endif
namespace pg8 {
#define PG8_LAS __attribute__((address_space(3)))
typedef f16 bf16_t;
typedef f16x8 bf16x8;
constexpr int BM = 256, BK = 64, HALF = 128, HTB = HALF * BK * 2  , STAGE_BYTES = 8 * HTB, NXCD = 8, WGM = PG8_WGM;

__host__ __device__ __forceinline__ int lds_byte(int r, int c) { const int st = (r >> 4) * 2 + (c >> 5), rr = r & 15, cc = c & 31, ob = rr * 64 + cc * 2; return st * 1024 + (ob ^ (((ob >> 9) & 1) << 5)); }
__host__ __device__ __forceinline__ void stage_rc(int b, int& R, int& C) { const int st = b / 1024, sb = b % 1024, swz = sb ^ (((sb >> 9) & 1) << 5); R = (st >> 1) * 16 + swz / 64; C = (st & 1) * 32 + (swz % 64) / 2; }
__host__ __device__ __forceinline__ int perm32(int rho) { const int n = rho >> 4, i = rho & 15; return 8 * (i >> 2) + 4 * n + (i & 3); }

struct Unit { int pm, pn; };
struct Gemm { const bf16_t* A; const bf16_t* Bt; int M, N, K; };

struct StaticOrder {
    int nM, nN, nwg, G, c;
    __host__ __device__ void init(int M, int N, int G_, int c_) { nM = M / BM; nN = N / BM; nwg = nM * nN; G = G_; c = c_; }
    __host__ __device__ bool next(int i, Unit& u) const {
        const long L = (long)i * G + c; if (L >= nwg) return false;
        int wgid = (int)L; { const int q = nwg / NXCD, r = nwg % NXCD, xcd = wgid % NXCD, off = wgid / NXCD; wgid = (xcd < r ? xcd * (q + 1) : r * (q + 1) + (xcd - r) * q) + off; }
        const int nig = WGM * nN, gid = wgid / nig, fm = gid * WGM, gsz = (nM - fm) < WGM ? (nM - fm) : WGM;
        u.pm = fm + ((wgid % nig) % gsz); u.pn = (wgid % nig) / gsz; return true;
    }
    __device__ __forceinline__ void a_ready(const Unit&) const {}
    __device__ __forceinline__ void done(const Unit&) const {}
};

struct EpiF32 {
    static constexpr bool PERM = false, AFTER_DRAIN = false;
    float* C; int ldc; int pn_mask;
    __device__ __forceinline__ void operator()(const f32x4 (&acc)[2][2][4][2], const Unit& u, int wr, int wc, int fr, int fq) const {
        const int row0 = u.pm * BM + wr * 64 + fr, col0 = (u.pn & pn_mask) * BM + wc * 32 + 4 * fq;
#pragma unroll
        for (int ai = 0; ai < 2; ++ai)
#pragma unroll
            for (int m = 0; m < 4; ++m) { float* rowp = C + (size_t)(row0 + ai * HALF + m * 16) * ldc + col0;
#pragma unroll
                for (int bj = 0; bj < 2; ++bj)
#pragma unroll
                    for (int n = 0; n < 2; ++n) *(f32x4*)(rowp + bj * HALF + n * 16) = acc[ai][bj][m][n]; }
    }
};
struct EpiGLU {
    static constexpr bool PERM = true, AFTER_DRAIN = false;
    f16* C; const f16* Y; const float* bias;
    __device__ __forceinline__ void operator()(const f32x4 (&acc)[2][2][4][2], const Unit& u, int wr, int wc, int fr, int fq) const {
        const int row0 = u.pm * BM + wr * 64 + fr, col0 = u.pn * BM + wc * 32 + 8 * fq;
        const WtBuf wb = wt_make(C, (unsigned)MP * DM * 2);
        f32x4 bv[2][2];
#pragma unroll
        for (int bj = 0; bj < 2; ++bj)
#pragma unroll
            for (int n = 0; n < 2; ++n) bv[bj][n] = *(const f32x4*)(bias + col0 + bj * HALF + 4 * n);
#pragma unroll
        for (int ai = 0; ai < 2; ++ai)
#pragma unroll
            for (int m = 0; m < 4; ++m) { const size_t off = (size_t)(row0 + ai * HALF + m * 16) * DM + col0;
#pragma unroll
                for (int bj = 0; bj < 2; ++bj) { const f16x8 y = *(const f16x8*)(Y + off + bj * HALF); const f32x4 v0 = acc[ai][bj][m][0] + bv[bj][0], v1 = acc[ai][bj][m][1] + bv[bj][1]; f16x8 o;
#pragma unroll
                    for (int i = 0; i < 4; ++i) { o[i] = (f16)((float)y[i] * sigmoidf_(v0[i])); o[4 + i] = (f16)((float)y[4 + i] * sigmoidf_(v1[i])); }
                    wt_st16(wb, (unsigned)((off + bj * HALF) * 2), o); } }
    }
};
struct EpiF16 {
    static constexpr bool PERM = true, AFTER_DRAIN = false;
    f16* O; int ldc; int pn_mask;
    __device__ __forceinline__ void operator()(const f32x4 (&acc)[2][2][4][2], const Unit& u, int wr, int wc, int fr, int fq) const {
        const int row0 = u.pm * BM + wr * 64 + fr, col0 = (u.pn & pn_mask) * BM + wc * 32 + 8 * fq;
        const WtBuf wb = wt_make(O, 0x7ffffff0u);
#pragma unroll
        for (int ai = 0; ai < 2; ++ai)
#pragma unroll
            for (int m = 0; m < 4; ++m) { const unsigned rowb = (unsigned)(((size_t)(row0 + ai * HALF + m * 16) * ldc + col0) * 2);
#pragma unroll
                for (int bj = 0; bj < 2; ++bj) { const f32x4 v0 = acc[ai][bj][m][0], v1 = acc[ai][bj][m][1]; f16x8 w;
#pragma unroll
                    for (int i = 0; i < 4; ++i) { w[i] = (f16)v0[i]; w[4 + i] = (f16)v1[i]; }
                    wt_st16(wb, rowb + bj * HALF * 2, w); } }
    }
};
struct EpiRelu2 {
    static constexpr bool PERM = true, AFTER_DRAIN = false;
    f16* O; int ldc;
    __device__ __forceinline__ void operator()(const f32x4 (&acc)[2][2][4][2], const Unit& u, int wr, int wc, int fr, int fq) const {
        const int row0 = u.pm * BM + wr * 64 + fr, col0 = u.pn * BM + wc * 32 + 8 * fq;
        const WtBuf wb = wt_make(O, 0x7ffffff0u);
#pragma unroll
        for (int ai = 0; ai < 2; ++ai)
#pragma unroll
            for (int m = 0; m < 4; ++m) { const unsigned rowb = (unsigned)(((size_t)(row0 + ai * HALF + m * 16) * ldc + col0) * 2);
#pragma unroll
                for (int bj = 0; bj < 2; ++bj) { const f32x4 v0 = acc[ai][bj][m][0], v1 = acc[ai][bj][m][1]; f16x8 w;
#pragma unroll
                    for (int i = 0; i < 4; ++i) { const float a = fmaxf(v0[i], 0.f), b = fmaxf(v1[i], 0.f); w[i] = (f16)(a * a); w[4 + i] = (f16)(b * b); }
                    wt_st16(wb, rowb + bj * HALF * 2, w); } }
    }
};
struct EpiProj {
    static constexpr bool PERM = false, AFTER_DRAIN = false;
    int nkv; float* out; f16 *RC, *KS, *VST, *KW, *VWT, *QN, *QR; float* GATES; const float* rope;
    __device__ __forceinline__ void operator()(const f32x4 (&acc)[2][2][4][2], const Unit& u, int wr, int wc, int fr, int fq) const {
        const int row0 = u.pm * BM + wr * 64 + fr, d0 = wc * 32 + 4 * fq, d1 = d0 + 16;
#pragma unroll
        for (int bj = 0; bj < 2; ++bj) {
            if (u.pn < nkv) {
                const int hh = 2 * u.pn + bj, br = hh >> 3, kv = (hh >> 2) & 1, g = hh & 3, cbase = kv * 512 + g * 128;
                const bool rot = (br >= 1) && (kv == 0) && (wc == 0);
#pragma unroll
                for (int ai = 0; ai < 2; ++ai)
#pragma unroll
                    for (int m = 0; m < 4; ++m) {
                        const int row = row0 + ai * HALF + m * 16, b = row >> 12, t = row & 4095;
                        f32x4 v0 = acc[ai][bj][m][0], v1 = acc[ai][bj][m][1];
                        if (rot) { const f32x4 cs = *(const f32x4*)(rope + (size_t)t * 32 + 4 * fq), sn = *(const f32x4*)(rope + (size_t)t * 32 + 16 + 4 * fq);
                            const f32x4 n0 = v0 * cs - v1 * sn, n1 = v1 * cs + v0 * sn; v0 = n0; v1 = n1; }
                        const f16x4 h0 = cvt4(v0), h1 = cvt4(v1);
                        if (br == 0) {
                            float* o = out + O_CMPP + (size_t)row * 1024 + cbase; *(f32x4*)(o + d0) = v0; *(f32x4*)(o + d1) = v1;
                            f16* r = RC + ((size_t)(((kv * 2 + b) * 4 + g) * 4096 + t)) * 128; *(f16x4*)(r + d0) = h0; *(f16x4*)(r + d1) = h1;
                        } else {
                            if (br == 1) { float* o = out + O_SLCP + (size_t)row * 1024 + cbase; *(f32x4*)(o + d0) = v0; *(f32x4*)(o + d1) = v1; }
                            else if (t >= SEQ - 512) { float* o = out + O_SWAP + ((size_t)(b * 512 + t - (SEQ - 512))) * 1024 + cbase; *(f32x4*)(o + d0) = v0; *(f32x4*)(o + d1) = v1; }
                            if (kv == 0) { f16* r = (br == 1 ? KS : KW) + ((size_t)((b * 4 + g) * 4096 + t)) * 128; *(f16x4*)(r + d0) = h0; *(f16x4*)(r + d1) = h1; }
                            else { const int tp = (t & 48) | ((t & 4) << 1) | ((t & 8) >> 1) | (t & 3);
                                f16* r = (br == 1 ? VST : VWT) + ((size_t)((b * 4 + g) * 64 + (t >> 6))) * 8192 + tp;
#pragma unroll
                                for (int i = 0; i < 4; ++i) { r[(d0 + i) * 64] = h0[i]; r[(d1 + i) * 64] = h1[i]; } }
                        }
                    }
            } else {
                const int c0 = (u.pn - nkv) * 256 + bj * 128;
                if (c0 < 2048) {
#pragma unroll
                    for (int ai = 0; ai < 2; ++ai)
#pragma unroll
                        for (int m = 0; m < 4; ++m) {
                            const int row = row0 + ai * HALF + m * 16, t = row & 4095;
                            f32x4 v0 = acc[ai][bj][m][0] * (QSCALE * LOG2E), v1 = acc[ai][bj][m][1] * (QSCALE * LOG2E);
                            f16* qn = QN + (size_t)row * DM + c0; *(f16x4*)(qn + d0) = cvt4(v0); *(f16x4*)(qn + d1) = cvt4(v1);
                            if (wc == 0) { const f32x4 cs = *(const f32x4*)(rope + (size_t)t * 32 + 4 * fq), sn = *(const f32x4*)(rope + (size_t)t * 32 + 16 + 4 * fq);
                                const f32x4 n0 = v0 * cs - v1 * sn, n1 = v1 * cs + v0 * sn;
                                f16* qr = QR + (size_t)row * 512 + (c0 >> 7) * 32; *(f16x4*)(qr + d0) = cvt4(n0); *(f16x4*)(qr + d1) = cvt4(n1); }
                        }
                } else if (c0 == 2048) {
#pragma unroll
                    for (int ai = 0; ai < 2; ++ai)
#pragma unroll
                        for (int m = 0; m < 4; ++m) {
                            const int row = row0 + ai * HALF + m * 16;
#pragma unroll
                            for (int n = 0; n < 2; ++n) { const int lc = wc * 32 + 16 * n + 4 * fq;
                                if (lc < 48) { const f32x4 v = acc[ai][bj][m][n]; f32x4 o;
#pragma unroll
                                    for (int i = 0; i < 4; ++i) o[i] = sigmoidf_(v[i]);
                                    *(f32x4*)(GATES + (size_t)row * 48 + lc) = o; } }
                        }
                }
            }
        }
    }
};
struct CmpOrder {
    int G, c, nunits;
    __device__ __forceinline__ bool next(int i, Unit& u) const {
        if (i > 0 && G > 65536) return false;
        const int idx = i * G + c; if (idx >= nunits) return false;
        const int pm = idx >> 1, kv = pm < 16 ? (pm >> 3) : ((pm - 16) >> 7);
        u.pm = pm; u.pn = (idx & 1) + 2 * kv; return true;
    }
    __device__ __forceinline__ void a_ready(const Unit&) const {}
    __device__ __forceinline__ void done(const Unit&) const {}
};

template <class Epi, class Sched, bool ALIGN_EPI = false, bool SP2 = false>
__device__ __forceinline__ void gemm_phase(PG8_LAS unsigned char* lds, const Gemm g, const Sched& S, const Epi& E) {
    const int tid = threadIdx.x, wid = __builtin_amdgcn_readfirstlane(tid >> 6), lane = tid & 63, wr = wid >> 2, wc = wid & 3, fr = lane & 15, fq = lane >> 4;
    const int K = g.K, nt = K / BK;
    unsigned voffA[2], voffB[2];
#pragma unroll
    for (int i = 0; i < 2; ++i) { int R, C; stage_rc(tid * 16 + i * 8192, R, C); const int Rb = Epi::PERM ? ((R & ~31) + perm32(R & 31)) : R;
        voffA[i] = (unsigned)(R * K + C) * 2u; voffB[i] = (unsigned)(Rb * K + C) * 2u; }
    const size_t kstep = (size_t)(BK * 2);
    const size_t hstep = (size_t)HALF * K * 2;
    const size_t tstep = 2 * hstep;
    const unsigned ldsw = (unsigned)wid * 1024u;
    const int aoff = lds_byte(wr * 64 + fr, fq * 8), boff = lds_byte(wc * 32 + fr, fq * 8);
#define PG8_SA(b, h) (((b) * 2 + (h)) * HTB)
#define PG8_SB(b, h) ((4 + (b) * 2 + (h)) * HTB)
#ifndef PG8_AUX
#define PG8_AUX 0
#endif
#define PG8_STAGE(bufoff, gbase, voff) do { _Pragma("unroll") for (int _i = 0; _i < 2; ++_i) \
        __builtin_amdgcn_global_load_lds((const unsigned*)((const char*)(gbase) + (voff)[_i]), (PG8_LAS unsigned*)(lds + (bufoff) + ldsw + _i * 8192), 16, 0, PG8_AUX); } while (0)
#define PG8_LDA(dst, b, h) do { _Pragma("unroll") for (int m = 0; m < 4; ++m) _Pragma("unroll") for (int k = 0; k < 2; ++k) dst[m][k] = *(const PG8_LAS bf16x8*)(lds + PG8_SA(b, h) + aoff + m * 2048 + k * 1024); } while (0)
#define PG8_LDB(dst, b, h) do { _Pragma("unroll") for (int n = 0; n < 2; ++n) _Pragma("unroll") for (int k = 0; k < 2; ++k) dst[n][k] = *(const PG8_LAS bf16x8*)(lds + PG8_SB(b, h) + boff + n * 2048 + k * 1024); } while (0)
#define PG8_MMA(ai, bj, At, Bt) do { __builtin_amdgcn_s_setprio(1); _Pragma("unroll") for (int m = 0; m < 4; ++m) _Pragma("unroll") for (int n = 0; n < 2; ++n) _Pragma("unroll") for (int k = 0; k < 2; ++k) \
        acc[ai][bj][m][n] = __builtin_amdgcn_mfma_f32_16x16x32_f16(Bt[n][k], At[m][k], acc[ai][bj][m][n], 0, 0, 0); __builtin_amdgcn_s_setprio(0); } while (0)
#define PG8_WAIT_V(n) asm volatile("s_waitcnt vmcnt(" #n ")" ::: "memory")
#define PG8_WAIT_L(n) asm volatile("s_waitcnt lgkmcnt(" #n ")" ::: "memory")
#define PG8_BAR __builtin_amdgcn_s_barrier()
#define PG8_SCHED __builtin_amdgcn_sched_barrier(0)
    Unit cur, nxt; int ui = 0;
    if (!S.next(0, cur)) return;
    f32x4 acc[2][2][4][2];
#pragma unroll
    for (int a = 0; a < 2; ++a)
#pragma unroll
        for (int b = 0; b < 2; ++b)
#pragma unroll
            for (int m = 0; m < 4; ++m)
#pragma unroll
                for (int n = 0; n < 2; ++n) acc[a][b][m][n] = (f32x4){0.f, 0.f, 0.f, 0.f};
    bf16x8 At[4][2], B0[2][2], B1[2][2];
    const char* cA = (const char*)g.A + (size_t)cur.pm * tstep; const char* cB = (const char*)g.Bt + (size_t)cur.pn * tstep;
    S.a_ready(cur);
    if constexpr (SP2) {
        PG8_STAGE(PG8_SB(0, 0), cB, voffB); PG8_STAGE(PG8_SB(0, 1), cB + hstep, voffB); PG8_STAGE(PG8_SA(0, 0), cA, voffA); PG8_STAGE(PG8_SA(0, 1), cA + hstep, voffA);
        if (wr == 1) PG8_BAR;
        PG8_WAIT_V(2); PG8_BAR;
        PG8_STAGE(PG8_SB(1, 0), cB + kstep, voffB); PG8_STAGE(PG8_SA(1, 0), cA + kstep, voffA); PG8_STAGE(PG8_SB(1, 1), cB + hstep + kstep, voffB);
        PG8_WAIT_V(6); PG8_BAR;
    } else {
        PG8_STAGE(PG8_SB(0, 0), cB, voffB); PG8_STAGE(PG8_SA(0, 0), cA, voffA); PG8_STAGE(PG8_SB(0, 1), cB + hstep, voffB); PG8_STAGE(PG8_SA(0, 1), cA + hstep, voffA);
        if (wr == 1) PG8_BAR;
        PG8_WAIT_V(4); PG8_BAR;
        PG8_STAGE(PG8_SB(1, 0), cB + kstep, voffB); PG8_STAGE(PG8_SA(1, 0), cA + kstep, voffA); PG8_STAGE(PG8_SB(1, 1), cB + hstep + kstep, voffB);
        PG8_WAIT_V(6); PG8_BAR;
    }
    for (;;) {
        const bool has_next = S.next(ui + 1, nxt);
        const char* nA = has_next ? (const char*)g.A + (size_t)nxt.pm * tstep : cA; const char* nB = has_next ? (const char*)g.Bt + (size_t)nxt.pn * tstep : cB;
        for (int t = 0; t < nt; t += 2) {
            const bool last = (t == nt - 2);
            const char* a1 = cA + (size_t)(t + 1) * kstep;
            const char* a2 = last ? nA : cA + (size_t)(t + 2) * kstep; const char* b2 = last ? nB : cB + (size_t)(t + 2) * kstep;
            const char* a3 = a2 + kstep; const char* b3 = b2 + kstep;
            if (last && has_next) S.a_ready(nxt);
            if constexpr (SP2) {
            PG8_LDB(B0, 0, 0); PG8_LDB(B1, 0, 1); PG8_SCHED; PG8_LDA(At, 0, 0); PG8_STAGE(PG8_SA(1, 1), a1 + hstep, voffA);
            PG8_WAIT_V(8); PG8_WAIT_L(0); PG8_BAR; PG8_MMA(0, 0, At, B0); PG8_MMA(0, 1, At, B1); PG8_BAR; PG8_SCHED;
            PG8_LDA(At, 0, 1); PG8_STAGE(PG8_SB(0, 0), b2, voffB); PG8_STAGE(PG8_SB(0, 1), b2 + hstep, voffB); PG8_STAGE(PG8_SA(0, 0), a2, voffA);
            PG8_WAIT_V(8); PG8_WAIT_L(0); PG8_BAR; PG8_MMA(1, 0, At, B0); PG8_MMA(1, 1, At, B1); PG8_BAR; PG8_SCHED;
            PG8_LDB(B0, 1, 0); PG8_LDB(B1, 1, 1); PG8_SCHED; PG8_LDA(At, 1, 0); PG8_STAGE(PG8_SA(0, 1), a2 + hstep, voffA);
            PG8_WAIT_V(8); PG8_WAIT_L(0); PG8_BAR; PG8_MMA(0, 0, At, B0); PG8_MMA(0, 1, At, B1); PG8_BAR; PG8_SCHED;
            PG8_LDA(At, 1, 1); PG8_STAGE(PG8_SB(1, 0), b3, voffB); PG8_STAGE(PG8_SB(1, 1), b3 + hstep, voffB); PG8_STAGE(PG8_SA(1, 0), a3, voffA);
            PG8_WAIT_V(8); PG8_WAIT_L(0); PG8_BAR; PG8_MMA(1, 0, At, B0); PG8_MMA(1, 1, At, B1); PG8_BAR; PG8_SCHED;
            } else {
            PG8_LDB(B0, 0, 0); PG8_SCHED; PG8_LDA(At, 0, 0); PG8_STAGE(PG8_SA(1, 1), a1 + hstep, voffA);
            PG8_WAIT_L(8); PG8_BAR; PG8_WAIT_L(0); PG8_MMA(0, 0, At, B0); PG8_BAR; PG8_SCHED;
            PG8_LDB(B1, 0, 1); PG8_STAGE(PG8_SB(0, 0), b2, voffB);
            PG8_BAR; PG8_WAIT_L(0); PG8_MMA(0, 1, At, B1); PG8_BAR;
            PG8_LDA(At, 0, 1); PG8_STAGE(PG8_SA(0, 0), a2, voffA);
            PG8_BAR; PG8_WAIT_L(0); PG8_MMA(1, 0, At, B0); PG8_BAR; PG8_SCHED;
            PG8_STAGE(PG8_SB(0, 1), b2 + hstep, voffB);
            PG8_WAIT_V(6); PG8_BAR; PG8_MMA(1, 1, At, B1); PG8_BAR;
            PG8_LDB(B0, 1, 0); PG8_SCHED; PG8_LDA(At, 1, 0); PG8_STAGE(PG8_SA(0, 1), a2 + hstep, voffA);
            PG8_WAIT_L(8); PG8_BAR; PG8_WAIT_L(0); PG8_MMA(0, 0, At, B0); PG8_BAR; PG8_SCHED;
            PG8_LDB(B1, 1, 1); PG8_STAGE(PG8_SB(1, 0), b3, voffB);
            PG8_BAR; PG8_WAIT_L(0); PG8_MMA(0, 1, At, B1); PG8_BAR;
            PG8_LDA(At, 1, 1); PG8_STAGE(PG8_SA(1, 0), a3, voffA);
            PG8_BAR; PG8_WAIT_L(0); PG8_MMA(1, 0, At, B0); PG8_BAR; PG8_SCHED;
            PG8_STAGE(PG8_SB(1, 1), b3 + hstep, voffB);
            PG8_WAIT_V(6); PG8_BAR; PG8_MMA(1, 1, At, B1); PG8_BAR;
            }
        }
        if constexpr (ALIGN_EPI) { if (wr == 0) PG8_BAR; }
        if constexpr (!Epi::AFTER_DRAIN) { E(acc, cur, wr, wc, fr, fq); S.done(cur); }
        if (!has_next) break;
#pragma unroll
        for (int a = 0; a < 2; ++a)
#pragma unroll
            for (int b = 0; b < 2; ++b)
#pragma unroll
                for (int m = 0; m < 4; ++m)
#pragma unroll
                    for (int n = 0; n < 2; ++n) acc[a][b][m][n] = (f32x4){0.f, 0.f, 0.f, 0.f};
        cur = nxt; cA = nA; cB = nB; ++ui;
        if constexpr (ALIGN_EPI) { if (wr == 1) PG8_BAR; }
    }
    PG8_WAIT_V(0);
    if constexpr (!ALIGN_EPI) { if (wr == 0) PG8_BAR; }
    PG8_BAR;
    if constexpr (Epi::AFTER_DRAIN) { E.fused(acc, cur, wr, wc, fr, fq, lds, wid, lane); S.done(cur); }
#undef PG8_SA
#undef PG8_SB
#undef PG8_STAGE
#undef PG8_LDA
#undef PG8_LDB
#undef PG8_MMA
#undef PG8_WAIT_V
#undef PG8_WAIT_L
#undef PG8_BAR
#undef PG8_SCHED
}
}
struct TDesc { const float* W; f16* WT; const float* gain; int K, N, Npad, row_off, item; };
__device__ __forceinline__ void t_load(const TDesc& d, f32x4 (&v)[16], int lane) {
    const int nblk = d.Npad / 64, kb = d.item / nblk, nb = d.item % nblk, k0 = 64 * kb, n0 = 64 * nb;
    const int c4 = lane & 15, kr = lane >> 4, n = n0 + 4 * c4;
#pragma unroll
    for (int i = 0; i < 16; ++i) v[i] = (n < d.N) ? *(const f32x4*)(d.W + (size_t)(k0 + 4 * i + kr) * d.N + n) : (f32x4){0.f, 0.f, 0.f, 0.f};
}
__device__ __forceinline__ void t_process(const TDesc& d, f32x4 (&v)[16], LAS float* scr, int lane) {
    const int nblk = d.Npad / 64, kb = d.item / nblk, nb = d.item % nblk, k0 = 64 * kb, n0 = 64 * nb;
    const int c4 = lane & 15, kr = lane >> 4;
    if (d.gain) {
#pragma unroll
        for (int i = 0; i < 16; ++i) v[i] = v[i] * d.gain[k0 + 4 * i + kr];
    }
#pragma unroll
    for (int i = 0; i < 16; ++i) { LAS float* q = scr + (4 * i + kr) * 65 + 4 * c4; q[0] = v[i][0]; q[1] = v[i][1]; q[2] = v[i][2]; q[3] = v[i][3]; }
    LDS_WAIT();
#pragma unroll
    for (int j = 0; j < 8; ++j) { const int pr = lane + 64 * j, c = pr & 7, nn = pr >> 3; const LAS float* s = scr + (8 * c) * 65 + nn; f16x8 o;
#pragma unroll
        for (int e = 0; e < 8; ++e) o[e] = (f16)s[e * 65];
        *(f16x8*)(d.WT + (size_t)(d.row_off + n0 + nn) * d.K + k0 + 8 * c) = o; }
    LDS_WAIT();
}
__device__ __forceinline__ void sincos_d(double x, double& s, double& c) {
    const double twopi = 6.283185307179586476925287, inv = 0.15915494309189533576888;
    const double k = rint(x * inv); double r = fma(-k, twopi, x); r = fma(-k, -2.4492935982947064e-16, r);
    const double r2 = r * r; double ts = 1.0, tc = 1.0;
#pragma unroll
    for (int i = 27; i >= 3; i -= 2) ts = 1.0 - ts * r2 / (double)(i * (i - 1));
#pragma unroll
    for (int i = 26; i >= 2; i -= 2) tc = 1.0 - tc * r2 / (double)(i * (i - 1));
    s = r * ts; c = tc;
}
__device__ __forceinline__ void resnorm_row(const float* y, const float* gpost, const float* xin, float* xout, int mode, const float* gnext, f16* o16, float* o32, int row, int lane_in) {
    int lane = lane_in; asm volatile("" : "+v"(lane));
    f32x4 v[8];
    const f32x4* xr = (const f32x4*)(xin + (size_t)row * DM) + lane;
#pragma unroll
    for (int j = 0; j < 8; ++j) v[j] = xr[64 * j];
    if (y) {
        const f32x4* yr = (const f32x4*)(y + (size_t)row * DM) + lane; f32x4 w[8]; float s = 0.f;
#pragma unroll
        for (int j = 0; j < 8; ++j) { w[j] = yr[64 * j]; s += (w[j][0] * w[j][0] + w[j][1] * w[j][1]) + (w[j][2] * w[j][2] + w[j][3] * w[j][3]); }
        const float r1 = 1.0f / sqrtf(wave_sum(s) * (1.0f / DM) + EPS);
#pragma unroll
        for (int j = 0; j < 8; ++j) { const f32x4 gp = *((const f32x4*)gpost + lane + 64 * j); v[j] = v[j] + w[j] * r1 * gp; }
    }
    if (xout) { f32x4* xo = (f32x4*)(xout + (size_t)row * DM) + lane;
#pragma unroll
        for (int j = 0; j < 8; ++j) xo[64 * j] = v[j]; }
    if (mode == 0) return;
    float s2 = 0.f;
#pragma unroll
    for (int j = 0; j < 8; ++j) s2 += (v[j][0] * v[j][0] + v[j][1] * v[j][1]) + (v[j][2] * v[j][2] + v[j][3] * v[j][3]);
    const float r2 = 1.0f / sqrtf(wave_sum(s2) * (1.0f / DM) + EPS);
    if (mode == 1) {
#pragma unroll
        for (int j = 0; j < 8; ++j) *((f16x4*)(o16 + (size_t)row * DM) + lane + 64 * j) = cvt4(v[j] * r2);
    } else if (mode == 2) {
        const int b = row >> 12, t = row & 4095;
#pragma unroll
        for (int j = 0; j < 8; ++j) { const int col = 4 * lane + 256 * j; const f32x4 gn = *((const f32x4*)gnext + lane + 64 * j);
            *(f16x4*)(o16 + ((size_t)((b * NG + (col >> 4)) * SEQ + t)) * 16 + (col & 15)) = cvt4(v[j] * r2 * gn); }
    } else {
#pragma unroll
        for (int j = 0; j < 8; ++j) { const f32x4 gn = *((const f32x4*)gnext + lane + 64 * j); *((f32x4*)(o32 + (size_t)row * DM) + lane + 64 * j) = v[j] * r2 * gn; }
    }
}

__device__ __forceinline__ void resnorm_rows(const f16* y, const float* gpost, const float* xin, float* xout, int mode, const float* gnext, f16* o16, int first, int stride, int nrows, int lane_in) {
    int lane = lane_in; asm volatile("" : "+v"(lane));
    if (first >= nrows) return;
    f32x4 xv[8], yv[8], xn[8]; f16x4 yn[8];
    { const f32x4* xr = (const f32x4*)(xin + (size_t)first * DM) + lane; const f16x4* yr = (const f16x4*)(y + (size_t)first * DM) + lane;
#pragma unroll
      for (int j = 0; j < 8; ++j) { xn[j] = xr[64 * j]; yn[j] = yr[64 * j]; } }
    for (int row = first; row < nrows; row += stride) {
#pragma unroll
        for (int j = 0; j < 8; ++j) { xv[j] = xn[j]; yv[j] = (f32x4){(float)yn[j][0], (float)yn[j][1], (float)yn[j][2], (float)yn[j][3]}; }
        if (row + stride < nrows) { const f32x4* xr = (const f32x4*)(xin + (size_t)(row + stride) * DM) + lane; const f16x4* yr = (const f16x4*)(y + (size_t)(row + stride) * DM) + lane;
#pragma unroll
            for (int j = 0; j < 8; ++j) { xn[j] = xr[64 * j]; yn[j] = yr[64 * j]; } }
        float s = 0.f;
#pragma unroll
        for (int j = 0; j < 8; ++j) s += (yv[j][0] * yv[j][0] + yv[j][1] * yv[j][1]) + (yv[j][2] * yv[j][2] + yv[j][3] * yv[j][3]);
        const float r1 = 1.0f / sqrtf(wave_sum(s) * (1.0f / DM) + EPS);
#pragma unroll
        for (int j = 0; j < 8; ++j) { const f32x4 gp = *((const f32x4*)gpost + lane + 64 * j); xv[j] = xv[j] + yv[j] * r1 * gp; }
        f32x4* xo = (f32x4*)(xout + (size_t)row * DM) + lane;
#pragma unroll
        for (int j = 0; j < 8; ++j) xo[64 * j] = xv[j];
        if (mode == 0) continue;
        float s2 = 0.f;
#pragma unroll
        for (int j = 0; j < 8; ++j) s2 += (xv[j][0] * xv[j][0] + xv[j][1] * xv[j][1]) + (xv[j][2] * xv[j][2] + xv[j][3] * xv[j][3]);
        const float r2 = 1.0f / sqrtf(wave_sum(s2) * (1.0f / DM) + EPS);
        if (mode == 1) {
#pragma unroll
            for (int j = 0; j < 8; ++j) *((f16x4*)(o16 + (size_t)row * DM) + lane + 64 * j) = cvt4(xv[j] * r2);
        } else {
            const int b = row >> 12, t = row & 4095;
#pragma unroll
            for (int j = 0; j < 8; ++j) { const int col = 4 * lane + 256 * j; const f32x4 gn = *((const f32x4*)gnext + lane + 64 * j);
                *(f16x4*)(o16 + ((size_t)((b * NG + (col >> 4)) * SEQ + t)) * 16 + (col & 15)) = cvt4(xv[j] * r2 * gn); }
        }
    }
}

template <bool SRC_F32, int OUT>
__device__ __forceinline__ void resnorm2_rows(const f16* y, const float* gpost, const float* xin32, f16* XN, float* RS, float* out32, const float* gnext, f16* XG, int first, int stride, int nrows, int lane_in) {
    int lane = lane_in; asm volatile("" : "+v"(lane));
    if (first >= nrows) return;
    f32x4 xv[8], yv[8], xn32[8]; f16x4 xn16[8], yn[8]; float sn = 1.f;
    {   const f16x4* yr = (const f16x4*)(y + (size_t)first * DM) + lane;
#pragma unroll
        for (int j = 0; j < 8; ++j) yn[j] = yr[64 * j];
        if (SRC_F32) { const f32x4* xr = (const f32x4*)(xin32 + (size_t)first * DM) + lane;
#pragma unroll
            for (int j = 0; j < 8; ++j) xn32[j] = xr[64 * j]; }
        else { const f16x4* xr = (const f16x4*)(XN + (size_t)first * DM) + lane; sn = RS[first];
#pragma unroll
            for (int j = 0; j < 8; ++j) xn16[j] = xr[64 * j]; } }
    for (int row = first; row < nrows; row += stride) {
#pragma unroll
        for (int j = 0; j < 8; ++j) { yv[j] = (f32x4){(float)yn[j][0], (float)yn[j][1], (float)yn[j][2], (float)yn[j][3]};
            if (SRC_F32) xv[j] = xn32[j]; else xv[j] = (f32x4){(float)xn16[j][0], (float)xn16[j][1], (float)xn16[j][2], (float)xn16[j][3]} * sn; }
        if (row + stride < nrows) { const int nr = row + stride; const f16x4* yr = (const f16x4*)(y + (size_t)nr * DM) + lane;
#pragma unroll
            for (int j = 0; j < 8; ++j) yn[j] = yr[64 * j];
            if (SRC_F32) { const f32x4* xr = (const f32x4*)(xin32 + (size_t)nr * DM) + lane;
#pragma unroll
                for (int j = 0; j < 8; ++j) xn32[j] = xr[64 * j]; }
            else { const f16x4* xr = (const f16x4*)(XN + (size_t)nr * DM) + lane; sn = RS[nr];
#pragma unroll
                for (int j = 0; j < 8; ++j) xn16[j] = xr[64 * j]; } }
        float s = 0.f;
#pragma unroll
        for (int j = 0; j < 8; ++j) s += (yv[j][0] * yv[j][0] + yv[j][1] * yv[j][1]) + (yv[j][2] * yv[j][2] + yv[j][3] * yv[j][3]);
        const float r1 = 1.0f / sqrtf(wave_sum(s) * (1.0f / DM) + EPS);
#pragma unroll
        for (int j = 0; j < 8; ++j) { const f32x4 gp = *((const f32x4*)gpost + lane + 64 * j); xv[j] = xv[j] + yv[j] * r1 * gp; }
        if (OUT == 0) { f32x4* xo = (f32x4*)(out32 + (size_t)row * DM) + lane;
#pragma unroll
            for (int j = 0; j < 8; ++j) xo[64 * j] = xv[j];
            continue; }
        float s2 = 0.f;
#pragma unroll
        for (int j = 0; j < 8; ++j) s2 += (xv[j][0] * xv[j][0] + xv[j][1] * xv[j][1]) + (xv[j][2] * xv[j][2] + xv[j][3] * xv[j][3]);
        const float ms = wave_sum(s2) * (1.0f / DM) + EPS, r2 = 1.0f / sqrtf(ms);
#pragma unroll
        for (int j = 0; j < 8; ++j) *((f16x4*)(XN + (size_t)row * DM) + lane + 64 * j) = cvt4(xv[j] * r2);
        if (lane == 0) RS[row] = sqrtf(ms);
        if (OUT == 2) {
            const int b = row >> 12, t = row & 4095;
#pragma unroll
            for (int j = 0; j < 8; ++j) { const int col = 4 * lane + 256 * j; const f32x4 gn = *((const f32x4*)gnext + lane + 64 * j);
                *(f16x4*)(XG + ((size_t)((b * NG + (col >> 4)) * SEQ + t)) * 16 + (col & 15)) = cvt4(xv[j] * r2 * gn); }
        }
    }
}
__device__ __forceinline__ void ph_prologue(const Params& p, LAS unsigned char* lds, int vcu, int G, int tid_in) {
    int tid = tid_in; asm volatile("" : "+v"(tid));
    const int lane = tid & 63, wave = __builtin_amdgcn_readfirstlane(tid >> 6), gw = vcu * 8 + wave, NGW = G * 8;
    unsigned char* ws = p.ws;
    LAS float* scr = (LAS float*)(lds + wave * 16640);
    {
        constexpr int I_GLU = 32 * 32, I_UP = 32 * 128, I_DN = 128 * 32, I_KV = 32 * 48, I_QG = 32 * 36, I_WO = 32 * 32, I_C1 = 32 * 4, I_C2 = 4 * 2;
        constexpr int NIT = 2 * I_GLU + 4 * I_UP + 4 * I_DN + I_KV + 2 * I_QG + 2 * I_WO + 4 * I_C1 + 2 * I_C2;
        auto desc = [&](int it) -> TDesc {
            int r = it;
            if (r < 2 * I_GLU) { const int l = r / I_GLU; return TDesc{p.in[17] + (size_t)l * DM * DM, (f16*)(ws + WS_WGLU) + (size_t)l * DM * DM, nullptr, DM, DM, DM, 0, r % I_GLU}; } r -= 2 * I_GLU;
            if (r < 4 * I_UP) { const int l = r / I_UP; return TDesc{p.in[33] + (size_t)l * DM * FF, (f16*)(ws + WS_WUP) + (size_t)l * DM * FF, p.in[32] + l * DM, DM, FF, FF, 0, r % I_UP}; } r -= 4 * I_UP;
            if (r < 4 * I_DN) { const int l = r / I_DN; return TDesc{p.in[34] + (size_t)l * DM * FF, (f16*)(ws + WS_WDN) + (size_t)l * DM * FF, nullptr, FF, DM, DM, 0, r % I_DN}; } r -= 4 * I_DN;
            if (r < I_KV) return TDesc{p.in[21], (f16*)(ws + WS_WKVQG), p.in[20], DM, NKV, NKV, 0, r}; r -= I_KV;
            if (r < I_QG) return TDesc{p.in[29], (f16*)(ws + WS_WKVQG), p.in[28], DM, NQG, NQGP, NKV, r}; r -= I_QG;
            if (r < I_QG) return TDesc{p.in[29] + (size_t)DM * NQG, (f16*)(ws + WS_WQG1), p.in[28] + DM, DM, NQG, NQGP, 0, r}; r -= I_QG;
            if (r < 2 * I_WO) { const int l = r / I_WO; return TDesc{p.in[30] + (size_t)l * DM * DM, (f16*)(ws + WS_WO) + (size_t)l * DM * DM, nullptr, DM, DM, DM, 0, r % I_WO}; } r -= 2 * I_WO;
            if (r < 4 * I_C1) { const int q = r / I_C1, kv = q >> 1, j = q & 1; return TDesc{p.in[kv ? 25 : 22] + (size_t)j * 2048 * 256, (f16*)(ws + WS_CW1) + (size_t)kv * 512 * 2048, nullptr, 2048, 256, 256, j * 256, r % I_C1}; } r -= 4 * I_C1;
            { const int kv = r / I_C2; return TDesc{p.in[kv ? 27 : 24], (f16*)(ws + WS_CW2) + (size_t)kv * 128 * 256, nullptr, 256, 128, 128, 0, r % I_C2}; }
        };
        int it = gw;
        if (it < NIT) {
            f32x4 va[16], vb[16];
            TDesc d0 = desc(it), d1 = d0;
            t_load(d0, va, lane);
            for (;;) {
                const int it1 = it + NGW; const bool has1 = it1 < NIT;
                if (has1) { d1 = desc(it1); t_load(d1, vb, lane); }
                t_process(d0, va, scr, lane);
                if (!has1) break;
                const int it2 = it1 + NGW; const bool has2 = it2 < NIT;
                if (has2) { d0 = desc(it2); t_load(d0, va, lane); }
                t_process(d1, vb, scr, lane);
                if (!has2) break;
                it = it2;
            }
        }
    }
    const int gt = vcu * 512 + tid, NGT = G * 512;
    if (wave == 0) {
        LAS float* sw = (LAS float*)lds;
        for (int lg = vcu; lg < 2 * NG; lg += G) {
            const int l = lg / NG, g = lg % NG, pp = lane, it = lg * NST + pp;
            const double dt = exp((double)p.in[11][lg]);
            const double lr = (double)p.in[9][it], li = (double)p.in[10][it];
            const double mag = exp(lr * dt); double sn, cs; sincos_d(li * dt, sn, cs);
            const double are = mag * cs, aim = mag * sn, den = lr * lr + li * li, nr0 = are - 1.0;
            const double fre = (nr0 * lr + aim * li) / den, fim = (aim * lr - nr0 * li) / den;
            float* AT = (float*)(ws + WS_AT); AT[2 * it] = (float)are; AT[2 * it + 1] = (float)aim;
            if (pp == 0) ((float*)(ws + WS_DT))[lg] = (float)dt;
            const float* bre = p.in[12] + (size_t)it * 16; const float* bim = p.in[13] + (size_t)it * 16;
            float* BBF = (float*)(ws + WS_BBF) + (size_t)it * 32;
            f16* BST = (f16*)(ws + WS_BST) + (size_t)lg * 128 * 16;
            const double idt = 1.0 / dt;
            float xr[16], xi[16];
#pragma unroll
            for (int i = 0; i < 16; ++i) { const double br = bre[i], bi = bim[i]; const double vr = fre * br - fim * bi, vi = fre * bi + fim * br;
                BBF[i] = (float)vr; BBF[16 + i] = (float)vi; xr[i] = (float)(vr * idt); xi[i] = (float)(vi * idt); BST[pp * 16 + i] = (f16)xr[i]; BST[(64 + pp) * 16 + i] = (f16)xi[i]; }
            sw[pp * 36] = (float)are; sw[pp * 36 + 1] = (float)aim;
#pragma unroll
            for (int i = 0; i < 16; ++i) { sw[pp * 36 + 4 + i] = xr[i]; sw[pp * 36 + 20 + i] = xi[i]; }
            const float* cre = p.in[14] + (size_t)lg * 16 * 64; const float* cim = p.in[15] + (size_t)lg * 16 * 64;
            {
              f16* MI = (f16*)(ws + WS_MI) + (size_t)lg * 128 * 256;
              double pre = 1.0, pim = 0.0;
              for (int t = 15; t >= 0; --t) {
                  const float fr_ = (float)pre, fi_ = (float)pim; f16x8 r0, r1, i0, i1;
#pragma unroll
                  for (int i = 0; i < 8; ++i) { r0[i] = (f16)(fr_ * xr[i] - fi_ * xi[i]); r1[i] = (f16)(fr_ * xr[8 + i] - fi_ * xi[8 + i]); i0[i] = (f16)(fr_ * xi[i] + fi_ * xr[i]); i1[i] = (f16)(fr_ * xi[8 + i] + fi_ * xr[8 + i]); }
                  *(f16x8*)(MI + (size_t)pp * 256 + t * 16) = r0; *(f16x8*)(MI + (size_t)pp * 256 + t * 16 + 8) = r1;
                  *(f16x8*)(MI + (size_t)(64 + pp) * 256 + t * 16) = i0; *(f16x8*)(MI + (size_t)(64 + pp) * 256 + t * 16 + 8) = i1;
                  const double nr = pre * are - pim * aim, ni = pre * aim + pim * are; pre = nr; pim = ni;
              } }
            {
              f16* W1 = (f16*)(ws + WS_W1) + (size_t)lg * 256 * 128;
              float cr[16], ci[16];
#pragma unroll
              for (int j = 0; j < 16; ++j) { cr[j] = cre[j * 64 + pp]; ci[j] = cim[j * 64 + pp]; }
              double pre = are, pim = aim;
              for (int t = 0; t < 16; ++t) {
                  const float Ar = (float)pre, Ai = (float)pim;
#pragma unroll
                  for (int j = 0; j < 16; ++j) { W1[(size_t)(t * 16 + j) * 128 + pp] = (f16)(cr[j] * Ar - ci[j] * Ai); W1[(size_t)(t * 16 + j) * 128 + 64 + pp] = (f16)(-cr[j] * Ai - ci[j] * Ar); }
                  const double nr = pre * are - pim * aim, ni = pre * aim + pim * are; pre = nr; pim = ni;
              }
              f16* CCT = (f16*)(ws + WS_CCT) + (size_t)lg * 16 * 128;
#pragma unroll
              for (int j = 0; j < 16; ++j) { CCT[j * 128 + pp] = (f16)cr[j]; CCT[j * 128 + 64 + pp] = (f16)(-ci[j]); } }
            LDS_WAIT();
            {
              const int j = lane >> 2, ib = (lane & 3) * 4;
              float acc[4][16];
#pragma unroll
              for (int e = 0; e < 4; ++e)
#pragma unroll
                  for (int tau = 0; tau < 16; ++tau) acc[e][tau] = 0.f;
              for (int p2 = 0; p2 < 64; ++p2) {
                  const float a2r = sw[p2 * 36], a2i = sw[p2 * 36 + 1], c2r = cre[j * 64 + p2], c2i = cim[j * 64 + p2];
#pragma unroll
                  for (int e = 0; e < 4; ++e) { float wr = sw[p2 * 36 + 4 + ib + e], wi = sw[p2 * 36 + 20 + ib + e];
#pragma unroll
                      for (int tau = 0; tau < 16; ++tau) { acc[e][tau] += c2r * wr - c2i * wi; const float nr = wr * a2r - wi * a2i; wi = wr * a2i + wi * a2r; wr = nr; } }
              }
              f16* KT = (f16*)(ws + WS_KT) + (size_t)lg * 4096;
#pragma unroll
              for (int tau = 0; tau < 16; ++tau) { f16x4 o; o[0] = (f16)acc[0][tau]; o[1] = (f16)acc[1][tau]; o[2] = (f16)acc[2][tau]; o[3] = (f16)acc[3][tau]; *(f16x4*)(KT + tau * 256 + j * 16 + ib) = o; } }
            LDS_WAIT();
        }
    }
    for (int it = gt; it < 4100 * 16; it += NGT) {
        const int pi = it >> 4, f = it & 15; const int pos = pi < 4096 ? pi : PAST + (pi - 4096);
        const float ang = (float)pos * p.inv_freq[f]; double sn, cs; sincos_d((double)ang, sn, cs);
        float* R = (float*)(ws + WS_ROPE) + (size_t)pi * 32; R[f] = (float)cs; R[16 + f] = (float)sn;
    }
    for (int it = gw; it < 512; it += NGW) {
        const int kv = it >> 8, h = it & 255; const float* pe = p.in[kv ? 26 : 23]; const float* w1 = p.in[kv ? 25 : 22];
        float s = 0.f;
        for (int i = lane; i < 4096; i += 64) s += pe[i] * w1[(size_t)i * 256 + h];
        s = wave_sum(s);
        if (lane == 0) ((float*)(ws + WS_PE))[it] = s;
    }
    {
        f16* RCS = (f16*)(ws + WS_RC) + RC_P_ELEMS; const int* pt = (const int*)p.in[7];
        for (int ch = gw; ch < NBS * NPAGES * 2; ch += NGW) {
            const int b = ch >> 8, pg = (ch >> 1) & 127, hf = ch & 1; const int page = pt[b * NPAGES + pg];
            const float* srcb = p.in[2] + ((size_t)page * PAGE + hf * 64) * 1024; const int pos0 = pg * PAGE + hf * 64;
            for (int r = 0; r < 64; r += 2) {
                f32x4 v[2][4];
#pragma unroll
                for (int u = 0; u < 2; ++u)
#pragma unroll
                    for (int j = 0; j < 4; ++j) v[u][j] = *((const f32x4*)(srcb + (size_t)(r + u) * 1024) + lane + 64 * j);
#pragma unroll
                for (int u = 0; u < 2; ++u)
#pragma unroll
                    for (int j = 0; j < 4; ++j) { const int e = 4 * lane + 256 * j, kv = e >> 9, g = (e >> 7) & 3, d = e & 127;
                        *(f16x4*)(RCS + ((size_t)(((kv * 8 + b) * 4 + g)) * PAST + pos0 + r + u) * 128 + d) = cvt4(v[u][j]); }
            }
        }
    }
    for (int it = gw; it < NBS * 508; it += NGW) {
        const int b = it / 508, r = it % 508;
        const f32x4* src = (const f32x4*)(p.in[4] + ((size_t)(b * 512 + r + 4)) * 1024) + lane; f32x4* dst = (f32x4*)(p.out + O_SWAS + ((size_t)(b * 512 + r)) * 1024) + lane;
#pragma unroll
        for (int j = 0; j < 4; ++j) dst[64 * j] = src[64 * j];
    }
    for (int m = gw; m < MP + MS; m += NGW) {
        if (m < MP) resnorm_row(nullptr, nullptr, p.in[0], nullptr, 2, p.in[8], (f16*)(ws + WS_A0), nullptr, m, lane);
        else resnorm_row(nullptr, nullptr, p.in[1], nullptr, 3, p.in[8], nullptr, (float*)(ws + WS_XNS), m - MP, lane);
    }
}
__device__ __forceinline__ void s5_prompt_unit(LAS unsigned char* lds, int l, int b, int g, const Params& p, int tid_in) {
    int tid = tid_in; asm volatile("" : "+v"(tid));
    const int lane = tid & 63, w = __builtin_amdgcn_readfirstlane(tid >> 6), fr = lane & 15, q = lane >> 4;
    unsigned char* ws = p.ws;
    const f16* xg = (const f16*)(ws + WS_A0) + ((size_t)(b * NG + g) * SEQ) * 16;
    const f16* BST = (const f16*)(ws + WS_BST) + (size_t)(l * NG + g) * 128 * 16;
    const f16* CCT = (const f16*)(ws + WS_CCT) + (size_t)(l * NG + g) * 16 * 128;
    const f16x8 z8 = {0, 0, 0, 0, 0, 0, 0, 0};
    f16x8 Bs[8], Cc[4];
#pragma unroll
    for (int nt = 0; nt < 8; ++nt) Bs[nt] = (q < 2) ? *(const f16x8*)(BST + (nt * 16 + fr) * 16 + 8 * q) : z8;
#pragma unroll
    for (int s = 0; s < 4; ++s) Cc[s] = *(const f16x8*)(CCT + fr * 128 + 32 * s + 8 * q);
    const float* AT = (const float*)(ws + WS_AT) + (size_t)((l * NG + g) * NST + lane) * 2;
    const float ar = AT[0], ai = AT[1];
    const float dt = ((const float*)(ws + WS_DT))[l * NG + g];
    const f32x4 dsk = *(const f32x4*)(p.in[16] + (size_t)l * DM + g * 16 + 4 * q);
    float hr = 0.f, hi = 0.f;
    const f32x4 z4 = {0.f, 0.f, 0.f, 0.f};
    float p16r = ar, p16i = ai;
#pragma unroll
    for (int i = 0; i < 4; ++i) { const float nr = p16r * p16r - p16i * p16i, ni = 2.f * p16r * p16i; p16r = nr; p16i = ni; }
    float h0r[32], h0i[32];
    {
        LAS f16* mi = (LAS f16*)(lds + 72704);
        LAS float* tb = (LAS float*)(lds + w * 8448);
        const f16* MI = (const f16*)(ws + WS_MI) + (size_t)(l * NG + g) * 128 * 256;
        for (int idx = tid; idx < 128 * 32; idx += 512) { const int r = idx >> 5, c8 = (idx & 31) * 8; *(LAS f16x8*)(mi + r * 264 + c8) = *(const f16x8*)(MI + (size_t)r * 256 + c8); }
        __syncthreads();
#pragma unroll
        for (int ct = 0; ct < 2; ++ct) {
            f32x4 accn[8];
#pragma unroll
            for (int nt = 0; nt < 8; ++nt) accn[nt] = z4;
#pragma unroll
            for (int s = 0; s < 8; ++s) {
                const int t = 2 * s + (q >> 1), i0 = 8 * (q & 1);
                const f16x8 ubc = *(const f16x8*)(xg + (size_t)(512 * w + (16 * ct + fr) * 16 + t) * 16 + i0);
#pragma unroll
                for (int nt = 0; nt < 8; ++nt) { const f16x8 am = *(const LAS f16x8*)(mi + (nt * 16 + fr) * 264 + 32 * s + 8 * q); accn[nt] = __builtin_amdgcn_mfma_f32_16x16x32_f16(am, ubc, accn[nt], 0, 0, 0); }
            }
#pragma unroll
            for (int nt = 0; nt < 8; ++nt) *(LAS f32x4*)(tb + fr * 132 + nt * 16 + 4 * q) = accn[nt];
            LDS_WAIT();
#pragma unroll
            for (int c = 0; c < 16; ++c) { h0r[16 * ct + c] = hr; h0i[16 * ct + c] = hi;
                const float br = tb[c * 132 + lane], bi = tb[c * 132 + 64 + lane]; const float nr = p16r * hr - p16i * hi + br, ni = p16r * hi + p16i * hr + bi; hr = nr; hi = ni; }
            LDS_WAIT();
        }
        __syncthreads();
    }
    LAS f16* hsb = (LAS f16*)(lds + w * 4352);
    LAS float* carry = (LAS float*)(lds + 34816);
    LAS f16* kt = (LAS f16*)(lds + 38912);
    LAS f16* w1 = (LAS f16*)(lds + 47104);
    carry[(w * 64 + lane) * 2] = hr; carry[(w * 64 + lane) * 2 + 1] = hi;
    *(LAS f16x8*)(kt + tid * 8) = *(const f16x8*)((const f16*)(ws + WS_KT) + (size_t)(l * NG + g) * 4096 + tid * 8);
    { const f16* W1g = (const f16*)(ws + WS_W1) + (size_t)(l * NG + g) * 256 * 128;
      for (int idx = tid; idx < 256 * 16; idx += 512) { const int r = idx >> 4, c8 = (idx & 15) * 8; *(LAS f16x8*)(w1 + r * 136 + c8) = *(const f16x8*)(W1g + (size_t)r * 128 + c8); } }
    __syncthreads();
    {
        float pr = ar, pi = ai;
#pragma unroll
        for (int i = 0; i < 9; ++i) { const float nr = pr * pr - pi * pi, ni = 2.f * pr * pi; pr = nr; pi = ni; }
        float zr = 0.f, zi = 0.f;
        for (int v = 0; v < w; ++v) { const float sr = carry[(v * 64 + lane) * 2], si = carry[(v * 64 + lane) * 2 + 1]; const float nr = pr * zr - pi * zi + sr, ni = pr * zi + pi * zr + si; zr = nr; zi = ni; }
#pragma unroll
        for (int c = 0; c < 32; ++c) { h0r[c] += zr; h0i[c] += zi; const float nr = p16r * zr - p16i * zi, ni = p16r * zi + p16i * zr; zr = nr; zi = ni; }
        hr += zr; hi += zi;
    }
    f16* yact = (f16*)(ws + WS_A1);
#pragma unroll
    for (int ct = 0; ct < 2; ++ct) {
        const int tok0 = 512 * w + (16 * ct + fr) * 16;
        f16x8 ubc[8];
#pragma unroll
        for (int s = 0; s < 8; ++s) ubc[s] = *(const f16x8*)(xg + (size_t)(tok0 + 2 * s + (q >> 1)) * 16 + 8 * (q & 1));
        f16x4 xnv[16];
#pragma unroll
        for (int t = 0; t < 16; ++t) xnv[t] = *(const f16x4*)(xg + (size_t)(tok0 + t) * 16 + 4 * q);
#pragma unroll
        for (int c = 0; c < 16; ++c) { hsb[c * 136 + lane] = (f16)h0r[16 * ct + c]; hsb[c * 136 + 64 + lane] = (f16)h0i[16 * ct + c]; }
        LDS_WAIT();
        f16x8 hsB[4];
#pragma unroll
        for (int s = 0; s < 4; ++s) hsB[s] = *(const LAS f16x8*)(hsb + fr * 136 + 32 * s + 8 * q);
        LDS_WAIT();
#pragma unroll
        for (int t = 0; t < 16; ++t) {
            f32x4 acc = z4;
#pragma unroll
            for (int s = 0; s < 4; ++s) { const f16x8 aw = *(const LAS f16x8*)(w1 + (t * 16 + fr) * 136 + 32 * s + 8 * q); acc = __builtin_amdgcn_mfma_f32_16x16x32_f16(aw, hsB[s], acc, 0, 0, 0); }
#pragma unroll
            for (int ks = 0; ks <= t / 2; ++ks) {
                const int tau = t - 2 * ks - (q >> 1);
                const f16x8 ak = (tau >= 0) ? *(const LAS f16x8*)(kt + (tau * 16 + fr) * 16 + 8 * (q & 1)) : z8;
                acc = __builtin_amdgcn_mfma_f32_16x16x32_f16(ak, ubc[ks], acc, 0, 0, 0);
            }
            f16x4 o;
#pragma unroll
            for (int r = 0; r < 4; ++r) o[r] = (f16)gelu_tanh(dt * acc[r] + dsk[r] * (float)xnv[t][r]);
            *(f16x4*)(yact + (size_t)(b * SEQ + tok0 + t) * DM + g * 16 + 4 * q) = o;
            __builtin_amdgcn_sched_barrier(0);
        }
    }
    if (w == 7) { const size_t o = (size_t)((l * NBP + b) * NG + g) * NST + lane; p.out[O_REP + o] = dt * hr; p.out[O_IMP + o] = dt * hi; }
    __syncthreads();
}
__device__ __forceinline__ void s5_sample_wave(int l, int b, int g, const Params& p, int lane_in) {
    int lane = lane_in; asm volatile("" : "+v"(lane));
    unsigned char* ws = p.ws;
    const size_t sidx = (size_t)((l * NBS + b) * NG + g) * NST + lane;
    float hr = p.in[5][sidx], hi = p.in[6][sidx];
    const float* AT = (const float*)(ws + WS_AT) + (size_t)((l * NG + g) * NST + lane) * 2; const float ar = AT[0], ai = AT[1];
    const float* BBF = (const float*)(ws + WS_BBF) + (size_t)((l * NG + g) * NST + lane) * 32;
    float bre[16], bim[16];
#pragma unroll
    for (int i = 0; i < 16; ++i) { bre[i] = BBF[i]; bim[i] = BBF[16 + i]; }
    const float* cre = p.in[14] + (size_t)(l * NG + g) * 16 * 64 + lane; const float* cim = p.in[15] + (size_t)(l * NG + g) * 16 * 64 + lane;
    const float dsk = (lane < 16) ? p.in[16][(size_t)l * DM + g * 16 + lane] : 0.f;
    for (int i = 0; i < LS; ++i) {
        const float* xn = (const float*)(ws + WS_XNS) + (size_t)(b * LS + i) * DM + g * 16;
        float br = 0.f, bi = 0.f;
#pragma unroll
        for (int k = 0; k < 16; ++k) { const float u = xn[k]; br += bre[k] * u; bi += bim[k] * u; }
        const float nr = ar * hr - ai * hi + br, ni = ar * hi + ai * hr + bi; hr = nr; hi = ni;
        float yv = 0.f;
#pragma unroll
        for (int j = 0; j < 16; ++j) { const float s = wave_sum(cre[j * 64] * hr - cim[j * 64] * hi); if (lane == j) yv = s; }
        if (lane < 16) { const float y = gelu_tanh(yv + dsk * xn[lane]); ((f16*)(ws + WS_AS1))[(size_t)(b * LS + i) * DM + g * 16 + lane] = (f16)y; }
    }
    p.out[O_RES + sidx] = hr; p.out[O_IMS + sidx] = hi;
}
template <int EPI>
__device__ __forceinline__ void sgemm_phase(LAS unsigned char* lds, const f16* Wt, int N, int K, const f16* act, const Params& p, int L, int nkvcols, int vcu, int G, int tid_in) {
    int tid = tid_in; asm volatile("" : "+v"(tid));
    const int lane = tid & 63, w = __builtin_amdgcn_readfirstlane(tid >> 6), c = lane & 31, h = lane >> 5;
    LAS float* red = (LAS float*)lds;
    LAS float* tile = (LAS float*)(lds + 8 * 32 * 33 * 4);
    unsigned char* ws = p.ws;
    const int kw = K >> 3, k0 = w * kw;
    for (int u = vcu; u < N / 32; u += G) {
        const int n0 = 32 * u;
        f32x16 acc;
#pragma unroll
        for (int r = 0; r < 16; ++r) acc[r] = 0.f;
        const f16* wrow = Wt + (size_t)(n0 + c) * K + k0 + 8 * h; const f16* arow = act + (size_t)c * K + k0 + 8 * h;
        for (int kb = 0; kb < kw; kb += 128) {
            f16x8 av[8], bv[8];
#pragma unroll
            for (int i = 0; i < 8; ++i) { av[i] = *(const f16x8*)(wrow + kb + 16 * i); bv[i] = *(const f16x8*)(arow + kb + 16 * i); }
#pragma unroll
            for (int i = 0; i < 8; ++i) acc = __builtin_amdgcn_mfma_f32_32x32x16_f16(av[i], bv[i], acc, 0, 0, 0);
        }
#pragma unroll
        for (int r = 0; r < 16; ++r) red[(w * 32 + (r & 3) + 8 * (r >> 2) + 4 * h) * 33 + c] = acc[r];
        __syncthreads();
        const int tok = tid >> 4, nl = (tid & 15) * 2;
        float v0 = 0.f, v1 = 0.f;
#pragma unroll
        for (int ww = 0; ww < 8; ++ww) { v0 += red[(ww * 32 + nl) * 33 + tok]; v1 += red[(ww * 32 + nl + 1) * 33 + tok]; }
        tile[tok * 33 + nl] = v0; tile[tok * 33 + nl + 1] = v1;
        __syncthreads();
#pragma unroll
        for (int e = 0; e < 2; ++e) {
            const int n = n0 + nl + e; const float v = e ? v1 : v0;
            if (EPI == 0) { const float y = (float)((const f16*)(ws + WS_AS1))[(size_t)tok * DM + n]; ((float*)(ws + WS_YS))[(size_t)tok * DM + n] = y * sigmoidf_(v + p.in[18][(size_t)L * DM + n]); }
            else if (EPI == 1) { const float a = fmaxf(v, 0.f); ((f16*)(ws + WS_HS))[(size_t)tok * FF + n] = (f16)(a * a); }
            else if (EPI == 2) { ((float*)(ws + WS_YS))[(size_t)tok * DM + n] = v; }
            else {
                const int d = n & 127, bq = tok >> 2, ii = tok & 3;
                const float* rp = (const float*)(ws + WS_ROPE) + (size_t)(4096 + ii) * 32;
                float vr = v;
                if (d < 32) { const float cs = rp[d & 15], sn = rp[16 + (d & 15)]; const float xp = tile[tok * 33 + ((nl + e) ^ 16)]; vr = (d < 16) ? (v * cs - xp * sn) : (v * cs + xp * sn); }
                if (n < nkvcols) {
                    const int hh = n >> 7, br = hh >> 3, kv = (hh >> 2) & 1, g = hh & 3, cc = kv * 512 + g * 128 + d;
                    const float o = (br >= 1 && kv == 0) ? vr : v;
                    if (br == 0) p.out[O_CMPS + (size_t)tok * 1024 + cc] = o;
                    else if (br == 1) p.out[O_SLCS + (size_t)tok * 1024 + cc] = o;
                    else p.out[O_SWAS + ((size_t)(bq * 512 + 508 + ii)) * 1024 + cc] = o;
                } else {
                    const int cq = n - nkvcols;
                    if (cq < 2048) { ((float*)(ws + WS_QNS))[(size_t)tok * DM + cq] = v * QSCALE; ((float*)(ws + WS_QRS))[(size_t)tok * DM + cq] = vr * QSCALE; }
                    else if (cq < NQG) ((float*)(ws + WS_GATESS))[(size_t)tok * 48 + cq - 2048] = sigmoidf_(v);
                }
            }
        }
        __syncthreads();
    }
}

__device__ __forceinline__ void cmp2_unit(LAS unsigned char* lds, int unit, const Params& p, int tid_in) {
    int tid = tid_in; asm volatile("" : "+v"(tid));
    unsigned char* ws = p.ws;
    const int lane = tid & 63, w = __builtin_amdgcn_readfirstlane(tid >> 6), fr = lane & 15, q = lane >> 4;
    int mi, part, nvalid, R0, kv, b, g; const bool prompt = unit < 32;
    if (prompt) { mi = unit >> 1; part = unit & 1; nvalid = 255; R0 = mi * 256; kv = mi >> 3; b = (mi >> 2) & 1; g = mi & 3; }
    else { const int us = unit - 32; mi = us >> 3; part = us & 7; nvalid = 1023; R0 = 4096 + mi * 1024; kv = mi >> 5; b = (mi >> 2) & 7; g = mi & 3; }
    const int n0 = part * 128;
    LAS f16* At = (LAS f16*)lds;
    LAS f16* Wt = (LAS f16*)(lds + 67584);
    const f16* PROJ = (const f16*)(ws + WS_PROJ); const float* PE = (const float*)(ws + WS_PE) + kv * 256;
    { const int h4 = (tid & 63) * 4; const f32x4 pe = *(const f32x4*)(PE + h4);
#pragma unroll
      for (int hb = 0; hb < 2; ++hb) {
          f16x4 a[8], bb[8];
#pragma unroll
          for (int i = 0; i < 8; ++i) { const int row = (tid >> 6) + 8 * (hb * 8 + i), n = n0 + row;
              if (n < nvalid) { a[i] = *(const f16x4*)(PROJ + (size_t)(R0 + n) * 512 + h4); bb[i] = *(const f16x4*)(PROJ + (size_t)(R0 + n + 1) * 512 + 256 + h4); }
              else { a[i] = (f16x4){0, 0, 0, 0}; bb[i] = a[i]; } }
#pragma unroll
          for (int i = 0; i < 8; ++i) { const int row = (tid >> 6) + 8 * (hb * 8 + i), n = n0 + row; f16x4 o = {0, 0, 0, 0};
              if (n < nvalid) {
#pragma unroll
                  for (int e = 0; e < 4; ++e) o[e] = (f16)gelu_tanh((float)a[i][e] + (float)bb[i][e] + pe[e]); }
              *(LAS f16x4*)(At + row * 264 + h4) = o; }
      } }
    const f16* W2 = (const f16*)(ws + WS_CW2) + (size_t)kv * 128 * 256;
    for (int idx = tid; idx < 128 * 32; idx += 512) { const int d = idx >> 5, c8 = (idx & 31) * 8; *(LAS f16x8*)(Wt + d * 264 + c8) = *(const f16x8*)(W2 + d * 256 + c8); }
    __syncthreads();
    f32x4 acc[8];
#pragma unroll
    for (int dt = 0; dt < 8; ++dt) acc[dt] = (f32x4){0.f, 0.f, 0.f, 0.f};
#pragma unroll
    for (int s = 0; s < 8; ++s) { const f16x8 bop = *(const LAS f16x8*)(At + (16 * w + fr) * 264 + 32 * s + 8 * q);
#pragma unroll
        for (int dt = 0; dt < 8; ++dt) { const f16x8 aop = *(const LAS f16x8*)(Wt + (16 * dt + fr) * 264 + 32 * s + 8 * q); acc[dt] = __builtin_amdgcn_mfma_f32_16x16x32_f16(aop, bop, acc[dt], 0, 0, 0); } }
    const int n = n0 + 16 * w + fr;
    if (prompt) {
        if (kv == 0) { f16* o = (f16*)(ws + WS_KC) + ((size_t)((b * 4 + g) * 256 + n)) * 128 + 4 * q;
#pragma unroll
            for (int dt = 0; dt < 8; ++dt) *(f16x4*)(o + 16 * dt) = cvt4(acc[dt]); }
        else { const int np = (n & ~12) | ((n & 4) << 1) | ((n & 8) >> 1);
            f16* o = (f16*)(ws + WS_VCT) + ((size_t)(b * 4 + g) * 128) * 256 + np;
#pragma unroll
            for (int dt = 0; dt < 8; ++dt)
#pragma unroll
                for (int r = 0; r < 4; ++r) o[(size_t)(16 * dt + 4 * q + r) * 256] = (f16)acc[dt][r]; }
    } else {
        f16* o = (f16*)(ws + (kv ? WS_VCS : WS_KCS)) + ((size_t)((b * 4 + g) * 1024 + n)) * 128 + 4 * q;
#pragma unroll
        for (int dt = 0; dt < 8; ++dt) *(f16x4*)(o + 16 * dt) = cvt4(acc[dt]);
    }
    __syncthreads();
}

__device__ __forceinline__ void pgates_phase(LAS unsigned char* lds, const f16* Wt, const f16* A, float* GATES, int vcu, int G, int tid_in) {
    int tid = tid_in; asm volatile("" : "+v"(tid));
    const int lane = tid & 63, w = __builtin_amdgcn_readfirstlane(tid >> 6), c = lane & 31, h = lane >> 5;
    LAS float* red = (LAS float*)lds;
    const int k0 = w * 256;
    for (int u = vcu; u < 512; u += G) {
        const int rg = u >> 1, n0 = 2048 + (u & 1) * 32;
        f32x16 acc;
#pragma unroll
        for (int r = 0; r < 16; ++r) acc[r] = 0.f;
        const f16* wrow = Wt + (size_t)(n0 + c) * DM + k0 + 8 * h; const f16* arow = A + (size_t)(rg * 32 + c) * DM + k0 + 8 * h;
#pragma unroll
        for (int kb = 0; kb < 256; kb += 128) {
            f16x8 av[8], bv[8];
#pragma unroll
            for (int i = 0; i < 8; ++i) { av[i] = *(const f16x8*)(wrow + kb + 16 * i); bv[i] = *(const f16x8*)(arow + kb + 16 * i); }
#pragma unroll
            for (int i = 0; i < 8; ++i) acc = __builtin_amdgcn_mfma_f32_32x32x16_f16(av[i], bv[i], acc, 0, 0, 0);
        }
#pragma unroll
        for (int r = 0; r < 16; ++r) red[(w * 32 + (r & 3) + 8 * (r >> 2) + 4 * h) * 33 + c] = acc[r];
        __syncthreads();
        const int tok = tid >> 4, nl = (tid & 15) * 2;
        float v0 = 0.f, v1 = 0.f;
#pragma unroll
        for (int ww = 0; ww < 8; ++ww) { v0 += red[(ww * 32 + nl) * 33 + tok]; v1 += red[(ww * 32 + nl + 1) * 33 + tok]; }
        const int col = (u & 1) * 32 + nl;
        if (col < 48) { float* o = GATES + (size_t)(rg * 32 + tok) * 48 + col; o[0] = sigmoidf_(v0); o[1] = sigmoidf_(v1); }
        __syncthreads();
    }
}
constexpr int AT_KB = 0, AT_VB = 32768, AT_VSZ = 16384, AT_PSUM = 69632, AT_SELM = 135168;
struct AStage { u32x4 k0, k1, v0, v1; };
template <bool HASV>
__device__ __forceinline__ void a_load(AStage& s, const f16* Kb, const f16* Vt, int vstride, int tid) {
    const int p0 = tid, p1 = tid + 512;
    s.k0 = *(const u32x4*)(Kb + (p0 >> 4) * 128 + (p0 & 15) * 8); s.k1 = *(const u32x4*)(Kb + (p1 >> 4) * 128 + (p1 & 15) * 8);
    if (HASV) { s.v0 = *(const u32x4*)(Vt + (size_t)(p0 >> 3) * vstride + (p0 & 7) * 8); s.v1 = *(const u32x4*)(Vt + (size_t)(p1 >> 3) * vstride + (p1 & 7) * 8); }
}
template <bool HASV>
__device__ __forceinline__ void a_store(const AStage& s, LAS unsigned char* kb, LAS unsigned char* vb, int tid) {
    const int p0 = tid, p1 = tid + 512;
    { const int row = p0 >> 4, ch = p0 & 15; *(LAS u32x4*)(kb + row * 256 + ((ch ^ (row & 15)) << 4)) = s.k0; }
    { const int row = p1 >> 4, ch = p1 & 15; *(LAS u32x4*)(kb + row * 256 + ((ch ^ (row & 15)) << 4)) = s.k1; }
    if (HASV) {
        { const int d = p0 >> 3, ch = p0 & 7, g = (d >> 1) & 15; u32x4 v = s.v0; if (g & 1) v = (u32x4){v[2], v[3], v[0], v[1]}; *(LAS u32x4*)(vb + d * 128 + ((ch ^ (g >> 1)) << 4)) = v; }
        { const int d = p1 >> 3, ch = p1 & 7, g = (d >> 1) & 15; u32x4 v = s.v1; if (g & 1) v = (u32x4){v[2], v[3], v[0], v[1]}; *(LAS u32x4*)(vb + d * 128 + ((ch ^ (g >> 1)) << 4)) = v; }
    }
}
__device__ __forceinline__ float l_comb(float l) { const auto rr = __builtin_amdgcn_permlane32_swap(__float_as_uint(l), __float_as_uint(l), false, false); return __uint_as_float(rr[0]) + __uint_as_float(rr[1]); }
template <int BR>
__device__ __forceinline__ void flash_loop(unsigned long long tmask, const f16* Kbase, const f16* Vbase, int vtile, int vstride, LAS unsigned char* lds, const f16x8 (&qf)[8], f32x16 (&acc)[4],
                                           float& m, float& l, float inv_l, int cur, int tk, int vmax, unsigned sel_lo, unsigned sel_hi, int tid_in) {
    if (tmask == 0ull) return;
    int tid_o = tid_in; asm volatile("" : "+v"(tid_o));
    const int tid = tid_o;
    const int lane = tid & 63, c = lane & 31, h = lane >> 5;
    const float NEG = -__builtin_inff();
    int j = __builtin_ctzll(tmask); tmask &= tmask - 1ull;
    const int wv = __builtin_amdgcn_readfirstlane(tid >> 6);
    unsigned koff[2], voff[2];
#pragma unroll
    for (int i = 0; i < 2; ++i) { const int o = wv * 1024 + i * 8192 + lane * 16;
        { const int row = o >> 8, slot = (o >> 4) & 15; koff[i] = (unsigned)(row * 256 + ((slot ^ (row & 15)) << 4)); }
        { const int d = o >> 7, slot = (o >> 4) & 7; voff[i] = (unsigned)(d * vstride * 2 + ((slot ^ ((d >> 1) & 7)) << 4)); } }
#define ATT_ISSUE(tile, buf) do { const char* _kg = (const char*)Kbase + (size_t)(tile) * 16384; const char* _vg = (const char*)Vbase + (size_t)(tile) * vtile * 2; \
        _Pragma("unroll") for (int _i = 0; _i < 2; ++_i) { \
            __builtin_amdgcn_global_load_lds((const unsigned*)(_kg + koff[_i]), (LAS unsigned*)(lds + AT_KB + (buf) * 16384 + wv * 1024 + _i * 8192), 16, 0, 0); \
            if (BR != 0) __builtin_amdgcn_global_load_lds((const unsigned*)(_vg + voff[_i]), (LAS unsigned*)(lds + AT_VB + (buf) * AT_VSZ + wv * 1024 + _i * 8192), 16, 0, 0); } } while (0)
    ATT_ISSUE(j, 0);
    asm volatile("s_waitcnt vmcnt(0)" ::: "memory");
    __syncthreads();
    int bi = 0;
    for (;;) {
        int jn = -1;
        if (tmask != 0ull) { jn = __builtin_ctzll(tmask); tmask &= tmask - 1ull; ATT_ISSUE(jn, bi ^ 1); }
        const LAS unsigned char* kb = lds + AT_KB + bi * 16384; const LAS unsigned char* vb = lds + AT_VB + bi * AT_VSZ;
        int lo = 0, hi = 63;
        if (BR <= 1) { hi = vmax - 64 * j; }
        bool rowoff = false;
        if (BR == 2) { const bool rs = j < 32 ? ((sel_lo >> j) & 1u) : ((sel_hi >> (j - 32)) & 1u);
                       if (j == cur) { if (!rs) { lo = 1; hi = 0; } else hi = tk; } else rowoff = !rs; }
        if (BR == 3) { if (j == cur) hi = tk; else if (j == cur - 8) lo = tk + 1; }
        const bool need_mask = !__all(lo == 0 && hi >= 63);
#ifndef ATT_CDUP
#define ATT_CDUP 1
#endif
        const int nhalf = (BR == 2 && __all(rowoff)) ? 0 : ((BR >= 2) ? 2 * ATT_CDUP : 2);
#ifdef ATT_UNROLL
#pragma unroll
#else
#pragma unroll 1
#endif
        for (int hfi = 0; hfi < nhalf; ++hfi) { const int hf = hfi & 1;
            f32x16 pp;
            if (BR >= 2) { const float bias = rowoff ? NEG : -m;
#pragma unroll
                for (int r = 0; r < 16; ++r) pp[r] = bias; }
            else {
#pragma unroll
                for (int r = 0; r < 16; ++r) pp[r] = 0.f; }
            { f16x8 ka[8];
#pragma unroll
              for (int s = 0; s < 8; ++s) ka[s] = *(const LAS f16x8*)(kb + (c + 32 * hf) * 256 + (((2 * s + h) ^ (c & 15)) << 4));
              __builtin_amdgcn_sched_barrier(0);
#pragma unroll
              for (int s = 0; s < 8; ++s) pp = __builtin_amdgcn_mfma_f32_32x32x16_f16(ka[s], qf[s], pp, 0, 0, 0);
            }
            if (need_mask) {
#pragma unroll
                for (int r = 0; r < 16; ++r) { const int k = (r & 3) + 8 * (r >> 2) + 4 * h + 32 * hf; if (k < lo || k > hi) pp[r] = NEG; }
            }
            if (BR == 1) {
#pragma unroll
                for (int r = 0; r < 16; ++r) pp[r] = __builtin_amdgcn_exp2f(pp[r] - m) * inv_l;
                LAS float* ps = (LAS float*)(lds + AT_PSUM) + tk * 256 + 64 * j + 32 * hf;
#pragma unroll
                for (int r = 0; r < 16; ++r) { float a = pp[r]; a += __shfl_xor(a, 1); a += __shfl_xor(a, 2);
                    if ((c & 3) == 0) ps[(r & 3) + 8 * (r >> 2) + 4 * h] = a; }
            } else {
                float mx = fmaxf(pp[0], pp[1]);
#pragma unroll
                for (int r = 2; r < 16; r += 2) asm("v_max3_f32 %0, %1, %2, %3" : "=v"(mx) : "v"(mx), "v"(pp[r]), "v"(pp[r + 1]));
                { const auto rr = __builtin_amdgcn_permlane32_swap(__float_as_uint(mx), __float_as_uint(mx), false, false); mx = fmaxf(__uint_as_float(rr[0]), __uint_as_float(rr[1])); }
                float rs = 0.f;
                if (BR >= 2) {
                    if (!__all(mx <= 8.0f)) {
                        const float dlt = fmaxf(mx, 0.f), alpha = __builtin_amdgcn_exp2f(-dlt);
                        m += dlt; l *= alpha;
#pragma unroll
                        for (int dt = 0; dt < 4; ++dt)
#pragma unroll
                            for (int r = 0; r < 16; ++r) acc[dt][r] *= alpha;
#pragma unroll
                        for (int r = 0; r < 16; ++r) pp[r] -= dlt;
                    }
#pragma unroll
                    for (int r = 0; r < 16; ++r) { pp[r] = __builtin_amdgcn_exp2f(pp[r]); rs += pp[r]; }
                } else {
                    if (!__all((mx - m) <= 8.0f)) { const float mn = fmaxf(m, mx), alpha = __builtin_amdgcn_exp2f(m - mn); m = mn; l *= alpha; }
#pragma unroll
                    for (int r = 0; r < 16; ++r) { pp[r] = __builtin_amdgcn_exp2f(pp[r] - m); rs += pp[r]; }
                }
                l += rs;
            }
            if (BR >= 1) {
                f16x8 pk[2];
#pragma unroll
                for (int e = 0; e < 8; ++e) { pk[0][e] = (f16)pp[e]; pk[1][e] = (f16)pp[8 + e]; }
                f16x8 va[4][2];
#pragma unroll
                for (int dt = 0; dt < 4; ++dt)
#pragma unroll
                    for (int s2 = 0; s2 < 2; ++s2) {
                        const int s = 2 * hf + s2;
                        const int gsw = (c >> 1) & 7;
                        va[dt][s2] = *(const LAS f16x8*)(vb + (32 * dt + c) * 128 + (((2 * s + h) ^ gsw) << 4));
                    }
                __builtin_amdgcn_sched_barrier(0);
#pragma unroll
                for (int s2 = 0; s2 < 2; ++s2)
#pragma unroll
                    for (int dt = 0; dt < 4; ++dt) acc[dt] = __builtin_amdgcn_mfma_f32_32x32x16_f16(va[dt][s2], pk[s2], acc[dt], 0, 0, 0);
              }
        }
        asm volatile("s_waitcnt vmcnt(0)" ::: "memory");
        __syncthreads();
        if (jn < 0) break;
        j = jn; bi ^= 1;
    }
#undef ATT_ISSUE
}
__device__ __forceinline__ void out16_update(LAS unsigned char* reg, const f32x16 (&acc)[4], float sc, bool first, int lane) {
#pragma unroll
    for (int dt = 0; dt < 4; ++dt)
#pragma unroll
        for (int hf = 0; hf < 2; ++hf) {
            LAS f16x8* ptr = (LAS f16x8*)(reg + ((dt * 2 + hf) * 64 + lane) * 16);
            f16x8 o;
            if (first) {
#pragma unroll
                for (int e = 0; e < 8; ++e) o[e] = (f16)(acc[dt][8 * hf + e] * sc);
            } else {
                const f16x8 pv = *ptr;
#pragma unroll
                for (int e = 0; e < 8; ++e) o[e] = (f16)((float)pv[e] + acc[dt][8 * hf + e] * sc);
            }
            *ptr = o;
        }
}
__device__ __forceinline__ void attn_prompt_tile(LAS unsigned char* lds, int b, int g, int cur, const Params& p, int tid_in) {
    int tid = tid_in; asm volatile("" : "+v"(tid));
    unsigned char* ws = p.ws;
    const int lane = tid & 63, w = __builtin_amdgcn_readfirstlane(tid >> 6), c = lane & 31, h = lane >> 5;
    const int tk = 8 * w + (c >> 2), t = 64 * cur + tk, hd = 4 * g + (c & 3);
    const size_t row = (size_t)b * SEQ + t;
    LAS unsigned char* oreg = lds + AT_PSUM + w * 8192;
    f32x16 acc[4];
    f16x8 qf[8];
    { const f16* qp = (const f16*)(ws + WS_QN) + row * DM + hd * 128 + 8 * h;
#pragma unroll
      for (int s = 0; s < 8; ++s) qf[s] = *(const f16x8*)(qp + 16 * s); }
    const int ntc = (4 * cur + 2) / 64 + 1;
    const f16* Kc = (const f16*)(ws + WS_KC) + (size_t)(b * 4 + g) * 256 * 128; const f16* Vc = (const f16*)(ws + WS_VCT) + (size_t)(b * 4 + g) * 128 * 256;
    const unsigned long long cmask = (1ull << ntc) - 1ull;
    float m = -1e30f, l = 0.f;
#pragma unroll
    for (int dt = 0; dt < 4; ++dt)
#pragma unroll
        for (int r = 0; r < 16; ++r) acc[dt][r] = 0.f;
    { const int vmax = t >= 31 ? ((t - 31) >> 4) : -1;
      flash_loop<0>(cmask, Kc, Vc, 64, 256, lds, qf, acc, m, l, 0.f, cur, tk, vmax, 0u, 0u, tid);
      l = l_comb(l);
      const float inv_l = l > 0.f ? 1.0f / l : 0.f;
      flash_loop<1>(cmask, Kc, Vc, 64, 256, lds, qf, acc, m, l, inv_l, cur, tk, vmax, 0u, 0u, tid); }
    {
        const LAS float* ps = (const LAS float*)(lds + AT_PSUM);
        LAS unsigned* selm = (LAS unsigned*)(lds + AT_SELM);
        int jj = lane; asm volatile("" : "+v"(jj));
        for (int k = 0; k < 8; ++k) {
            const int tkk = 8 * w + k; float imp = 0.f;
#pragma unroll
            for (int i = 4 * jj - 1; i <= 4 * jj + 3; ++i) if (i >= 0 && i < 64 * ntc && i <= 254) imp += ps[tkk * 256 + i];
            const bool elig = jj <= cur, forced = (jj == 0) || (jj == cur) || (jj == cur - 1);
            const float val = elig ? (forced ? 1.0e4f : imp) : -__builtin_inff();
            int rank = 0;
            for (int kk = 0; kk < 64; ++kk) { const float vk = __shfl(val, kk); rank += ((vk > val) || (vk == val && kk < jj)) ? 1 : 0; }
            const unsigned long long mk = __ballot(elig && rank < 16);
            if (lane == 0) { selm[2 * tkk] = (unsigned)mk; selm[2 * tkk + 1] = (unsigned)(mk >> 32); }
        }
    }
    { const float g_c = ((const float*)(ws + WS_GATES))[row * 48 + hd * 3 + 0];
      LDS_WAIT();
      out16_update(oreg, acc, g_c, true, lane); }
    __syncthreads();
    unsigned sel_lo, sel_hi; unsigned long long umask;
    { const LAS unsigned* selm = (const LAS unsigned*)(lds + AT_SELM);
      unsigned ulo = selm[2 * lane], uhi = selm[2 * lane + 1];
#pragma unroll
      for (int o = 1; o < 64; o <<= 1) { ulo |= __shfl_xor(ulo, o); uhi |= __shfl_xor(uhi, o); }
      umask = ((unsigned long long)(unsigned)__builtin_amdgcn_readfirstlane(uhi) << 32) | (unsigned)__builtin_amdgcn_readfirstlane(ulo);
      sel_lo = selm[2 * tk]; sel_hi = selm[2 * tk + 1]; }
    { const f16* qp = (const f16*)(ws + WS_QN) + row * DM + hd * 128 + 8 * h; const f16* qr = (const f16*)(ws + WS_QR) + row * 512 + hd * 32 + 8 * h;
#pragma unroll
      for (int s = 0; s < 8; ++s) qf[s] = (s < 2) ? *(const f16x8*)(qr + 16 * s) : *(const f16x8*)(qp + 16 * s); }
    m = 0.f; l = 0.f;
#pragma unroll
    for (int dt = 0; dt < 4; ++dt)
#pragma unroll
        for (int r = 0; r < 16; ++r) acc[dt][r] = 0.f;
    flash_loop<2>(umask, (const f16*)(ws + WS_KS) + (size_t)(b * 4 + g) * SEQ * 128, (const f16*)(ws + WS_VST) + (size_t)(b * 4 + g) * 128 * SEQ, 8192, 64, lds, qf, acc, m, l, 0.f, cur, tk, 0, sel_lo, sel_hi, tid);
    { const float g_s = ((const float*)(ws + WS_GATES))[row * 48 + hd * 3 + 1];
      l = l_comb(l); out16_update(oreg, acc, l > 0.f ? g_s / l : 0.f, false, lane); }
    m = 0.f; l = 0.f;
#pragma unroll
    for (int dt = 0; dt < 4; ++dt)
#pragma unroll
        for (int r = 0; r < 16; ++r) acc[dt][r] = 0.f;
    { const int jlo = cur >= 8 ? cur - 8 : 0; const unsigned long long wmask = ((cur == 63 ? ~0ull : ((1ull << (cur + 1)) - 1ull))) & ~((1ull << jlo) - 1ull);
      flash_loop<3>(wmask, (const f16*)(ws + WS_KW) + (size_t)(b * 4 + g) * SEQ * 128, (const f16*)(ws + WS_VWT) + (size_t)(b * 4 + g) * 128 * SEQ, 8192, 64, lds, qf, acc, m, l, 0.f, cur, tk, 0, 0u, 0u, tid); }
    { const float g_w = ((const float*)(ws + WS_GATES))[row * 48 + hd * 3 + 2]; l = l_comb(l); const float sc = l > 0.f ? g_w / l : 0.f;
      f16* op = (f16*)(ws + WS_A1) + row * DM + hd * 128 + 4 * h;
#pragma unroll
      for (int dt = 0; dt < 4; ++dt)
#pragma unroll
          for (int hf = 0; hf < 2; ++hf) {
              const f16x8 pv = *(const LAS f16x8*)(oreg + ((dt * 2 + hf) * 64 + lane) * 16);
              f16x4 o0, o1;
#pragma unroll
              for (int e = 0; e < 4; ++e) { o0[e] = (f16)((float)pv[e] + acc[dt][8 * hf + e] * sc); o1[e] = (f16)((float)pv[4 + e] + acc[dt][8 * hf + 4 + e] * sc); }
              *(f16x4*)(op + 32 * dt + 16 * hf) = o0; *(f16x4*)(op + 32 * dt + 16 * hf + 8) = o1;
          } }
    LDS_WAIT();
    __syncthreads();
}
__device__ __forceinline__ float reduce4(float v0, float v1, float v2, float v3, int lane) {
    const bool up = (lane & 32) != 0;
    float a0 = up ? v2 : v0, a1 = up ? v3 : v1; const float b0 = up ? v0 : v2, b1 = up ? v1 : v3;
    a0 += __shfl_xor(b0, 32); a1 += __shfl_xor(b1, 32);
    const bool up2 = (lane & 16) != 0;
    float c0 = up2 ? a1 : a0; const float d0 = up2 ? a0 : a1;
    c0 += __shfl_xor(d0, 16);
    c0 += __shfl_xor(c0, 8); c0 += __shfl_xor(c0, 4); c0 += __shfl_xor(c0, 2); c0 += __shfl_xor(c0, 1);
    return c0;
}
__device__ __forceinline__ void softmax4(LAS float* sc, int n, int tid) {
    const int lane = tid & 63, w = __builtin_amdgcn_readfirstlane(tid >> 6);
    if (w < 4) {
        LAS float* s = sc + w * 1024; float mx = -__builtin_inff();
        for (int i = lane; i < n; i += 64) mx = fmaxf(mx, s[i]);
        mx = wave_max(mx); if (!(mx > -__builtin_inff())) mx = 0.f;
        float sum = 0.f;
        for (int i = lane; i < n; i += 64) { const float e = __expf(s[i] - mx); s[i] = e; sum += e; }
        sum = wave_sum(sum); const float inv = sum > 0.f ? 1.0f / sum : 1.0f;
        for (int i = lane; i < n; i += 64) s[i] *= inv;
    }
    __syncthreads();
}
constexpr int SA_STG = 33792, SA_V = 17408, SA_QS = 67584, SA_SC2 = 71680, SA_SC = 73728, SA_ST = 74752, SA_LIST = 74816, SA_VAL = 74880, SA_SCALL = 75968;
struct SaRegs { f32x4 k[4], v[4]; };
__device__ __forceinline__ void sa_load_f32(SaRegs& R, const float* r0, const float* r1, int split, int nvalid, int tid) {
#pragma unroll
    for (int i = 0; i < 4; ++i) { const int idx = tid + 512 * i, row = idx >> 5, c4 = (idx & 31) * 4;
        const float* kp = (row < split) ? r0 + (size_t)row * 1024 : r1 + (size_t)(row - split) * 1024;
        if (row < nvalid) { R.k[i] = *(const f32x4*)(kp + c4); R.v[i] = *(const f32x4*)(kp + 512 + c4); }
        else { R.k[i] = (f32x4){0.f, 0.f, 0.f, 0.f}; R.v[i] = (f32x4){0.f, 0.f, 0.f, 0.f}; } }
}
__device__ __forceinline__ void sa_store_f32(const SaRegs& R, LAS unsigned char* stg, int tid) {
#pragma unroll
    for (int i = 0; i < 4; ++i) { const int idx = tid + 512 * i, row = idx >> 5, c4 = (idx & 31) * 4;
        *(LAS f16x4*)(stg + row * 272 + c4 * 2) = cvt4(R.k[i]); *(LAS f16x4*)(stg + SA_V + row * 256 + c4 * 2) = cvt4(R.v[i]); }
}
__device__ __forceinline__ void sa_scores(const LAS unsigned char* stg, const LAS float* q  , LAS float* sc2, int tid) {
    const int key = tid & 63, hd = (tid >> 6) & 3, hf = tid >> 8;
    const LAS f16* kr = (const LAS f16*)(stg + key * 272) + 64 * hf; const LAS float* qr = q + hd * 128 + 64 * hf;
    float s = 0.f;
#pragma unroll
    for (int i = 0; i < 8; ++i) { const f16x8 kk = *(const LAS f16x8*)(kr + 8 * i); const f32x4 qa = *(const LAS f32x4*)(qr + 8 * i), qb = *(const LAS f32x4*)(qr + 8 * i + 4);
        s += (float)kk[0] * qa[0] + (float)kk[1] * qa[1] + (float)kk[2] * qa[2] + (float)kk[3] * qa[3] + (float)kk[4] * qb[0] + (float)kk[5] * qb[1] + (float)kk[6] * qb[2] + (float)kk[7] * qb[3]; }
    sc2[(hf * 4 + hd) * 64 + key] = s;
}
__device__ __forceinline__ void sa_online(LAS unsigned char* lds, int nkeep, int tid) {
    const int lane = tid & 63, w = __builtin_amdgcn_readfirstlane(tid >> 6);
    if (w < 4) {
        const LAS float* sc2 = (const LAS float*)(lds + SA_SC2); LAS float* sc = (LAS float*)(lds + SA_SC); LAS float* st = (LAS float*)(lds + SA_ST);
        float s = sc2[w * 64 + lane] + sc2[(4 + w) * 64 + lane];
        if (lane >= nkeep) s = -__builtin_inff();
        const float mo = st[w], mx = wave_max(s), mn = fmaxf(mo, mx);
        const float pv = __expf(s - mn), ps = wave_sum(pv), al = __expf(mo - mn);
        sc[w * 64 + lane] = pv;
        if (lane == 0) { st[w] = mn; st[4 + w] = st[4 + w] * al + ps; st[8 + w] = al; }
    }
}
__device__ __forceinline__ void attn_sample_unit(LAS unsigned char* lds, int unit, const Params& p, int tid_in) {
    int tid = tid_in; asm volatile("" : "+v"(tid));
    unsigned char* ws = p.ws;
    const int lane = tid & 63, w = __builtin_amdgcn_readfirstlane(tid >> 6);
    const int b = unit >> 4, g = (unit >> 2) & 3, ii = unit & 3, tok = b * LS + ii, t = PAST + ii;
    LAS float* qs = (LAS float*)(lds + SA_QS); LAS float* sc2 = (LAS float*)(lds + SA_SC2); LAS float* sc = (LAS float*)(lds + SA_SC); LAS float* st = (LAS float*)(lds + SA_ST);
    LAS int* list = (LAS int*)(lds + SA_LIST); LAS float* val = (LAS float*)(lds + SA_VAL); LAS float* scall = (LAS float*)(lds + SA_SCALL);
    const int* pt = (const int*)p.in[7] + b * NPAGES;
    { const int hh = (tid >> 7), d = tid & 127;
      qs[hh * 128 + d] = ((const float*)(ws + WS_QNS))[(size_t)tok * DM + (4 * g + hh) * 128 + d];
      qs[512 + hh * 128 + d] = ((const float*)(ws + WS_QRS))[(size_t)tok * DM + (4 * g + hh) * 128 + d]; }
    const int hh_t = tid >> 7, d_t = tid & 127;
    const float* gt = (const float*)(ws + WS_GATESS) + (size_t)tok * 48 + (4 * g + hh_t) * 3;
    const float g_c = gt[0], g_s = gt[1], g_w = gt[2];
    float o_tot = 0.f;
    const f16* Kc = (const f16*)(ws + WS_KCS) + (size_t)(b * 4 + g) * 1024 * 128; const f16* Vc = (const f16*)(ws + WS_VCS) + (size_t)(b * 4 + g) * 1024 * 128;
    {
        f16x8 r0, r1;
        { const int i0 = tid, i1 = tid + 512; r0 = *(const f16x8*)(Kc + (size_t)(i0 >> 4) * 128 + (i0 & 15) * 8); r1 = *(const f16x8*)(Kc + (size_t)(i1 >> 4) * 128 + (i1 & 15) * 8);
          *(LAS f16x8*)(lds + (i0 >> 4) * 272 + (i0 & 15) * 16) = r0; *(LAS f16x8*)(lds + (i1 >> 4) * 272 + (i1 & 15) * 16) = r1; }
        __syncthreads();
        for (int ct = 0; ct < 16; ++ct) {
            LAS unsigned char* cur = lds + (ct & 1) * SA_STG; LAS unsigned char* nxt = lds + ((ct + 1) & 1) * SA_STG;
            if (ct + 1 < 16) { const int i0 = tid, i1 = tid + 512; const f16* kb = Kc + (size_t)(ct + 1) * 64 * 128;
                r0 = *(const f16x8*)(kb + (size_t)(i0 >> 4) * 128 + (i0 & 15) * 8); r1 = *(const f16x8*)(kb + (size_t)(i1 >> 4) * 128 + (i1 & 15) * 8); }
            sa_scores(cur, qs, sc2, tid);
            __syncthreads();
            if (tid < 256) { const int key = tid & 63, hd = tid >> 6, n = 64 * ct + key; scall[hd * 1024 + n] = (n < 1023) ? sc2[hd * 64 + key] + sc2[(4 + hd) * 64 + key] : -__builtin_inff(); }
            if (ct + 1 < 16) { const int i0 = tid, i1 = tid + 512; *(LAS f16x8*)(nxt + (i0 >> 4) * 272 + (i0 & 15) * 16) = r0; *(LAS f16x8*)(nxt + (i1 >> 4) * 272 + (i1 & 15) * 16) = r1; }
            __syncthreads();
        }
    }
    softmax4(scall, 1024, tid);
    if (tid < 257) {
        const int j = tid; float imp = 0.f;
        for (int i = 4 * j - 1; i <= 4 * j + 3; ++i) if (i >= 0 && i <= 1022) imp += (scall[i] + scall[1024 + i]) + (scall[2048 + i] + scall[3072 + i]);
        val[j] = (j == 0 || j >= 255) ? 1.0e4f : imp;
    }
    __syncthreads();
    if (tid < 257) {
        const int j = tid; const float v = val[j]; int rank = 0;
        for (int k = 0; k < 257; ++k) { const float vk = val[k]; rank += ((vk > v) || (vk == v && k < j)) ? 1 : 0; }
        if (rank < 16) list[rank] = j;
    }
    {
        f16x8 r0, r1; float o = 0.f;
        { const int i0 = tid, i1 = tid + 512; r0 = *(const f16x8*)(Vc + (size_t)(i0 >> 4) * 128 + (i0 & 15) * 8); r1 = *(const f16x8*)(Vc + (size_t)(i1 >> 4) * 128 + (i1 & 15) * 8);
          *(LAS f16x8*)(lds + SA_V + (i0 >> 4) * 256 + (i0 & 15) * 16) = r0; *(LAS f16x8*)(lds + SA_V + (i1 >> 4) * 256 + (i1 & 15) * 16) = r1; }
        __syncthreads();
        for (int ct = 0; ct < 16; ++ct) {
            const LAS f16* cur = (const LAS f16*)(lds + (ct & 1) * SA_STG + SA_V); LAS unsigned char* nxt = lds + ((ct + 1) & 1) * SA_STG + SA_V;
            if (ct + 1 < 16) { const int i0 = tid, i1 = tid + 512; const f16* vb = Vc + (size_t)(ct + 1) * 64 * 128;
                r0 = *(const f16x8*)(vb + (size_t)(i0 >> 4) * 128 + (i0 & 15) * 8); r1 = *(const f16x8*)(vb + (size_t)(i1 >> 4) * 128 + (i1 & 15) * 8); }
            const LAS float* pr = scall + hh_t * 1024 + 64 * ct;
#pragma unroll 16
            for (int k = 0; k < 64; ++k) o += pr[k] * (float)cur[k * 128 + d_t];
            if (ct + 1 < 16) { const int i0 = tid, i1 = tid + 512; *(LAS f16x8*)(nxt + (i0 >> 4) * 256 + (i0 & 15) * 16) = r0; *(LAS f16x8*)(nxt + (i1 >> 4) * 256 + (i1 & 15) * 16) = r1; }
            __syncthreads();
        }
        o_tot += g_c * o;
    }
#pragma unroll 1
    for (int br = 0; br < 2; ++br) {
        const int nblk = br == 0 ? 16 : 8;
        const LAS float* q = qs + 512;
        if (tid < 4) { st[tid] = -1e30f; st[4 + tid] = 0.f; st[8 + tid] = 1.f; }
        float o = 0.f;
        SaRegs R;
        const float* r0p; const float* r1p; int split, nvalid;
#define SA_DESC(sidx) do { if (br == 0) { const int blk = list[sidx]; split = 64; r1p = nullptr; \
                if (blk < 256) { r0p = p.in[3] + (((size_t)pt[blk >> 1] * PAGE + (blk & 1) * 64) * 2) * 512 + g * 128; nvalid = 64; } \
                else { r0p = p.out + O_SLCS + (size_t)(b * LS) * 1024 + g * 128; nvalid = ii + 1; } } \
            else { const int pos0 = t - 511 + 64 * (sidx); nvalid = 64; \
                r0p = p.in[4] + ((size_t)(b * 512 + pos0 - (PAST - 512)) * 2) * 512 + g * 128; split = PAST - pos0; if (split > 64) split = 64; \
                r1p = p.out + O_SWAS + ((size_t)(b * 512 + 508)) * 1024 + g * 128; } } while (0)
        SA_DESC(0);
        sa_load_f32(R, r0p, r1p, split, nvalid, tid);
        __syncthreads();
        sa_store_f32(R, lds, tid);
        __syncthreads();
        for (int s = 0; s < nblk; ++s) {
            LAS unsigned char* cur = lds + (s & 1) * SA_STG; LAS unsigned char* nxt = lds + ((s + 1) & 1) * SA_STG;
            const int nv_cur = nvalid;
            if (s + 1 < nblk) { SA_DESC(s + 1); sa_load_f32(R, r0p, r1p, split, nvalid, tid); }
            sa_scores(cur, q, sc2, tid);
            __syncthreads();
            sa_online(lds, nv_cur, tid);
            __syncthreads();
            { const float al = st[8 + hh_t]; const LAS f16* vb = (const LAS f16*)(cur + SA_V); const LAS float* pr = sc + hh_t * 64; float a = 0.f;
#pragma unroll 16
              for (int k = 0; k < 64; ++k) a += pr[k] * (float)vb[k * 128 + d_t];
              o = o * al + a; }
            if (s + 1 < nblk) sa_store_f32(R, nxt, tid);
            __syncthreads();
        }
#undef SA_DESC
        const float lsum = st[4 + hh_t];
        o_tot += (br == 0 ? g_s : g_w) * (lsum > 0.f ? o / lsum : 0.f);
        __syncthreads();
    }
    ((f16*)(ws + WS_AS1))[(size_t)tok * DM + (4 * g + hh_t) * 128 + d_t] = (f16)o_tot;
    __syncthreads();
}
constexpr int NPHASE = 41;
#ifndef SQ0
#define SQ0 40
#endif
#ifndef SG_FIRST
#define SG_FIRST 0
#endif
#ifndef PG8_SP2
#define PG8_SP2 true
#endif
#ifndef PG8_ALIGN
#define PG8_ALIGN false
#endif
#ifndef REP_PRO
#define REP_PRO 1
#endif
#ifndef REP_S5
#define REP_S5 1
#endif
#ifndef REP_ATT
#define REP_ATT 1
#endif
#ifndef REP_SG
#define REP_SG 1
#endif
#ifndef REP_RN
#define REP_RN 1
#endif
#ifndef REP_GEMM
#define REP_GEMM 1
#endif
__host__ __device__ inline bool phase_active(int ph) {
    if (ph == 0) return true;
    const int L = (ph - 1) / 10, s = (ph - 1) % 10;
    if (s == 1) return L <= 2;
    if (s == 2) return L == 2;
    if (s == 4) return false;
    if (s == 3 || s == 5) return L >= 2;
    return true;
}
#ifndef PAD_SEL
#define PAD_SEL 0
#endif
#ifndef PAD_US
#define PAD_US 1000
#endif
#define IN(k) (lo <= (k) && (k) < hi)
#ifndef PAD_LMASK
#define PAD_LMASK 15
#endif
#define PAD_BEGIN(sbit) unsigned long long pad_t0 = 0; if (((PAD_SEL >> (sbit)) & 1) && ((PAD_LMASK >> L) & 1)) pad_t0 = __builtin_amdgcn_s_memrealtime();
#define PAD_END(sbit) if (((PAD_SEL >> (sbit)) & 1) && ((PAD_LMASK >> L) & 1)) { while (__builtin_amdgcn_s_memrealtime() - pad_t0 < (unsigned long long)PAD_US * 100ull) __builtin_amdgcn_s_sleep(8); }
#ifndef BAR_DUP
#define BAR_DUP 1
#endif
#define SEAM(k) do { if (use_bar && (k) + 1 < hi) { for (int _b = 0; _b < BAR_DUP; ++_b) xcd_barrier(bar); } } while (0)
template <int L>
__device__ __forceinline__ void layer_phases(const Params& p, LAS unsigned char* lds, const XcdBarrier& bar, const bool use_bar, const int lo, const int hi, const int tid, const int G, const int bx, const int vcu) {
    unsigned char* const ws = p.ws;
    const int lane = tid & 63, wave = __builtin_amdgcn_readfirstlane(tid >> 6);
    const int gw = vcu * 8 + wave, NGW = G * 8;
    constexpr int base = 1 + 10 * L;
    if (IN(base + 0)) { PAD_BEGIN(0)
        if constexpr (L < 2) {
            for (int rep = 0; rep < REP_S5; ++rep)
            for (int u = vcu; u < NBP * NG; u += G) s5_prompt_unit(lds, L, u >> 7, u & 127, p, tid);
            for (int rep = 0; rep < REP_S5; ++rep)
            for (int u = gw; u < NBS * NG; u += NGW) s5_sample_wave(L, u >> 7, u & 127, p, lane);
        } else {
            constexpr int N = (L == 2) ? (NKV + NQGP) : DM; const f16* Wt = (const f16*)(ws + (L == 2 ? WS_WKVQG : WS_WQG1));
            pg8::Gemm g{(const f16*)(ws + WS_X), Wt, MP, N, DM}; pg8::StaticOrder S; S.init(MP, N, G, bx);
            pg8::EpiProj E{L == 2 ? 12 : 0, p.out, (f16*)(ws + WS_RC), (f16*)(ws + WS_KS), (f16*)(ws + WS_VST), (f16*)(ws + WS_KW), (f16*)(ws + WS_VWT), (f16*)(ws + WS_QN), (f16*)(ws + WS_QR), (float*)(ws + WS_GATES), (const float*)(ws + WS_ROPE)};
            pg8::gemm_phase<pg8::EpiProj, pg8::StaticOrder, PG8_ALIGN, PG8_SP2>(lds, g, S, E);
            if constexpr (L == 2) {
                if (G == 256 && bx >= 160) {
                    pg8::Gemm g2{(const f16*)(ws + WS_RC), (const f16*)(ws + WS_CW1), 272 * 256, 1024, 2048}; pg8::CmpOrder S2{1 << 20, 448 + (bx - 160), 544};
                    pg8::EpiF16 E2{(f16*)(ws + WS_PROJ), 512, 1};
                    pg8::gemm_phase<pg8::EpiF16, pg8::CmpOrder, PG8_ALIGN, PG8_SP2>(lds, g2, S2, E2);
                }
            }
            if constexpr (L == 3) pgates_phase(lds, Wt, (const f16*)(ws + WS_X), (float*)(ws + WS_GATES), vcu, G, tid);
            sgemm_phase<3>(lds, Wt, (L == 2) ? N : NQGP, DM, (const f16*)(ws + WS_AS0), p, L, L == 2 ? NKV : 0, vcu, G, tid);
        }
        PAD_END(0) SEAM(base + 0);
    }
    if constexpr (L <= 2) {
        if (IN(base + 1)) { PAD_BEGIN(1)
            if constexpr (L < 2) {
                const f16* Wt = (const f16*)(ws + WS_WGLU) + (size_t)L * DM * DM;
                pg8::Gemm g{(const f16*)(ws + WS_A1), Wt, MP, DM, DM}; pg8::StaticOrder S; S.init(MP, DM, G, bx);
                pg8::EpiGLU E{(f16*)(ws + WS_Y), (const f16*)(ws + WS_A1), p.in[18] + (size_t)L * DM};
                if (SG_FIRST && (bx & 1)) { sgemm_phase<0>(lds, Wt, DM, DM, (const f16*)(ws + WS_AS1), p, L, 0, vcu, G, tid); }
                pg8::gemm_phase<pg8::EpiGLU, pg8::StaticOrder, PG8_ALIGN, PG8_SP2>(lds, g, S, E);
                if (!(SG_FIRST && (bx & 1))) { sgemm_phase<0>(lds, Wt, DM, DM, (const f16*)(ws + WS_AS1), p, L, 0, vcu, G, tid); }
            } else {
                pg8::Gemm g{(const f16*)(ws + WS_RC), (const f16*)(ws + WS_CW1), 272 * 256, 1024, 2048}; pg8::CmpOrder S{G, bx, G == 256 ? 448 : 544};
                pg8::EpiF16 E{(f16*)(ws + WS_PROJ), 512, 1};
                pg8::gemm_phase<pg8::EpiF16, pg8::CmpOrder, PG8_ALIGN, PG8_SP2>(lds, g, S, E);
            }
            PAD_END(1) SEAM(base + 1);
        }
    }
    if constexpr (L == 2) {
        if (IN(base + 2)) { PAD_BEGIN(2)
            for (int u = vcu; u < 544; u += G) cmp2_unit(lds, u, p, tid);
            PAD_END(2) SEAM(base + 2);
        }
    }
    if constexpr (L >= 2) {
        if (IN(base + 3)) { PAD_BEGIN(3)
            { const int xq = bx & 7;
              unsigned* qctr = (unsigned*)(ws + WS_CTL) + 2048 + 64 * ((L - 2) * 8 + xq);
              volatile LAS unsigned* qslot = (volatile LAS unsigned*)(lds + LDS_XB) + 2;
              for (;;) {
                  if (tid == 0) qslot[0] = __hip_atomic_fetch_add(qctr, 1u, __ATOMIC_RELAXED, __HIP_MEMORY_SCOPE_AGENT);
                  __syncthreads();
                  const int it = (int)qslot[0];
                  __syncthreads();
                  if (it >= 80) break;
                  if (it >= SQ0 && it < SQ0 + 16) attn_sample_unit(lds, xq * 16 + (it - SQ0), p, tid);
                  else attn_prompt_tile(lds, xq >> 2, xq & 3, 63 - (it < SQ0 ? it : it - 16), p, tid);
              } }
            PAD_END(3) SEAM(base + 3);
        }
        if (IN(base + 5)) { PAD_BEGIN(5)
            const f16* Wt = (const f16*)(ws + WS_WO) + (size_t)(L - 2) * DM * DM;
            pg8::Gemm g{(const f16*)(ws + WS_A1), Wt, MP, DM, DM}; pg8::StaticOrder S; S.init(MP, DM, G, bx);
            pg8::EpiF16 E{(f16*)(ws + WS_Y), DM, 0x7fffffff};
            if (SG_FIRST && (bx & 1)) { sgemm_phase<2>(lds, Wt, DM, DM, (const f16*)(ws + WS_AS1), p, L, 0, vcu, G, tid); }
            pg8::gemm_phase<pg8::EpiF16, pg8::StaticOrder, PG8_ALIGN, PG8_SP2>(lds, g, S, E);
            if (!(SG_FIRST && (bx & 1))) { sgemm_phase<2>(lds, Wt, DM, DM, (const f16*)(ws + WS_AS1), p, L, 0, vcu, G, tid); }
            PAD_END(5) SEAM(base + 5);
        }
    }
    if (IN(base + 6)) { PAD_BEGIN(6)
        const float* gpost = (L < 2) ? p.in[19] + (size_t)L * DM : p.in[31] + (size_t)(L - 2) * DM;
        resnorm2_rows<(L == 0), 1>((const f16*)(ws + WS_Y), gpost, p.in[0], (f16*)(ws + WS_X), (float*)(ws + WS_RS), nullptr, nullptr, nullptr, gw, NGW, MP, lane);
        if (gw < MS) resnorm_row((const float*)(ws + WS_YS), gpost, (L == 0) ? p.in[1] : (const float*)(ws + WS_XS), (float*)(ws + WS_XS), 1, nullptr, (f16*)(ws + WS_AS0), nullptr, gw, lane);
        PAD_END(6) SEAM(base + 6);
    }
    if (IN(base + 7)) { PAD_BEGIN(7)
        const f16* Wt = (const f16*)(ws + WS_WUP) + (size_t)L * DM * FF;
        pg8::Gemm g{(const f16*)(ws + WS_X), Wt, MP, FF, DM}; pg8::StaticOrder S; S.init(MP, FF, G, bx);
        pg8::EpiRelu2 E{(f16*)(ws + WS_H), FF};
        if (SG_FIRST && (bx & 1)) { sgemm_phase<1>(lds, Wt, FF, DM, (const f16*)(ws + WS_AS0), p, L, 0, vcu, G, tid); }
        pg8::gemm_phase<pg8::EpiRelu2, pg8::StaticOrder, PG8_ALIGN, PG8_SP2>(lds, g, S, E);
        if (!(SG_FIRST && (bx & 1))) { sgemm_phase<1>(lds, Wt, FF, DM, (const f16*)(ws + WS_AS0), p, L, 0, vcu, G, tid); }
        PAD_END(7) SEAM(base + 7);
    }
    if (IN(base + 8)) { PAD_BEGIN(8)
        const f16* Wt = (const f16*)(ws + WS_WDN) + (size_t)L * DM * FF;
        pg8::Gemm g{(const f16*)(ws + WS_H), Wt, MP, DM, FF}; pg8::StaticOrder S; S.init(MP, DM, G, bx);
        pg8::EpiF16 E{(f16*)(ws + WS_Y), DM, 0x7fffffff};
        if (SG_FIRST && (bx & 1)) { sgemm_phase<2>(lds, Wt, DM, FF, (const f16*)(ws + WS_HS), p, L, 0, vcu, G, tid); }
        pg8::gemm_phase<pg8::EpiF16, pg8::StaticOrder, PG8_ALIGN, PG8_SP2>(lds, g, S, E);
        if (!(SG_FIRST && (bx & 1))) { sgemm_phase<2>(lds, Wt, DM, FF, (const f16*)(ws + WS_HS), p, L, 0, vcu, G, tid); }
        PAD_END(8) SEAM(base + 8);
    }
    if (IN(base + 9)) { PAD_BEGIN(9)
        const float* gpost = p.in[35] + (size_t)L * DM;
        if constexpr (L == 0) resnorm2_rows<false, 2>((const f16*)(ws + WS_Y), gpost, nullptr, (f16*)(ws + WS_X), (float*)(ws + WS_RS), nullptr, p.in[8] + DM, (f16*)(ws + WS_A0), gw, NGW, MP, lane);
        else if constexpr (L < 3) resnorm2_rows<false, 1>((const f16*)(ws + WS_Y), gpost, nullptr, (f16*)(ws + WS_X), (float*)(ws + WS_RS), nullptr, nullptr, nullptr, gw, NGW, MP, lane);
        else resnorm2_rows<false, 0>((const f16*)(ws + WS_Y), gpost, nullptr, (f16*)(ws + WS_X), (float*)(ws + WS_RS), p.out + O_YP, nullptr, nullptr, gw, NGW, MP, lane);
        if (gw < MS) {
            if constexpr (L == 0) resnorm_row((const float*)(ws + WS_YS), gpost, (const float*)(ws + WS_XS), (float*)(ws + WS_XS), 3, p.in[8] + DM, nullptr, (float*)(ws + WS_XNS), gw, lane);
            else if constexpr (L < 3) resnorm_row((const float*)(ws + WS_YS), gpost, (const float*)(ws + WS_XS), (float*)(ws + WS_XS), 1, nullptr, (f16*)(ws + WS_AS0), nullptr, gw, lane);
            else resnorm_row((const float*)(ws + WS_YS), gpost, (const float*)(ws + WS_XS), p.out + O_YS, 0, nullptr, nullptr, nullptr, gw, lane);
        }
        PAD_END(9) SEAM(base + 9);
    }
}
__global__ void __launch_bounds__(512, 2) mk_fwd(Params p) {
    extern __shared__ __attribute__((aligned(16))) unsigned char lds_raw[];
    LAS unsigned char* lds = (LAS unsigned char*)lds_raw;
    const int tid = threadIdx.x;
    const int G = gridDim.x, bx = blockIdx.x, vcu = (G % 8 == 0) ? (bx % 8) * (G / 8) + bx / 8 : bx;
    if (tid < 4) ((LAS unsigned*)(lds + LDS_XB))[tid] = 0u;
    __syncthreads();
    const int lo = p.ph_lo, hi = p.ph_hi;
    const bool use_bar = (hi - lo) > 1;
    XcdBarrier bar; bar.bar = (unsigned*)(p.ws + WS_CTL) + CW_BAR; bar.x = 0; bar.st = (volatile LAS unsigned*)(lds + LDS_XB);
    if (use_bar) bar = xcd_barrier_post((unsigned*)(p.ws + WS_CTL) + CW_BAR, (volatile LAS unsigned*)(lds + LDS_XB));
    if (IN(0)) { constexpr int L = 0; PAD_BEGIN(10) ph_prologue(p, lds, vcu, G, tid); if (REP_PRO > 1) { __syncthreads(); ph_prologue(p, lds, vcu, G, tid); } PAD_END(10) SEAM(0); }
    layer_phases<0>(p, lds, bar, use_bar, lo, hi, tid, G, bx, vcu);
    layer_phases<1>(p, lds, bar, use_bar, lo, hi, tid, G, bx, vcu);
    layer_phases<2>(p, lds, bar, use_bar, lo, hi, tid, G, bx, vcu);
    layer_phases<3>(p, lds, bar, use_bar, lo, hi, tid, G, bx, vcu);
}
#undef IN
#undef SEAM

#ifndef MK_MULTI_LAUNCH
#define MK_MULTI_LAUNCH 0
#endif
extern "C" void kernel_launch(void* const* d_in, const int* in_sizes, int n_in, void* d_out, int out_size, void* d_ws, size_t ws_size, hipStream_t stream) {
    static int grid = 0;
    if (grid == 0) {
        if (n_in != 36 || (size_t)out_size != O_END || ws_size < WS_END) { fprintf(stderr, "kernel_launch: unexpected shapes: n_in %d out %d ws %zu (need %zu)\n", n_in, out_size, ws_size, (size_t)WS_END); grid = -1; return; }
        int dev = 0, cus = 0, per_cu = 0;
        if (hipGetDevice(&dev) != hipSuccess || hipDeviceGetAttribute(&cus, hipDeviceAttributeMultiprocessorCount, dev) != hipSuccess) { grid = -1; return; }
        if (hipFuncSetAttribute((const void*)mk_fwd, hipFuncAttributeMaxDynamicSharedMemorySize, LDS_BYTES) != hipSuccess) { fprintf(stderr, "kernel_launch: hipFuncSetAttribute failed\n"); grid = -1; return; }
        if (hipOccupancyMaxActiveBlocksPerMultiprocessor(&per_cu, (const void*)mk_fwd, 512, LDS_BYTES) != hipSuccess || per_cu < 1) fprintf(stderr, "kernel_launch: occupancy query reports %d\n", per_cu);
        (void)hipGetLastError();
        grid = cus;
    }
    if (grid < 0) return;
    (void)hipMemsetAsync((char*)d_ws + WS_CTL, 0, CTL_BYTES, stream);
    Params P{};
    for (int i = 0; i < 36; ++i) P.in[i] = (const float*)d_in[i];
    P.out = (float*)d_out; P.ws = (unsigned char*)d_ws;
    for (int i = 0; i < 16; ++i) P.inv_freq[i] = powf(500000.0f, -(float)i / 16.0f);
#if MK_MULTI_LAUNCH
    for (int ph = 0; ph < NPHASE; ++ph) { if (!phase_active(ph)) continue; P.ph_lo = ph; P.ph_hi = ph + 1; hipLaunchKernelGGL(mk_fwd, dim3(grid), dim3(512), LDS_BYTES, stream, P); }
#else
    P.ph_lo = 0; P.ph_hi = NPHASE;
    hipLaunchKernelGGL(mk_fwd, dim3(grid), dim3(512), LDS_BYTES, stream, P);
#endif
    const hipError_t le = hipPeekAtLastError();
    if (le != hipSuccess) fprintf(stderr, "kernel_launch: launch failed: %s\n", hipGetErrorName(le));
}
```

```cpp
#include <hip/hip_runtime.h>
#include <cstdio>
#include <cmath>

#define LAS __attribute__((address_space(3)))
#define GAS __attribute__((address_space(1)))
typedef _Float16 f16;
typedef f16 f16x8 __attribute__((ext_vector_type(8)));
typedef f16 f16x4 __attribute__((ext_vector_type(4)));
typedef f16 f16x2 __attribute__((ext_vector_type(2)));
typedef float f32x2 __attribute__((ext_vector_type(2)));
typedef float f32x4 __attribute__((ext_vector_type(4)));
typedef float f32x16 __attribute__((ext_vector_type(16)));
typedef unsigned u32x4 __attribute__((ext_vector_type(4)));
typedef unsigned u32x2 __attribute__((ext_vector_type(2)));
#define LDS_WAIT() asm volatile("s_waitcnt lgkmcnt(0)" ::: "memory")
#define VM_WAIT() asm volatile("s_waitcnt vmcnt(0)" ::: "memory")

constexpr int DM = 2048, FF = 8192, SEQ = 4096, NBP = 2, MP = NBP * SEQ;
constexpr int NBS = 8, LS = 4, MS = NBS * LS;
constexpr int PAST = 16384, NPAGES = 128, PAGE = 128;
constexpr int NG = 128, NST = 64;
constexpr int NQG = 2096, NQGP = 2304, NKV = 3072;
constexpr float EPS = 1e-6f;
constexpr float QSCALE = 0.08838834764831845f;
constexpr float LOG2E = 1.4426950408889634f;

constexpr size_t O_YP = 0, O_YS = O_YP + (size_t)MP * DM, O_CMPP = O_YS + (size_t)MS * DM, O_CMPS = O_CMPP + (size_t)MP * 1024,
                 O_SLCP = O_CMPS + (size_t)MS * 1024, O_SLCS = O_SLCP + (size_t)MP * 1024, O_SWAP = O_SLCS + (size_t)MS * 1024,
                 O_SWAS = O_SWAP + (size_t)NBP * 512 * 1024, O_REP = O_SWAS + (size_t)NBS * 512 * 1024, O_IMP = O_REP + 2 * NBP * NG * NST,
                 O_RES = O_IMP + 2 * NBP * NG * NST, O_IMS = O_RES + 2 * NBS * NG * NST, O_END = O_IMS + 2 * NBS * NG * NST;

constexpr size_t al256(size_t x) { return (x + 255) & ~(size_t)255; }
constexpr size_t WS_CTL = 0, CTL_BYTES = 1u << 20;
constexpr size_t WS_WGLU = WS_CTL + CTL_BYTES;
constexpr size_t WS_WUP = WS_WGLU + (size_t)2 * DM * DM * 2;
constexpr size_t WS_WDN = WS_WUP + (size_t)4 * FF * DM * 2;
constexpr size_t WS_WKVQG = WS_WDN + (size_t)4 * FF * DM * 2;
constexpr size_t WS_WQG1 = WS_WKVQG + (size_t)(NKV + NQGP) * DM * 2;
constexpr size_t WS_WO = WS_WQG1 + (size_t)NQGP * DM * 2;
constexpr size_t WS_CW1 = WS_WO + (size_t)2 * DM * DM * 2;
constexpr size_t WS_CW2 = WS_CW1 + (size_t)2 * 512 * 2048 * 2;
constexpr size_t WS_BST = WS_CW2 + (size_t)2 * 128 * 256 * 2;
constexpr size_t WS_CCT = WS_BST + (size_t)2 * NG * 128 * 16 * 2;
constexpr size_t WS_AT = WS_CCT + (size_t)2 * NG * 16 * 128 * 2;
constexpr size_t WS_BBF = WS_AT + (size_t)2 * NG * NST * 2 * 4;
constexpr size_t WS_DT = WS_BBF + (size_t)2 * NG * NST * 32 * 4;
constexpr size_t WS_ROPE = WS_DT + 1024;
constexpr size_t WS_PE = al256(WS_ROPE + (size_t)4100 * 32 * 4);
constexpr size_t WS_X = WS_PE + 2048;
constexpr size_t WS_Y = WS_X + (size_t)MP * DM * 4;
constexpr size_t WS_A0 = WS_Y + (size_t)MP * DM * 4;
constexpr size_t WS_A1 = WS_A0 + (size_t)MP * DM * 2;
constexpr size_t WS_H = WS_A1 + (size_t)MP * DM * 2;
constexpr size_t WS_QN = WS_H + (size_t)MP * FF * 2;
constexpr size_t WS_QR = WS_QN + (size_t)MP * DM * 2;
constexpr size_t WS_GATES = WS_QR + (size_t)MP * DM * 2;
constexpr size_t WS_RC = WS_GATES + (size_t)MP * 48 * 4;
constexpr size_t RC_P_ELEMS = (size_t)2 * 2 * 4 * 4096 * 128, RC_S_ELEMS = (size_t)2 * 8 * 4 * 16384 * 128;
constexpr size_t WS_KS = WS_RC + (RC_P_ELEMS + RC_S_ELEMS) * 2;
constexpr size_t KVB = (size_t)2 * 4 * 4096 * 128 * 2;
constexpr size_t WS_VST = WS_KS + KVB, WS_KW = WS_VST + KVB, WS_VWT = WS_KW + KVB;
constexpr size_t WS_PROJ = WS_VWT + KVB;
constexpr size_t WS_KC = WS_PROJ + (size_t)(4096 + 65536) * 512 * 4;
constexpr size_t WS_VCT = WS_KC + (size_t)8 * 256 * 128 * 2;
constexpr size_t WS_KCS = WS_VCT + (size_t)8 * 256 * 128 * 2;
constexpr size_t WS_VCS = WS_KCS + (size_t)32 * 1024 * 128 * 2;
constexpr size_t WS_XS = WS_VCS + (size_t)32 * 1024 * 128 * 2;
constexpr size_t WS_YS = WS_XS + (size_t)MS * DM * 4;
constexpr size_t WS_XNS = WS_YS + (size_t)MS * DM * 4;
constexpr size_t WS_AS0 = WS_XNS + (size_t)MS * DM * 4;
constexpr size_t WS_AS1 = WS_AS0 + (size_t)MS * DM * 2;
constexpr size_t WS_HS = WS_AS1 + (size_t)MS * DM * 2;
constexpr size_t WS_QNS = WS_HS + (size_t)MS * FF * 2;
constexpr size_t WS_QRS = WS_QNS + (size_t)MS * DM * 4;
constexpr size_t WS_GATESS = WS_QRS + (size_t)MS * DM * 4;
constexpr size_t WS_MI = al256(WS_GATESS + (size_t)MS * 48 * 4);
constexpr size_t WS_W1 = WS_MI + (size_t)2 * NG * 128 * 256 * 2;
constexpr size_t WS_KT = WS_W1 + (size_t)2 * NG * 256 * 128 * 2;
constexpr size_t WS_RS = WS_KT + (size_t)2 * NG * 4096 * 2;
constexpr size_t WS_END = WS_RS + (size_t)MP * 4;
constexpr int CW_BAR = 4096;

constexpr int LDS_BYTES = 155648;
constexpr int LDS_XB = 155632;

struct Params {
    const float* in[36];
    float* out;
    unsigned char* ws;
    float inv_freq[16];
    int ph_lo, ph_hi;
};

#define DPP_F(v, ctrl) __builtin_bit_cast(float, __builtin_amdgcn_update_dpp(__builtin_bit_cast(int, v), __builtin_bit_cast(int, v), ctrl, 0xf, 0xf, false))
__device__ __forceinline__ float wave_sum(float v) {
    v += __builtin_bit_cast(float, __builtin_amdgcn_update_dpp(0, __builtin_bit_cast(int, v), 0x111, 0xf, 0xf, false));
    v += __builtin_bit_cast(float, __builtin_amdgcn_update_dpp(0, __builtin_bit_cast(int, v), 0x112, 0xf, 0xf, false));
    v += __builtin_bit_cast(float, __builtin_amdgcn_update_dpp(0, __builtin_bit_cast(int, v), 0x114, 0xf, 0xf, false));
    v += __builtin_bit_cast(float, __builtin_amdgcn_update_dpp(0, __builtin_bit_cast(int, v), 0x118, 0xf, 0xf, false));
    v += __builtin_bit_cast(float, __builtin_amdgcn_update_dpp(0, __builtin_bit_cast(int, v), 0x142, 0xa, 0xf, false));
    v += __builtin_bit_cast(float, __builtin_amdgcn_update_dpp(0, __builtin_bit_cast(int, v), 0x143, 0xc, 0xf, false));
    return __builtin_bit_cast(float, __builtin_amdgcn_readlane(__builtin_bit_cast(int, v), 63));
}
__device__ __forceinline__ float wave_max(float v) {
    v = fmaxf(v, DPP_F(v, 0x111)); v = fmaxf(v, DPP_F(v, 0x112)); v = fmaxf(v, DPP_F(v, 0x114)); v = fmaxf(v, DPP_F(v, 0x118));
    v = fmaxf(v, __builtin_bit_cast(float, __builtin_amdgcn_update_dpp(__builtin_bit_cast(int, v), __builtin_bit_cast(int, v), 0x142, 0xa, 0xf, false)));
    v = fmaxf(v, __builtin_bit_cast(float, __builtin_amdgcn_update_dpp(__builtin_bit_cast(int, v), __builtin_bit_cast(int, v), 0x143, 0xc, 0xf, false)));
    return __builtin_bit_cast(float, __builtin_amdgcn_readlane(__builtin_bit_cast(int, v), 63));
}
__device__ __forceinline__ float sigmoidf_(float x) { return __builtin_amdgcn_rcpf(1.0f + __expf(-x)); }
__device__ __forceinline__ float gelu_tanh(float y) { const float z = 0.7978845608028654f * (y + 0.044715f * y * y * y); return y * __builtin_amdgcn_rcpf(1.0f + __expf(-2.0f * z)); }

__device__ __forceinline__ f16x4 cvt4(const f32x4 v) { f16x4 r; r[0] = (f16)v[0]; r[1] = (f16)v[1]; r[2] = (f16)v[2]; r[3] = (f16)v[3]; return r; }
#ifndef WT_STORES
#define WT_STORES 0
#endif
struct WtBuf { __amdgpu_buffer_rsrc_t r; unsigned char* base; };
__device__ __forceinline__ WtBuf wt_make(void* base, unsigned nbytes) {
    const unsigned long long u = (unsigned long long)base;
    const unsigned lo = (unsigned)__builtin_amdgcn_readfirstlane((int)(unsigned)u), hi = (unsigned)__builtin_amdgcn_readfirstlane((int)(unsigned)(u >> 32));
    unsigned char* b = (unsigned char*)(((unsigned long long)hi << 32) | lo);
    WtBuf w; w.r = __builtin_amdgcn_make_buffer_rsrc(b, 0, (int)nbytes, 0x00020000); w.base = b; return w;
}
__device__ __forceinline__ void wt_st16(const WtBuf& w, unsigned off, f16x8 v) { if (WT_STORES) __builtin_amdgcn_raw_buffer_store_b128(__builtin_bit_cast(u32x4, v), w.r, (int)off, 0, 16); else *(f16x8*)(w.base + off) = v; }
__device__ __forceinline__ void wt_st8(const WtBuf& w, unsigned off, f16x4 v) { if (WT_STORES) __builtin_amdgcn_raw_buffer_store_b64(__builtin_bit_cast(u32x2, v), w.r, (int)off, 0, 16); else *(f16x4*)(w.base + off) = v; }
#define XB_TMO      128
#define XB_XCNT(j)  (256  + 64 * (j))
#define XB_XSUB(j)  (1280 + 64 * (j))
#define XB_XGEN(j)  (2304 + 64 * (j))
#define XB_TOP      3328
#define XB_TOPGEN   3392
#define XCD_BAR_WORDS 3456
#define XB_SPIN_CAP (1u << 22)
__device__ __forceinline__ unsigned xb_ld(unsigned* p)              { return __hip_atomic_load(p, __ATOMIC_RELAXED, __HIP_MEMORY_SCOPE_AGENT); }
__device__ __forceinline__ unsigned xb_add(unsigned* p, unsigned v) { return __hip_atomic_fetch_add(p, v, __ATOMIC_RELAXED, __HIP_MEMORY_SCOPE_AGENT); }
__device__ __forceinline__ unsigned xb_xcc_id() { return (unsigned)__builtin_amdgcn_s_getreg((3 << 11) | 20) & 0xFu; }
#define XB_SPIN(cond, bar) do { unsigned _sp = 0; while (cond) { __builtin_amdgcn_s_sleep(1); \
    if ((++_sp & 255u) == 0u) { if (xb_ld(&(bar)[XB_TMO])) break; if (_sp > XB_SPIN_CAP) { atomicAdd(&(bar)[XB_TMO], 1u); break; } } } } while (0)
struct XcdBarrier { unsigned* bar; unsigned x; volatile LAS unsigned* st; };
__device__ __forceinline__ XcdBarrier xcd_barrier_post(unsigned* bar, volatile LAS unsigned* st) {
    XcdBarrier b; b.bar = bar; b.x = xb_xcc_id(); b.st = st;
    if (threadIdx.x == 0) (void)xb_add(&bar[XB_XCNT(b.x)], 1u);
    return b;
}
__device__ __forceinline__ void xcd_barrier_complete(unsigned* bar, unsigned x, unsigned& nloc, unsigned& nx) {
    const unsigned G = gridDim.x * gridDim.y * gridDim.z;
    unsigned sum, cnt, mine, sp = 0u;
    for (;;) {
        sum = 0u; cnt = 0u; mine = 0u;
#pragma unroll
        for (unsigned j = 0; j < 16; ++j) { const unsigned c = xb_ld(&bar[XB_XCNT(j)]); sum += c; cnt += (c > 0u) ? 1u : 0u; mine = (j == x) ? c : mine; }
        if (sum == G) break;
        __builtin_amdgcn_s_sleep(1);
        if ((++sp & 255u) == 0u) { if (xb_ld(&bar[XB_TMO])) break; if (sp > XB_SPIN_CAP) { atomicAdd(&bar[XB_TMO], 1u); break; } }
    }
    nloc = mine > 0u ? mine : 1u; nx = cnt > 0u ? cnt : 1u;
}
__device__ __forceinline__ void xcd_barrier(const XcdBarrier& b) {
    asm volatile("s_waitcnt vmcnt(0)" ::: "memory");
    __syncthreads();
    if (threadIdx.x == 0) {
        unsigned* bar = b.bar;
        __builtin_amdgcn_s_waitcnt(0);
        unsigned nloc = b.st[0], nx = b.st[1];
        if (nloc == 0u) { xcd_barrier_complete(bar, b.x, nloc, nx); b.st[0] = nloc; b.st[1] = nx; }
        const unsigned old = xb_add(&bar[XB_XSUB(b.x)], 1u);
        const unsigned gen = old / nloc;
        if (old + 1u == (gen + 1u) * nloc) {
            __builtin_amdgcn_fence(__ATOMIC_RELEASE, "agent");
            asm volatile("s_waitcnt vmcnt(0)" ::: "memory");
            const unsigned og = xb_add(&bar[XB_TOP], 1u);
            const unsigned tg = og / nx;
            if (og + 1u == (tg + 1u) * nx) xb_add(&bar[XB_TOPGEN], 1u);
            else XB_SPIN(xb_ld(&bar[XB_TOPGEN]) == tg, bar);
            __builtin_amdgcn_fence(__ATOMIC_ACQUIRE, "agent");
            xb_add(&bar[XB_XGEN(b.x)], 1u);
            asm volatile("s_waitcnt vmcnt(0)" ::: "memory");
        } else {
            XB_SPIN(xb_ld(&bar[XB_XGEN(b.x)]) == gen, bar);
            __builtin_amdgcn_fence(__ATOMIC_ACQUIRE, "agent");
            asm volatile("s_waitcnt vmcnt(0)" ::: "memory");
        }
    }
    __syncthreads();
}
#ifndef PG8_WGM
#define PG8_WGM 2
#endif
namespace pg8 {
#define PG8_LAS __attribute__((address_space(3)))
typedef f16 bf16_t;
typedef f16x8 bf16x8;
constexpr int BM = 256, BK = 64, HALF = 128, HTB = HALF * BK * 2  , STAGE_BYTES = 8 * HTB, NXCD = 8, WGM = PG8_WGM;

__host__ __device__ __forceinline__ int lds_byte(int r, int c) { const int st = (r >> 4) * 2 + (c >> 5), rr = r & 15, cc = c & 31, ob = rr * 64 + cc * 2; return st * 1024 + (ob ^ (((ob >> 9) & 1) << 5)); }
__host__ __device__ __forceinline__ void stage_rc(int b, int& R, int& C) { const int st = b / 1024, sb = b % 1024, swz = sb ^ (((sb >> 9) & 1) << 5); R = (st >> 1) * 16 + swz / 64; C = (st & 1) * 32 + (swz % 64) / 2; }
__host__ __device__ __forceinline__ int perm32(int rho) { const int n = rho >> 4, i = rho & 15; return 8 * (i >> 2) + 4 * n + (i & 3); }

struct Unit { int pm, pn; };
struct Gemm { const bf16_t* A; const bf16_t* Bt; int M, N, K; };

struct StaticOrder {
    int nM, nN, nwg, G, c;
    __host__ __device__ void init(int M, int N, int G_, int c_) { nM = M / BM; nN = N / BM; nwg = nM * nN; G = G_; c = c_; }
    __host__ __device__ bool next(int i, Unit& u) const {
        const long L = (long)i * G + c; if (L >= nwg) return false;
        int wgid = (int)L; { const int q = nwg / NXCD, r = nwg % NXCD, xcd = wgid % NXCD, off = wgid / NXCD; wgid = (xcd < r ? xcd * (q + 1) : r * (q + 1) + (xcd - r) * q) + off; }
        const int nig = WGM * nN, gid = wgid / nig, fm = gid * WGM, gsz = (nM - fm) < WGM ? (nM - fm) : WGM;
        u.pm = fm + ((wgid % nig) % gsz); u.pn = (wgid % nig) / gsz; return true;
    }
    __device__ __forceinline__ void a_ready(const Unit&) const {}
    __device__ __forceinline__ void done(const Unit&) const {}
};

struct EpiF32 {
    static constexpr bool PERM = false, AFTER_DRAIN = false;
    float* C; int ldc; int pn_mask;
    __device__ __forceinline__ void operator()(const f32x4 (&acc)[2][2][4][2], const Unit& u, int wr, int wc, int fr, int fq) const {
        const int row0 = u.pm * BM + wr * 64 + fr, col0 = (u.pn & pn_mask) * BM + wc * 32 + 4 * fq;
#pragma unroll
        for (int ai = 0; ai < 2; ++ai)
#pragma unroll
            for (int m = 0; m < 4; ++m) { float* rowp = C + (size_t)(row0 + ai * HALF + m * 16) * ldc + col0;
#pragma unroll
                for (int bj = 0; bj < 2; ++bj)
#pragma unroll
                    for (int n = 0; n < 2; ++n) *(f32x4*)(rowp + bj * HALF + n * 16) = acc[ai][bj][m][n]; }
    }
};
struct EpiGLU {
    static constexpr bool PERM = true, AFTER_DRAIN = false;
    f16* C; const f16* Y; const float* bias;
    __device__ __forceinline__ void operator()(const f32x4 (&acc)[2][2][4][2], const Unit& u, int wr, int wc, int fr, int fq) const {
        const int row0 = u.pm * BM + wr * 64 + fr, col0 = u.pn * BM + wc * 32 + 8 * fq;
        const WtBuf wb = wt_make(C, (unsigned)MP * DM * 2);
        f32x4 bv[2][2];
#pragma unroll
        for (int bj = 0; bj < 2; ++bj)
#pragma unroll
            for (int n = 0; n < 2; ++n) bv[bj][n] = *(const f32x4*)(bias + col0 + bj * HALF + 4 * n);
#pragma unroll
        for (int ai = 0; ai < 2; ++ai)
#pragma unroll
            for (int m = 0; m < 4; ++m) { const size_t off = (size_t)(row0 + ai * HALF + m * 16) * DM + col0;
#pragma unroll
                for (int bj = 0; bj < 2; ++bj) { const f16x8 y = *(const f16x8*)(Y + off + bj * HALF); const f32x4 v0 = acc[ai][bj][m][0] + bv[bj][0], v1 = acc[ai][bj][m][1] + bv[bj][1]; f16x8 o;
#pragma unroll
                    for (int i = 0; i < 4; ++i) { o[i] = (f16)((float)y[i] * sigmoidf_(v0[i])); o[4 + i] = (f16)((float)y[4 + i] * sigmoidf_(v1[i])); }
                    wt_st16(wb, (unsigned)((off + bj * HALF) * 2), o); } }
    }
};
struct EpiF16 {
    static constexpr bool PERM = true, AFTER_DRAIN = false;
    f16* O; int ldc; int pn_mask;
    __device__ __forceinline__ void operator()(const f32x4 (&acc)[2][2][4][2], const Unit& u, int wr, int wc, int fr, int fq) const {
        const int row0 = u.pm * BM + wr * 64 + fr, col0 = (u.pn & pn_mask) * BM + wc * 32 + 8 * fq;
        const WtBuf wb = wt_make(O, 0x7ffffff0u);
#pragma unroll
        for (int ai = 0; ai < 2; ++ai)
#pragma unroll
            for (int m = 0; m < 4; ++m) { const unsigned rowb = (unsigned)(((size_t)(row0 + ai * HALF + m * 16) * ldc + col0) * 2);
#pragma unroll
                for (int bj = 0; bj < 2; ++bj) { const f32x4 v0 = acc[ai][bj][m][0], v1 = acc[ai][bj][m][1]; f16x8 w;
#pragma unroll
                    for (int i = 0; i < 4; ++i) { w[i] = (f16)v0[i]; w[4 + i] = (f16)v1[i]; }
                    wt_st16(wb, rowb + bj * HALF * 2, w); } }
    }
};
struct EpiRelu2 {
    static constexpr bool PERM = true, AFTER_DRAIN = false;
    f16* O; int ldc;
    __device__ __forceinline__ void operator()(const f32x4 (&acc)[2][2][4][2], const Unit& u, int wr, int wc, int fr, int fq) const {
        const int row0 = u.pm * BM + wr * 64 + fr, col0 = u.pn * BM + wc * 32 + 8 * fq;
        const WtBuf wb = wt_make(O, 0x7ffffff0u);
#pragma unroll
        for (int ai = 0; ai < 2; ++ai)
#pragma unroll
            for (int m = 0; m < 4; ++m) { const unsigned rowb = (unsigned)(((size_t)(row0 + ai * HALF + m * 16) * ldc + col0) * 2);
#pragma unroll
                for (int bj = 0; bj < 2; ++bj) { const f32x4 v0 = acc[ai][bj][m][0], v1 = acc[ai][bj][m][1]; f16x8 w;
#pragma unroll
                    for (int i = 0; i < 4; ++i) { const float a = fmaxf(v0[i], 0.f), b = fmaxf(v1[i], 0.f); w[i] = (f16)(a * a); w[4 + i] = (f16)(b * b); }
                    wt_st16(wb, rowb + bj * HALF * 2, w); } }
    }
};
struct EpiProj {
    static constexpr bool PERM = false, AFTER_DRAIN = false;
    int nkv; float* out; f16 *RC, *KS, *VST, *KW, *VWT, *QN, *QR; float* GATES; const float* rope;
    __device__ __forceinline__ void operator()(const f32x4 (&acc)[2][2][4][2], const Unit& u, int wr, int wc, int fr, int fq) const {
        const int row0 = u.pm * BM + wr * 64 + fr, d0 = wc * 32 + 4 * fq, d1 = d0 + 16;
#pragma unroll
        for (int bj = 0; bj < 2; ++bj) {
            if (u.pn < nkv) {
                const int hh = 2 * u.pn + bj, br = hh >> 3, kv = (hh >> 2) & 1, g = hh & 3, cbase = kv * 512 + g * 128;
                const bool rot = (br >= 1) && (kv == 0) && (wc == 0);
#pragma unroll
                for (int ai = 0; ai < 2; ++ai)
#pragma unroll
                    for (int m = 0; m < 4; ++m) {
                        const int row = row0 + ai * HALF + m * 16, b = row >> 12, t = row & 4095;
                        f32x4 v0 = acc[ai][bj][m][0], v1 = acc[ai][bj][m][1];
                        if (rot) { const f32x4 cs = *(const f32x4*)(rope + (size_t)t * 32 + 4 * fq), sn = *(const f32x4*)(rope + (size_t)t * 32 + 16 + 4 * fq);
                            const f32x4 n0 = v0 * cs - v1 * sn, n1 = v1 * cs + v0 * sn; v0 = n0; v1 = n1; }
                        const f16x4 h0 = cvt4(v0), h1 = cvt4(v1);
                        if (br == 0) {
                            float* o = out + O_CMPP + (size_t)row * 1024 + cbase; *(f32x4*)(o + d0) = v0; *(f32x4*)(o + d1) = v1;
                            f16* r = RC + ((size_t)(((kv * 2 + b) * 4 + g) * 4096 + t)) * 128; *(f16x4*)(r + d0) = h0; *(f16x4*)(r + d1) = h1;
                        } else {
                            if (br == 1) { float* o = out + O_SLCP + (size_t)row * 1024 + cbase; *(f32x4*)(o + d0) = v0; *(f32x4*)(o + d1) = v1; }
                            else if (t >= SEQ - 512) { float* o = out + O_SWAP + ((size_t)(b * 512 + t - (SEQ - 512))) * 1024 + cbase; *(f32x4*)(o + d0) = v0; *(f32x4*)(o + d1) = v1; }
                            if (kv == 0) { f16* r = (br == 1 ? KS : KW) + ((size_t)((b * 4 + g) * 4096 + t)) * 128; *(f16x4*)(r + d0) = h0; *(f16x4*)(r + d1) = h1; }
                            else { const int tp = (t & 48) | ((t & 4) << 1) | ((t & 8) >> 1) | (t & 3);
                                f16* r = (br == 1 ? VST : VWT) + ((size_t)((b * 4 + g) * 64 + (t >> 6))) * 8192 + tp;
#pragma unroll
                                for (int i = 0; i < 4; ++i) { r[(d0 + i) * 64] = h0[i]; r[(d1 + i) * 64] = h1[i]; } }
                        }
                    }
            } else {
                const int c0 = (u.pn - nkv) * 256 + bj * 128;
                if (c0 < 2048) {
#pragma unroll
                    for (int ai = 0; ai < 2; ++ai)
#pragma unroll
                        for (int m = 0; m < 4; ++m) {
                            const int row = row0 + ai * HALF + m * 16, t = row & 4095;
                            f32x4 v0 = acc[ai][bj][m][0] * (QSCALE * LOG2E), v1 = acc[ai][bj][m][1] * (QSCALE * LOG2E);
                            f16* qn = QN + (size_t)row * DM + c0; *(f16x4*)(qn + d0) = cvt4(v0); *(f16x4*)(qn + d1) = cvt4(v1);
                            if (wc == 0) { const f32x4 cs = *(const f32x4*)(rope + (size_t)t * 32 + 4 * fq), sn = *(const f32x4*)(rope + (size_t)t * 32 + 16 + 4 * fq);
                                const f32x4 n0 = v0 * cs - v1 * sn, n1 = v1 * cs + v0 * sn;
                                f16* qr = QR + (size_t)row * 512 + (c0 >> 7) * 32; *(f16x4*)(qr + d0) = cvt4(n0); *(f16x4*)(qr + d1) = cvt4(n1); }
                        }
                } else if (c0 == 2048) {
#pragma unroll
                    for (int ai = 0; ai < 2; ++ai)
#pragma unroll
                        for (int m = 0; m < 4; ++m) {
                            const int row = row0 + ai * HALF + m * 16;
#pragma unroll
                            for (int n = 0; n < 2; ++n) { const int lc = wc * 32 + 16 * n + 4 * fq;
                                if (lc < 48) { const f32x4 v = acc[ai][bj][m][n]; f32x4 o;
#pragma unroll
                                    for (int i = 0; i < 4; ++i) o[i] = sigmoidf_(v[i]);
                                    *(f32x4*)(GATES + (size_t)row * 48 + lc) = o; } }
                        }
                }
            }
        }
    }
};
struct CmpOrder {
    int G, c, nunits;
    __device__ __forceinline__ bool next(int i, Unit& u) const {
        if (i > 0 && G > 65536) return false;
        const int idx = i * G + c; if (idx >= nunits) return false;
        const int pm = idx >> 1, kv = pm < 16 ? (pm >> 3) : ((pm - 16) >> 7);
        u.pm = pm; u.pn = (idx & 1) + 2 * kv; return true;
    }
    __device__ __forceinline__ void a_ready(const Unit&) const {}
    __device__ __forceinline__ void done(const Unit&) const {}
};

template <class Epi, class Sched, bool ALIGN_EPI = false, bool SP2 = false>
__device__ __forceinline__ void gemm_phase(PG8_LAS unsigned char* lds, const Gemm g, const Sched& S, const Epi& E) {
    const int tid = threadIdx.x, wid = __builtin_amdgcn_readfirstlane(tid >> 6), lane = tid & 63, wr = wid >> 2, wc = wid & 3, fr = lane & 15, fq = lane >> 4;
    const int K = g.K, nt = K / BK;
    unsigned voffA[2], voffB[2];
#pragma unroll
    for (int i = 0; i < 2; ++i) { int R, C; stage_rc(tid * 16 + i * 8192, R, C); const int Rb = Epi::PERM ? ((R & ~31) + perm32(R & 31)) : R;
        voffA[i] = (unsigned)(R * K + C) * 2u; voffB[i] = (unsigned)(Rb * K + C) * 2u; }
    const size_t kstep = (size_t)(BK * 2);
    const size_t hstep = (size_t)HALF * K * 2;
    const size_t tstep = 2 * hstep;
    const unsigned ldsw = (unsigned)wid * 1024u;
    const int aoff = lds_byte(wr * 64 + fr, fq * 8), boff = lds_byte(wc * 32 + fr, fq * 8);
#define PG8_SA(b, h) (((b) * 2 + (h)) * HTB)
#define PG8_SB(b, h) ((4 + (b) * 2 + (h)) * HTB)
#ifndef PG8_AUX
#define PG8_AUX 0
#endif
#define PG8_STAGE(bufoff, gbase, voff) do { _Pragma("unroll") for (int _i = 0; _i < 2; ++_i) \
        __builtin_amdgcn_global_load_lds((const unsigned*)((const char*)(gbase) + (voff)[_i]), (PG8_LAS unsigned*)(lds + (bufoff) + ldsw + _i * 8192), 16, 0, PG8_AUX); } while (0)
#define PG8_LDA(dst, b, h) do { _Pragma("unroll") for (int m = 0; m < 4; ++m) _Pragma("unroll") for (int k = 0; k < 2; ++k) dst[m][k] = *(const PG8_LAS bf16x8*)(lds + PG8_SA(b, h) + aoff + m * 2048 + k * 1024); } while (0)
#define PG8_LDB(dst, b, h) do { _Pragma("unroll") for (int n = 0; n < 2; ++n) _Pragma("unroll") for (int k = 0; k < 2; ++k) dst[n][k] = *(const PG8_LAS bf16x8*)(lds + PG8_SB(b, h) + boff + n * 2048 + k * 1024); } while (0)
#define PG8_MMA(ai, bj, At, Bt) do { __builtin_amdgcn_s_setprio(1); _Pragma("unroll") for (int m = 0; m < 4; ++m) _Pragma("unroll") for (int n = 0; n < 2; ++n) _Pragma("unroll") for (int k = 0; k < 2; ++k) \
        acc[ai][bj][m][n] = __builtin_amdgcn_mfma_f32_16x16x32_f16(Bt[n][k], At[m][k], acc[ai][bj][m][n], 0, 0, 0); __builtin_amdgcn_s_setprio(0); } while (0)
#define PG8_WAIT_V(n) asm volatile("s_waitcnt vmcnt(" #n ")" ::: "memory")
#define PG8_WAIT_L(n) asm volatile("s_waitcnt lgkmcnt(" #n ")" ::: "memory")
#define PG8_BAR __builtin_amdgcn_s_barrier()
#define PG8_SCHED __builtin_amdgcn_sched_barrier(0)
    Unit cur, nxt; int ui = 0;
    if (!S.next(0, cur)) return;
    f32x4 acc[2][2][4][2];
#pragma unroll
    for (int a = 0; a < 2; ++a)
#pragma unroll
        for (int b = 0; b < 2; ++b)
#pragma unroll
            for (int m = 0; m < 4; ++m)
#pragma unroll
                for (int n = 0; n < 2; ++n) acc[a][b][m][n] = (f32x4){0.f, 0.f, 0.f, 0.f};
    bf16x8 At[4][2], B0[2][2], B1[2][2];
    const char* cA = (const char*)g.A + (size_t)cur.pm * tstep; const char* cB = (const char*)g.Bt + (size_t)cur.pn * tstep;
    S.a_ready(cur);
    if constexpr (SP2) {
        PG8_STAGE(PG8_SB(0, 0), cB, voffB); PG8_STAGE(PG8_SB(0, 1), cB + hstep, voffB); PG8_STAGE(PG8_SA(0, 0), cA, voffA); PG8_STAGE(PG8_SA(0, 1), cA + hstep, voffA);
        if (wr == 1) PG8_BAR;
        PG8_WAIT_V(2); PG8_BAR;
        PG8_STAGE(PG8_SB(1, 0), cB + kstep, voffB); PG8_STAGE(PG8_SA(1, 0), cA + kstep, voffA); PG8_STAGE(PG8_SB(1, 1), cB + hstep + kstep, voffB);
        PG8_WAIT_V(6); PG8_BAR;
    } else {
        PG8_STAGE(PG8_SB(0, 0), cB, voffB); PG8_STAGE(PG8_SA(0, 0), cA, voffA); PG8_STAGE(PG8_SB(0, 1), cB + hstep, voffB); PG8_STAGE(PG8_SA(0, 1), cA + hstep, voffA);
        if (wr == 1) PG8_BAR;
        PG8_WAIT_V(4); PG8_BAR;
        PG8_STAGE(PG8_SB(1, 0), cB + kstep, voffB); PG8_STAGE(PG8_SA(1, 0), cA + kstep, voffA); PG8_STAGE(PG8_SB(1, 1), cB + hstep + kstep, voffB);
        PG8_WAIT_V(6); PG8_BAR;
    }
    for (;;) {
        const bool has_next = S.next(ui + 1, nxt);
        const char* nA = has_next ? (const char*)g.A + (size_t)nxt.pm * tstep : cA; const char* nB = has_next ? (const char*)g.Bt + (size_t)nxt.pn * tstep : cB;
        for (int t = 0; t < nt; t += 2) {
            const bool last = (t == nt - 2);
            const char* a1 = cA + (size_t)(t + 1) * kstep;
            const char* a2 = last ? nA : cA + (size_t)(t + 2) * kstep; const char* b2 = last ? nB : cB + (size_t)(t + 2) * kstep;
            const char* a3 = a2 + kstep; const char* b3 = b2 + kstep;
            if (last && has_next) S.a_ready(nxt);
            if constexpr (SP2) {
            PG8_LDB(B0, 0, 0); PG8_LDB(B1, 0, 1); PG8_SCHED; PG8_LDA(At, 0, 0); PG8_STAGE(PG8_SA(1, 1), a1 + hstep, voffA);
            PG8_WAIT_V(8); PG8_WAIT_L(0); PG8_BAR; PG8_MMA(0, 0, At, B0); PG8_MMA(0, 1, At, B1); PG8_BAR; PG8_SCHED;
            PG8_LDA(At, 0, 1); PG8_STAGE(PG8_SB(0, 0), b2, voffB); PG8_STAGE(PG8_SB(0, 1), b2 + hstep, voffB); PG8_STAGE(PG8_SA(0, 0), a2, voffA);
            PG8_WAIT_V(8); PG8_WAIT_L(0); PG8_BAR; PG8_MMA(1, 0, At, B0); PG8_MMA(1, 1, At, B1); PG8_BAR; PG8_SCHED;
            PG8_LDB(B0, 1, 0); PG8_LDB(B1, 1, 1); PG8_SCHED; PG8_LDA(At, 1, 0); PG8_STAGE(PG8_SA(0, 1), a2 + hstep, voffA);
            PG8_WAIT_V(8); PG8_WAIT_L(0); PG8_BAR; PG8_MMA(0, 0, At, B0); PG8_MMA(0, 1, At, B1); PG8_BAR; PG8_SCHED;
            PG8_LDA(At, 1, 1); PG8_STAGE(PG8_SB(1, 0), b3, voffB); PG8_STAGE(PG8_SB(1, 1), b3 + hstep, voffB); PG8_STAGE(PG8_SA(1, 0), a3, voffA);
            PG8_WAIT_V(8); PG8_WAIT_L(0); PG8_BAR; PG8_MMA(1, 0, At, B0); PG8_MMA(1, 1, At, B1); PG8_BAR; PG8_SCHED;
            } else {
            PG8_LDB(B0, 0, 0); PG8_SCHED; PG8_LDA(At, 0, 0); PG8_STAGE(PG8_SA(1, 1), a1 + hstep, voffA);
            PG8_WAIT_L(8); PG8_BAR; PG8_WAIT_L(0); PG8_MMA(0, 0, At, B0); PG8_BAR; PG8_SCHED;
            PG8_LDB(B1, 0, 1); PG8_STAGE(PG8_SB(0, 0), b2, voffB);
            PG8_BAR; PG8_WAIT_L(0); PG8_MMA(0, 1, At, B1); PG8_BAR;
            PG8_LDA(At, 0, 1); PG8_STAGE(PG8_SA(0, 0), a2, voffA);
            PG8_BAR; PG8_WAIT_L(0); PG8_MMA(1, 0, At, B0); PG8_BAR; PG8_SCHED;
            PG8_STAGE(PG8_SB(0, 1), b2 + hstep, voffB);
            PG8_WAIT_V(6); PG8_BAR; PG8_MMA(1, 1, At, B1); PG8_BAR;
            PG8_LDB(B0, 1, 0); PG8_SCHED; PG8_LDA(At, 1, 0); PG8_STAGE(PG8_SA(0, 1), a2 + hstep, voffA);
            PG8_WAIT_L(8); PG8_BAR; PG8_WAIT_L(0); PG8_MMA(0, 0, At, B0); PG8_BAR; PG8_SCHED;
            PG8_LDB(B1, 1, 1); PG8_STAGE(PG8_SB(1, 0), b3, voffB);
            PG8_BAR; PG8_WAIT_L(0); PG8_MMA(0, 1, At, B1); PG8_BAR;
            PG8_LDA(At, 1, 1); PG8_STAGE(PG8_SA(1, 0), a3, voffA);
            PG8_BAR; PG8_WAIT_L(0); PG8_MMA(1, 0, At, B0); PG8_BAR; PG8_SCHED;
            PG8_STAGE(PG8_SB(1, 1), b3 + hstep, voffB);
            PG8_WAIT_V(6); PG8_BAR; PG8_MMA(1, 1, At, B1); PG8_BAR;
            }
        }
        if constexpr (ALIGN_EPI) { if (wr == 0) PG8_BAR; }
        if constexpr (!Epi::AFTER_DRAIN) { E(acc, cur, wr, wc, fr, fq); S.done(cur); }
        if (!has_next) break;
#pragma unroll
        for (int a = 0; a < 2; ++a)
#pragma unroll
            for (int b = 0; b < 2; ++b)
#pragma unroll
                for (int m = 0; m < 4; ++m)
#pragma unroll
                    for (int n = 0; n < 2; ++n) acc[a][b][m][n] = (f32x4){0.f, 0.f, 0.f, 0.f};
        cur = nxt; cA = nA; cB = nB; ++ui;
        if constexpr (ALIGN_EPI) { if (wr == 1) PG8_BAR; }
    }
    PG8_WAIT_V(0);
    if constexpr (!ALIGN_EPI) { if (wr == 0) PG8_BAR; }
    PG8_BAR;
    if constexpr (Epi::AFTER_DRAIN) { E.fused(acc, cur, wr, wc, fr, fq, lds, wid, lane); S.done(cur); }
#undef PG8_SA
#undef PG8_SB
#undef PG8_STAGE
#undef PG8_LDA
#undef PG8_LDB
#undef PG8_MMA
#undef PG8_WAIT_V
#undef PG8_WAIT_L
#undef PG8_BAR
#undef PG8_SCHED
}
}
struct TDesc { const float* W; f16* WT; const float* gain; int K, N, Npad, row_off, item; };
__device__ __forceinline__ void t_load(const TDesc& d, f32x4 (&v)[16], int lane) {
    const int nblk = d.Npad / 64, kb = d.item / nblk, nb = d.item % nblk, k0 = 64 * kb, n0 = 64 * nb;
    const int c4 = lane & 15, kr = lane >> 4, n = n0 + 4 * c4;
#pragma unroll
    for (int i = 0; i < 16; ++i) v[i] = (n < d.N) ? *(const f32x4*)(d.W + (size_t)(k0 + 4 * i + kr) * d.N + n) : (f32x4){0.f, 0.f, 0.f, 0.f};
}
__device__ __forceinline__ void t_process(const TDesc& d, f32x4 (&v)[16], LAS float* scr, int lane) {
    const int nblk = d.Npad / 64, kb = d.item / nblk, nb = d.item % nblk, k0 = 64 * kb, n0 = 64 * nb;
    const int c4 = lane & 15, kr = lane >> 4;
    if (d.gain) {
#pragma unroll
        for (int i = 0; i < 16; ++i) v[i] = v[i] * d.gain[k0 + 4 * i + kr];
    }
#pragma unroll
    for (int i = 0; i < 16; ++i) { LAS float* q = scr + (4 * i + kr) * 65 + 4 * c4; q[0] = v[i][0]; q[1] = v[i][1]; q[2] = v[i][2]; q[3] = v[i][3]; }
    LDS_WAIT();
#pragma unroll
    for (int j = 0; j < 8; ++j) { const int pr = lane + 64 * j, c = pr & 7, nn = pr >> 3; const LAS float* s = scr + (8 * c) * 65 + nn; f16x8 o;
#pragma unroll
        for (int e = 0; e < 8; ++e) o[e] = (f16)s[e * 65];
        *(f16x8*)(d.WT + (size_t)(d.row_off + n0 + nn) * d.K + k0 + 8 * c) = o; }
    LDS_WAIT();
}
__device__ __forceinline__ void sincos_d(double x, double& s, double& c) {
    const double twopi = 6.283185307179586476925287, inv = 0.15915494309189533576888;
    const double k = rint(x * inv); double r = fma(-k, twopi, x); r = fma(-k, -2.4492935982947064e-16, r);
    const double r2 = r * r; double ts = 1.0, tc = 1.0;
#pragma unroll
    for (int i = 27; i >= 3; i -= 2) ts = 1.0 - ts * r2 / (double)(i * (i - 1));
#pragma unroll
    for (int i = 26; i >= 2; i -= 2) tc = 1.0 - tc * r2 / (double)(i * (i - 1));
    s = r * ts; c = tc;
}
__device__ __forceinline__ void resnorm_row(const float* y, const float* gpost, const float* xin, float* xout, int mode, const float* gnext, f16* o16, float* o32, int row, int lane_in) {
    int lane = lane_in; asm volatile("" : "+v"(lane));
    f32x4 v[8];
    const f32x4* xr = (const f32x4*)(xin + (size_t)row * DM) + lane;
#pragma unroll
    for (int j = 0; j < 8; ++j) v[j] = xr[64 * j];
    if (y) {
        const f32x4* yr = (const f32x4*)(y + (size_t)row * DM) + lane; f32x4 w[8]; float s = 0.f;
#pragma unroll
        for (int j = 0; j < 8; ++j) { w[j] = yr[64 * j]; s += (w[j][0] * w[j][0] + w[j][1] * w[j][1]) + (w[j][2] * w[j][2] + w[j][3] * w[j][3]); }
        const float r1 = 1.0f / sqrtf(wave_sum(s) * (1.0f / DM) + EPS);
#pragma unroll
        for (int j = 0; j < 8; ++j) { const f32x4 gp = *((const f32x4*)gpost + lane + 64 * j); v[j] = v[j] + w[j] * r1 * gp; }
    }
    if (xout) { f32x4* xo = (f32x4*)(xout + (size_t)row * DM) + lane;
#pragma unroll
        for (int j = 0; j < 8; ++j) xo[64 * j] = v[j]; }
    if (mode == 0) return;
    float s2 = 0.f;
#pragma unroll
    for (int j = 0; j < 8; ++j) s2 += (v[j][0] * v[j][0] + v[j][1] * v[j][1]) + (v[j][2] * v[j][2] + v[j][3] * v[j][3]);
    const float r2 = 1.0f / sqrtf(wave_sum(s2) * (1.0f / DM) + EPS);
    if (mode == 1) {
#pragma unroll
        for (int j = 0; j < 8; ++j) *((f16x4*)(o16 + (size_t)row * DM) + lane + 64 * j) = cvt4(v[j] * r2);
    } else if (mode == 2) {
        const int b = row >> 12, t = row & 4095;
#pragma unroll
        for (int j = 0; j < 8; ++j) { const int col = 4 * lane + 256 * j; const f32x4 gn = *((const f32x4*)gnext + lane + 64 * j);
            *(f16x4*)(o16 + ((size_t)((b * NG + (col >> 4)) * SEQ + t)) * 16 + (col & 15)) = cvt4(v[j] * r2 * gn); }
    } else {
#pragma unroll
        for (int j = 0; j < 8; ++j) { const f32x4 gn = *((const f32x4*)gnext + lane + 64 * j); *((f32x4*)(o32 + (size_t)row * DM) + lane + 64 * j) = v[j] * r2 * gn; }
    }
}

__device__ __forceinline__ void resnorm_rows(const f16* y, const float* gpost, const float* xin, float* xout, int mode, const float* gnext, f16* o16, int first, int stride, int nrows, int lane_in) {
    int lane = lane_in; asm volatile("" : "+v"(lane));
    if (first >= nrows) return;
    f32x4 xv[8], yv[8], xn[8]; f16x4 yn[8];
    { const f32x4* xr = (const f32x4*)(xin + (size_t)first * DM) + lane; const f16x4* yr = (const f16x4*)(y + (size_t)first * DM) + lane;
#pragma unroll
      for (int j = 0; j < 8; ++j) { xn[j] = xr[64 * j]; yn[j] = yr[64 * j]; } }
    for (int row = first; row < nrows; row += stride) {
#pragma unroll
        for (int j = 0; j < 8; ++j) { xv[j] = xn[j]; yv[j] = (f32x4){(float)yn[j][0], (float)yn[j][1], (float)yn[j][2], (float)yn[j][3]}; }
        if (row + stride < nrows) { const f32x4* xr = (const f32x4*)(xin + (size_t)(row + stride) * DM) + lane; const f16x4* yr = (const f16x4*)(y + (size_t)(row + stride) * DM) + lane;
#pragma unroll
            for (int j = 0; j < 8; ++j) { xn[j] = xr[64 * j]; yn[j] = yr[64 * j]; } }
        float s = 0.f;
#pragma unroll
        for (int j = 0; j < 8; ++j) s += (yv[j][0] * yv[j][0] + yv[j][1] * yv[j][1]) + (yv[j][2] * yv[j][2] + yv[j][3] * yv[j][3]);
        const float r1 = 1.0f / sqrtf(wave_sum(s) * (1.0f / DM) + EPS);
#pragma unroll
        for (int j = 0; j < 8; ++j) { const f32x4 gp = *((const f32x4*)gpost + lane + 64 * j); xv[j] = xv[j] + yv[j] * r1 * gp; }
        f32x4* xo = (f32x4*)(xout + (size_t)row * DM) + lane;
#pragma unroll
        for (int j = 0; j < 8; ++j) xo[64 * j] = xv[j];
        if (mode == 0) continue;
        float s2 = 0.f;
#pragma unroll
        for (int j = 0; j < 8; ++j) s2 += (xv[j][0] * xv[j][0] + xv[j][1] * xv[j][1]) + (xv[j][2] * xv[j][2] + xv[j][3] * xv[j][3]);
        const float r2 = 1.0f / sqrtf(wave_sum(s2) * (1.0f / DM) + EPS);
        if (mode == 1) {
#pragma unroll
            for (int j = 0; j < 8; ++j) *((f16x4*)(o16 + (size_t)row * DM) + lane + 64 * j) = cvt4(xv[j] * r2);
        } else {
            const int b = row >> 12, t = row & 4095;
#pragma unroll
            for (int j = 0; j < 8; ++j) { const int col = 4 * lane + 256 * j; const f32x4 gn = *((const f32x4*)gnext + lane + 64 * j);
                *(f16x4*)(o16 + ((size_t)((b * NG + (col >> 4)) * SEQ + t)) * 16 + (col & 15)) = cvt4(xv[j] * r2 * gn); }
        }
    }
}

template <bool SRC_F32, int OUT>
__device__ __forceinline__ void resnorm2_rows(const f16* y, const float* gpost, const float* xin32, f16* XN, float* RS, float* out32, const float* gnext, f16* XG, int first, int stride, int nrows, int lane_in) {
    int lane = lane_in; asm volatile("" : "+v"(lane));
    if (first >= nrows) return;
    f32x4 xv[8], yv[8], xn32[8]; f16x4 xn16[8], yn[8]; float sn = 1.f;
    {   const f16x4* yr = (const f16x4*)(y + (size_t)first * DM) + lane;
#pragma unroll
        for (int j = 0; j < 8; ++j) yn[j] = yr[64 * j];
        if (SRC_F32) { const f32x4* xr = (const f32x4*)(xin32 + (size_t)first * DM) + lane;
#pragma unroll
            for (int j = 0; j < 8; ++j) xn32[j] = xr[64 * j]; }
        else { const f16x4* xr = (const f16x4*)(XN + (size_t)first * DM) + lane; sn = RS[first];
#pragma unroll
            for (int j = 0; j < 8; ++j) xn16[j] = xr[64 * j]; } }
    for (int row = first; row < nrows; row += stride) {
#pragma unroll
        for (int j = 0; j < 8; ++j) { yv[j] = (f32x4){(float)yn[j][0], (float)yn[j][1], (float)yn[j][2], (float)yn[j][3]};
            if (SRC_F32) xv[j] = xn32[j]; else xv[j] = (f32x4){(float)xn16[j][0], (float)xn16[j][1], (float)xn16[j][2], (float)xn16[j][3]} * sn; }
        if (row + stride < nrows) { const int nr = row + stride; const f16x4* yr = (const f16x4*)(y + (size_t)nr * DM) + lane;
#pragma unroll
            for (int j = 0; j < 8; ++j) yn[j] = yr[64 * j];
            if (SRC_F32) { const f32x4* xr = (const f32x4*)(xin32 + (size_t)nr * DM) + lane;
#pragma unroll
                for (int j = 0; j < 8; ++j) xn32[j] = xr[64 * j]; }
            else { const f16x4* xr = (const f16x4*)(XN + (size_t)nr * DM) + lane; sn = RS[nr];
#pragma unroll
                for (int j = 0; j < 8; ++j) xn16[j] = xr[64 * j]; } }
        float s = 0.f;
#pragma unroll
        for (int j = 0; j < 8; ++j) s += (yv[j][0] * yv[j][0] + yv[j][1] * yv[j][1]) + (yv[j][2] * yv[j][2] + yv[j][3] * yv[j][3]);
        const float r1 = 1.0f / sqrtf(wave_sum(s) * (1.0f / DM) + EPS);
#pragma unroll
        for (int j = 0; j < 8; ++j) { const f32x4 gp = *((const f32x4*)gpost + lane + 64 * j); xv[j] = xv[j] + yv[j] * r1 * gp; }
        if (OUT == 0) { f32x4* xo = (f32x4*)(out32 + (size_t)row * DM) + lane;
#pragma unroll
            for (int j = 0; j < 8; ++j) xo[64 * j] = xv[j];
            continue; }
        float s2 = 0.f;
#pragma unroll
        for (int j = 0; j < 8; ++j) s2 += (xv[j][0] * xv[j][0] + xv[j][1] * xv[j][1]) + (xv[j][2] * xv[j][2] + xv[j][3] * xv[j][3]);
        const float ms = wave_sum(s2) * (1.0f / DM) + EPS, r2 = 1.0f / sqrtf(ms);
#pragma unroll
        for (int j = 0; j < 8; ++j) *((f16x4*)(XN + (size_t)row * DM) + lane + 64 * j) = cvt4(xv[j] * r2);
        if (lane == 0) RS[row] = sqrtf(ms);
        if (OUT == 2) {
            const int b = row >> 12, t = row & 4095;
#pragma unroll
            for (int j = 0; j < 8; ++j) { const int col = 4 * lane + 256 * j; const f32x4 gn = *((const f32x4*)gnext + lane + 64 * j);
                *(f16x4*)(XG + ((size_t)((b * NG + (col >> 4)) * SEQ + t)) * 16 + (col & 15)) = cvt4(xv[j] * r2 * gn); }
        }
    }
}
__device__ __forceinline__ void ph_prologue(const Params& p, LAS unsigned char* lds, int vcu, int G, int tid_in) {
    int tid = tid_in; asm volatile("" : "+v"(tid));
    const int lane = tid & 63, wave = __builtin_amdgcn_readfirstlane(tid >> 6), gw = vcu * 8 + wave, NGW = G * 8;
    unsigned char* ws = p.ws;
    LAS float* scr = (LAS float*)(lds + wave * 16640);
    {
        constexpr int I_GLU = 32 * 32, I_UP = 32 * 128, I_DN = 128 * 32, I_KV = 32 * 48, I_QG = 32 * 36, I_WO = 32 * 32, I_C1 = 32 * 4, I_C2 = 4 * 2;
        constexpr int NIT = 2 * I_GLU + 4 * I_UP + 4 * I_DN + I_KV + 2 * I_QG + 2 * I_WO + 4 * I_C1 + 2 * I_C2;
        auto desc = [&](int it) -> TDesc {
            int r = it;
            if (r < 2 * I_GLU) { const int l = r / I_GLU; return TDesc{p.in[17] + (size_t)l * DM * DM, (f16*)(ws + WS_WGLU) + (size_t)l * DM * DM, nullptr, DM, DM, DM, 0, r % I_GLU}; } r -= 2 * I_GLU;
            if (r < 4 * I_UP) { const int l = r / I_UP; return TDesc{p.in[33] + (size_t)l * DM * FF, (f16*)(ws + WS_WUP) + (size_t)l * DM * FF, p.in[32] + l * DM, DM, FF, FF, 0, r % I_UP}; } r -= 4 * I_UP;
            if (r < 4 * I_DN) { const int l = r / I_DN; return TDesc{p.in[34] + (size_t)l * DM * FF, (f16*)(ws + WS_WDN) + (size_t)l * DM * FF, nullptr, FF, DM, DM, 0, r % I_DN}; } r -= 4 * I_DN;
            if (r < I_KV) return TDesc{p.in[21], (f16*)(ws + WS_WKVQG), p.in[20], DM, NKV, NKV, 0, r}; r -= I_KV;
            if (r < I_QG) return TDesc{p.in[29], (f16*)(ws + WS_WKVQG), p.in[28], DM, NQG, NQGP, NKV, r}; r -= I_QG;
            if (r < I_QG) return TDesc{p.in[29] + (size_t)DM * NQG, (f16*)(ws + WS_WQG1), p.in[28] + DM, DM, NQG, NQGP, 0, r}; r -= I_QG;
            if (r < 2 * I_WO) { const int l = r / I_WO; return TDesc{p.in[30] + (size_t)l * DM * DM, (f16*)(ws + WS_WO) + (size_t)l * DM * DM, nullptr, DM, DM, DM, 0, r % I_WO}; } r -= 2 * I_WO;
            if (r < 4 * I_C1) { const int q = r / I_C1, kv = q >> 1, j = q & 1; return TDesc{p.in[kv ? 25 : 22] + (size_t)j * 2048 * 256, (f16*)(ws + WS_CW1) + (size_t)kv * 512 * 2048, nullptr, 2048, 256, 256, j * 256, r % I_C1}; } r -= 4 * I_C1;
            { const int kv = r / I_C2; return TDesc{p.in[kv ? 27 : 24], (f16*)(ws + WS_CW2) + (size_t)kv * 128 * 256, nullptr, 256, 128, 128, 0, r % I_C2}; }
        };
        int it = gw;
        if (it < NIT) {
            f32x4 va[16], vb[16];
            TDesc d0 = desc(it), d1 = d0;
            t_load(d0, va, lane);
            for (;;) {
                const int it1 = it + NGW; const bool has1 = it1 < NIT;
                if (has1) { d1 = desc(it1); t_load(d1, vb, lane); }
                t_process(d0, va, scr, lane);
                if (!has1) break;
                const int it2 = it1 + NGW; const bool has2 = it2 < NIT;
                if (has2) { d0 = desc(it2); t_load(d0, va, lane); }
                t_process(d1, vb, scr, lane);
                if (!has2) break;
                it = it2;
            }
        }
    }
    const int gt = vcu * 512 + tid, NGT = G * 512;
    if (wave == 0) {
        LAS float* sw = (LAS float*)lds;
        for (int lg = vcu; lg < 2 * NG; lg += G) {
            const int l = lg / NG, g = lg % NG, pp = lane, it = lg * NST + pp;
            const double dt = exp((double)p.in[11][lg]);
            const double lr = (double)p.in[9][it], li = (double)p.in[10][it];
            const double mag = exp(lr * dt); double sn, cs; sincos_d(li * dt, sn, cs);
            const double are = mag * cs, aim = mag * sn, den = lr * lr + li * li, nr0 = are - 1.0;
            const double fre = (nr0 * lr + aim * li) / den, fim = (aim * lr - nr0 * li) / den;
            float* AT = (float*)(ws + WS_AT); AT[2 * it] = (float)are; AT[2 * it + 1] = (float)aim;
            if (pp == 0) ((float*)(ws + WS_DT))[lg] = (float)dt;
            const float* bre = p.in[12] + (size_t)it * 16; const float* bim = p.in[13] + (size_t)it * 16;
            float* BBF = (float*)(ws + WS_BBF) + (size_t)it * 32;
            f16* BST = (f16*)(ws + WS_BST) + (size_t)lg * 128 * 16;
            const double idt = 1.0 / dt;
            float xr[16], xi[16];
#pragma unroll
            for (int i = 0; i < 16; ++i) { const double br = bre[i], bi = bim[i]; const double vr = fre * br - fim * bi, vi = fre * bi + fim * br;
                BBF[i] = (float)vr; BBF[16 + i] = (float)vi; xr[i] = (float)(vr * idt); xi[i] = (float)(vi * idt); BST[pp * 16 + i] = (f16)xr[i]; BST[(64 + pp) * 16 + i] = (f16)xi[i]; }
            sw[pp * 36] = (float)are; sw[pp * 36 + 1] = (float)aim;
#pragma unroll
            for (int i = 0; i < 16; ++i) { sw[pp * 36 + 4 + i] = xr[i]; sw[pp * 36 + 20 + i] = xi[i]; }
            const float* cre = p.in[14] + (size_t)lg * 16 * 64; const float* cim = p.in[15] + (size_t)lg * 16 * 64;
            {
              f16* MI = (f16*)(ws + WS_MI) + (size_t)lg * 128 * 256;
              double pre = 1.0, pim = 0.0;
              for (int t = 15; t >= 0; --t) {
                  const float fr_ = (float)pre, fi_ = (float)pim; f16x8 r0, r1, i0, i1;
#pragma unroll
                  for (int i = 0; i < 8; ++i) { r0[i] = (f16)(fr_ * xr[i] - fi_ * xi[i]); r1[i] = (f16)(fr_ * xr[8 + i] - fi_ * xi[8 + i]); i0[i] = (f16)(fr_ * xi[i] + fi_ * xr[i]); i1[i] = (f16)(fr_ * xi[8 + i] + fi_ * xr[8 + i]); }
                  *(f16x8*)(MI + (size_t)pp * 256 + t * 16) = r0; *(f16x8*)(MI + (size_t)pp * 256 + t * 16 + 8) = r1;
                  *(f16x8*)(MI + (size_t)(64 + pp) * 256 + t * 16) = i0; *(f16x8*)(MI + (size_t)(64 + pp) * 256 + t * 16 + 8) = i1;
                  const double nr = pre * are - pim * aim, ni = pre * aim + pim * are; pre = nr; pim = ni;
              } }
            {
              f16* W1 = (f16*)(ws + WS_W1) + (size_t)lg * 256 * 128;
              float cr[16], ci[16];
#pragma unroll
              for (int j = 0; j < 16; ++j) { cr[j] = cre[j * 64 + pp]; ci[j] = cim[j * 64 + pp]; }
              double pre = are, pim = aim;
              for (int t = 0; t < 16; ++t) {
                  const float Ar = (float)pre, Ai = (float)pim;
#pragma unroll
                  for (int j = 0; j < 16; ++j) { W1[(size_t)(t * 16 + j) * 128 + pp] = (f16)(cr[j] * Ar - ci[j] * Ai); W1[(size_t)(t * 16 + j) * 128 + 64 + pp] = (f16)(-cr[j] * Ai - ci[j] * Ar); }
                  const double nr = pre * are - pim * aim, ni = pre * aim + pim * are; pre = nr; pim = ni;
              }
              f16* CCT = (f16*)(ws + WS_CCT) + (size_t)lg * 16 * 128;
#pragma unroll
              for (int j = 0; j < 16; ++j) { CCT[j * 128 + pp] = (f16)cr[j]; CCT[j * 128 + 64 + pp] = (f16)(-ci[j]); } }
            LDS_WAIT();
            {
              const int j = lane >> 2, ib = (lane & 3) * 4;
              float acc[4][16];
#pragma unroll
              for (int e = 0; e < 4; ++e)
#pragma unroll
                  for (int tau = 0; tau < 16; ++tau) acc[e][tau] = 0.f;
              for (int p2 = 0; p2 < 64; ++p2) {
                  const float a2r = sw[p2 * 36], a2i = sw[p2 * 36 + 1], c2r = cre[j * 64 + p2], c2i = cim[j * 64 + p2];
#pragma unroll
                  for (int e = 0; e < 4; ++e) { float wr = sw[p2 * 36 + 4 + ib + e], wi = sw[p2 * 36 + 20 + ib + e];
#pragma unroll
                      for (int tau = 0; tau < 16; ++tau) { acc[e][tau] += c2r * wr - c2i * wi; const float nr = wr * a2r - wi * a2i; wi = wr * a2i + wi * a2r; wr = nr; } }
              }
              f16* KT = (f16*)(ws + WS_KT) + (size_t)lg * 4096;
#pragma unroll
              for (int tau = 0; tau < 16; ++tau) { f16x4 o; o[0] = (f16)acc[0][tau]; o[1] = (f16)acc[1][tau]; o[2] = (f16)acc[2][tau]; o[3] = (f16)acc[3][tau]; *(f16x4*)(KT + tau * 256 + j * 16 + ib) = o; } }
            LDS_WAIT();
        }
    }
    for (int it = gt; it < 4100 * 16; it += NGT) {
        const int pi = it >> 4, f = it & 15; const int pos = pi < 4096 ? pi : PAST + (pi - 4096);
        const float ang = (float)pos * p.inv_freq[f]; double sn, cs; sincos_d((double)ang, sn, cs);
        float* R = (float*)(ws + WS_ROPE) + (size_t)pi * 32; R[f] = (float)cs; R[16 + f] = (float)sn;
    }
    for (int it = gw; it < 512; it += NGW) {
        const int kv = it >> 8, h = it & 255; const float* pe = p.in[kv ? 26 : 23]; const float* w1 = p.in[kv ? 25 : 22];
        float s = 0.f;
        for (int i = lane; i < 4096; i += 64) s += pe[i] * w1[(size_t)i * 256 + h];
        s = wave_sum(s);
        if (lane == 0) ((float*)(ws + WS_PE))[it] = s;
    }
    {
        f16* RCS = (f16*)(ws + WS_RC) + RC_P_ELEMS; const int* pt = (const int*)p.in[7];
        for (int ch = gw; ch < NBS * NPAGES * 2; ch += NGW) {
            const int b = ch >> 8, pg = (ch >> 1) & 127, hf = ch & 1; const int page = pt[b * NPAGES + pg];
            const float* srcb = p.in[2] + ((size_t)page * PAGE + hf * 64) * 1024; const int pos0 = pg * PAGE + hf * 64;
            for (int r = 0; r < 64; r += 2) {
                f32x4 v[2][4];
#pragma unroll
                for (int u = 0; u < 2; ++u)
#pragma unroll
                    for (int j = 0; j < 4; ++j) v[u][j] = *((const f32x4*)(srcb + (size_t)(r + u) * 1024) + lane + 64 * j);
#pragma unroll
                for (int u = 0; u < 2; ++u)
#pragma unroll
                    for (int j = 0; j < 4; ++j) { const int e = 4 * lane + 256 * j, kv = e >> 9, g = (e >> 7) & 3, d = e & 127;
                        *(f16x4*)(RCS + ((size_t)(((kv * 8 + b) * 4 + g)) * PAST + pos0 + r + u) * 128 + d) = cvt4(v[u][j]); }
            }
        }
    }
    for (int it = gw; it < NBS * 508; it += NGW) {
        const int b = it / 508, r = it % 508;
        const f32x4* src = (const f32x4*)(p.in[4] + ((size_t)(b * 512 + r + 4)) * 1024) + lane; f32x4* dst = (f32x4*)(p.out + O_SWAS + ((size_t)(b * 512 + r)) * 1024) + lane;
#pragma unroll
        for (int j = 0; j < 4; ++j) dst[64 * j] = src[64 * j];
    }
    for (int m = gw; m < MP + MS; m += NGW) {
        if (m < MP) resnorm_row(nullptr, nullptr, p.in[0], nullptr, 2, p.in[8], (f16*)(ws + WS_A0), nullptr, m, lane);
        else resnorm_row(nullptr, nullptr, p.in[1], nullptr, 3, p.in[8], nullptr, (float*)(ws + WS_XNS), m - MP, lane);
    }
}
__device__ __forceinline__ void s5_prompt_unit(LAS unsigned char* lds, int l, int b, int g, const Params& p, int tid_in) {
    int tid = tid_in; asm volatile("" : "+v"(tid));
    const int lane = tid & 63, w = __builtin_amdgcn_readfirstlane(tid >> 6), fr = lane & 15, q = lane >> 4;
    unsigned char* ws = p.ws;
    const f16* xg = (const f16*)(ws + WS_A0) + ((size_t)(b * NG + g) * SEQ) * 16;
    const f16* BST = (const f16*)(ws + WS_BST) + (size_t)(l * NG + g) * 128 * 16;
    const f16* CCT = (const f16*)(ws + WS_CCT) + (size_t)(l * NG + g) * 16 * 128;
    const f16x8 z8 = {0, 0, 0, 0, 0, 0, 0, 0};
    f16x8 Bs[8], Cc[4];
#pragma unroll
    for (int nt = 0; nt < 8; ++nt) Bs[nt] = (q < 2) ? *(const f16x8*)(BST + (nt * 16 + fr) * 16 + 8 * q) : z8;
#pragma unroll
    for (int s = 0; s < 4; ++s) Cc[s] = *(const f16x8*)(CCT + fr * 128 + 32 * s + 8 * q);
    const float* AT = (const float*)(ws + WS_AT) + (size_t)((l * NG + g) * NST + lane) * 2;
    const float ar = AT[0], ai = AT[1];
    const float dt = ((const float*)(ws + WS_DT))[l * NG + g];
    const f32x4 dsk = *(const f32x4*)(p.in[16] + (size_t)l * DM + g * 16 + 4 * q);
    float hr = 0.f, hi = 0.f;
    const f32x4 z4 = {0.f, 0.f, 0.f, 0.f};
    float p16r = ar, p16i = ai;
#pragma unroll
    for (int i = 0; i < 4; ++i) { const float nr = p16r * p16r - p16i * p16i, ni = 2.f * p16r * p16i; p16r = nr; p16i = ni; }
    float h0r[32], h0i[32];
    {
        LAS f16* mi = (LAS f16*)(lds + 72704);
        LAS float* tb = (LAS float*)(lds + w * 8448);
        const f16* MI = (const f16*)(ws + WS_MI) + (size_t)(l * NG + g) * 128 * 256;
        for (int idx = tid; idx < 128 * 32; idx += 512) { const int r = idx >> 5, c8 = (idx & 31) * 8; *(LAS f16x8*)(mi + r * 264 + c8) = *(const f16x8*)(MI + (size_t)r * 256 + c8); }
        __syncthreads();
#pragma unroll
        for (int ct = 0; ct < 2; ++ct) {
            f32x4 accn[8];
#pragma unroll
            for (int nt = 0; nt < 8; ++nt) accn[nt] = z4;
#pragma unroll
            for (int s = 0; s < 8; ++s) {
                const int t = 2 * s + (q >> 1), i0 = 8 * (q & 1);
                const f16x8 ubc = *(const f16x8*)(xg + (size_t)(512 * w + (16 * ct + fr) * 16 + t) * 16 + i0);
#pragma unroll
                for (int nt = 0; nt < 8; ++nt) { const f16x8 am = *(const LAS f16x8*)(mi + (nt * 16 + fr) * 264 + 32 * s + 8 * q); accn[nt] = __builtin_amdgcn_mfma_f32_16x16x32_f16(am, ubc, accn[nt], 0, 0, 0); }
            }
#pragma unroll
            for (int nt = 0; nt < 8; ++nt) *(LAS f32x4*)(tb + fr * 132 + nt * 16 + 4 * q) = accn[nt];
            LDS_WAIT();
#pragma unroll
            for (int c = 0; c < 16; ++c) { h0r[16 * ct + c] = hr; h0i[16 * ct + c] = hi;
                const float br = tb[c * 132 + lane], bi = tb[c * 132 + 64 + lane]; const float nr = p16r * hr - p16i * hi + br, ni = p16r * hi + p16i * hr + bi; hr = nr; hi = ni; }
            LDS_WAIT();
        }
        __syncthreads();
    }
    LAS f16* hsb = (LAS f16*)(lds + w * 4352);
    LAS float* carry = (LAS float*)(lds + 34816);
    LAS f16* kt = (LAS f16*)(lds + 38912);
    LAS f16* w1 = (LAS f16*)(lds + 47104);
    carry[(w * 64 + lane) * 2] = hr; carry[(w * 64 + lane) * 2 + 1] = hi;
    *(LAS f16x8*)(kt + tid * 8) = *(const f16x8*)((const f16*)(ws + WS_KT) + (size_t)(l * NG + g) * 4096 + tid * 8);
    { const f16* W1g = (const f16*)(ws + WS_W1) + (size_t)(l * NG + g) * 256 * 128;
      for (int idx = tid; idx < 256 * 16; idx += 512) { const int r = idx >> 4, c8 = (idx & 15) * 8; *(LAS f16x8*)(w1 + r * 136 + c8) = *(const f16x8*)(W1g + (size_t)r * 128 + c8); } }
    __syncthreads();
    {
        float pr = ar, pi = ai;
#pragma unroll
        for (int i = 0; i < 9; ++i) { const float nr = pr * pr - pi * pi, ni = 2.f * pr * pi; pr = nr; pi = ni; }
        float zr = 0.f, zi = 0.f;
        for (int v = 0; v < w; ++v) { const float sr = carry[(v * 64 + lane) * 2], si = carry[(v * 64 + lane) * 2 + 1]; const float nr = pr * zr - pi * zi + sr, ni = pr * zi + pi * zr + si; zr = nr; zi = ni; }
#pragma unroll
        for (int c = 0; c < 32; ++c) { h0r[c] += zr; h0i[c] += zi; const float nr = p16r * zr - p16i * zi, ni = p16r * zi + p16i * zr; zr = nr; zi = ni; }
        hr += zr; hi += zi;
    }
    f16* yact = (f16*)(ws + WS_A1);
#pragma unroll
    for (int ct = 0; ct < 2; ++ct) {
        const int tok0 = 512 * w + (16 * ct + fr) * 16;
        f16x8 ubc[8];
#pragma unroll
        for (int s = 0; s < 8; ++s) ubc[s] = *(const f16x8*)(xg + (size_t)(tok0 + 2 * s + (q >> 1)) * 16 + 8 * (q & 1));
        f16x4 xnv[16];
#pragma unroll
        for (int t = 0; t < 16; ++t) xnv[t] = *(const f16x4*)(xg + (size_t)(tok0 + t) * 16 + 4 * q);
#pragma unroll
        for (int c = 0; c < 16; ++c) { hsb[c * 136 + lane] = (f16)h0r[16 * ct + c]; hsb[c * 136 + 64 + lane] = (f16)h0i[16 * ct + c]; }
        LDS_WAIT();
        f16x8 hsB[4];
#pragma unroll
        for (int s = 0; s < 4; ++s) hsB[s] = *(const LAS f16x8*)(hsb + fr * 136 + 32 * s + 8 * q);
        LDS_WAIT();
#pragma unroll
        for (int t = 0; t < 16; ++t) {
            f32x4 acc = z4;
#pragma unroll
            for (int s = 0; s < 4; ++s) { const f16x8 aw = *(const LAS f16x8*)(w1 + (t * 16 + fr) * 136 + 32 * s + 8 * q); acc = __builtin_amdgcn_mfma_f32_16x16x32_f16(aw, hsB[s], acc, 0, 0, 0); }
#pragma unroll
            for (int ks = 0; ks <= t / 2; ++ks) {
                const int tau = t - 2 * ks - (q >> 1);
                const f16x8 ak = (tau >= 0) ? *(const LAS f16x8*)(kt + (tau * 16 + fr) * 16 + 8 * (q & 1)) : z8;
                acc = __builtin_amdgcn_mfma_f32_16x16x32_f16(ak, ubc[ks], acc, 0, 0, 0);
            }
            f16x4 o;
#pragma unroll
            for (int r = 0; r < 4; ++r) o[r] = (f16)gelu_tanh(dt * acc[r] + dsk[r] * (float)xnv[t][r]);
            *(f16x4*)(yact + (size_t)(b * SEQ + tok0 + t) * DM + g * 16 + 4 * q) = o;
            __builtin_amdgcn_sched_barrier(0);
        }
    }
    if (w == 7) { const size_t o = (size_t)((l * NBP + b) * NG + g) * NST + lane; p.out[O_REP + o] = dt * hr; p.out[O_IMP + o] = dt * hi; }
    __syncthreads();
}
__device__ __forceinline__ void s5_sample_wave(int l, int b, int g, const Params& p, int lane_in) {
    int lane = lane_in; asm volatile("" : "+v"(lane));
    unsigned char* ws = p.ws;
    const size_t sidx = (size_t)((l * NBS + b) * NG + g) * NST + lane;
    float hr = p.in[5][sidx], hi = p.in[6][sidx];
    const float* AT = (const float*)(ws + WS_AT) + (size_t)((l * NG + g) * NST + lane) * 2; const float ar = AT[0], ai = AT[1];
    const float* BBF = (const float*)(ws + WS_BBF) + (size_t)((l * NG + g) * NST + lane) * 32;
    float bre[16], bim[16];
#pragma unroll
    for (int i = 0; i < 16; ++i) { bre[i] = BBF[i]; bim[i] = BBF[16 + i]; }
    const float* cre = p.in[14] + (size_t)(l * NG + g) * 16 * 64 + lane; const float* cim = p.in[15] + (size_t)(l * NG + g) * 16 * 64 + lane;
    const float dsk = (lane < 16) ? p.in[16][(size_t)l * DM + g * 16 + lane] : 0.f;
    for (int i = 0; i < LS; ++i) {
        const float* xn = (const float*)(ws + WS_XNS) + (size_t)(b * LS + i) * DM + g * 16;
        float br = 0.f, bi = 0.f;
#pragma unroll
        for (int k = 0; k < 16; ++k) { const float u = xn[k]; br += bre[k] * u; bi += bim[k] * u; }
        const float nr = ar * hr - ai * hi + br, ni = ar * hi + ai * hr + bi; hr = nr; hi = ni;
        float yv = 0.f;
#pragma unroll
        for (int j = 0; j < 16; ++j) { const float s = wave_sum(cre[j * 64] * hr - cim[j * 64] * hi); if (lane == j) yv = s; }
        if (lane < 16) { const float y = gelu_tanh(yv + dsk * xn[lane]); ((f16*)(ws + WS_AS1))[(size_t)(b * LS + i) * DM + g * 16 + lane] = (f16)y; }
    }
    p.out[O_RES + sidx] = hr; p.out[O_IMS + sidx] = hi;
}
template <int EPI>
__device__ __forceinline__ void sgemm_phase(LAS unsigned char* lds, const f16* Wt, int N, int K, const f16* act, const Params& p, int L, int nkvcols, int vcu, int G, int tid_in) {
    int tid = tid_in; asm volatile("" : "+v"(tid));
    const int lane = tid & 63, w = __builtin_amdgcn_readfirstlane(tid >> 6), c = lane & 31, h = lane >> 5;
    LAS float* red = (LAS float*)lds;
    LAS float* tile = (LAS float*)(lds + 8 * 32 * 33 * 4);
    unsigned char* ws = p.ws;
    const int kw = K >> 3, k0 = w * kw;
    for (int u = vcu; u < N / 32; u += G) {
        const int n0 = 32 * u;
        f32x16 acc;
#pragma unroll
        for (int r = 0; r < 16; ++r) acc[r] = 0.f;
        const f16* wrow = Wt + (size_t)(n0 + c) * K + k0 + 8 * h; const f16* arow = act + (size_t)c * K + k0 + 8 * h;
        for (int kb = 0; kb < kw; kb += 128) {
            f16x8 av[8], bv[8];
#pragma unroll
            for (int i = 0; i < 8; ++i) { av[i] = *(const f16x8*)(wrow + kb + 16 * i); bv[i] = *(const f16x8*)(arow + kb + 16 * i); }
#pragma unroll
            for (int i = 0; i < 8; ++i) acc = __builtin_amdgcn_mfma_f32_32x32x16_f16(av[i], bv[i], acc, 0, 0, 0);
        }
#pragma unroll
        for (int r = 0; r < 16; ++r) red[(w * 32 + (r & 3) + 8 * (r >> 2) + 4 * h) * 33 + c] = acc[r];
        __syncthreads();
        const int tok = tid >> 4, nl = (tid & 15) * 2;
        float v0 = 0.f, v1 = 0.f;
#pragma unroll
        for (int ww = 0; ww < 8; ++ww) { v0 += red[(ww * 32 + nl) * 33 + tok]; v1 += red[(ww * 32 + nl + 1) * 33 + tok]; }
        tile[tok * 33 + nl] = v0; tile[tok * 33 + nl + 1] = v1;
        __syncthreads();
#pragma unroll
        for (int e = 0; e < 2; ++e) {
            const int n = n0 + nl + e; const float v = e ? v1 : v0;
            if (EPI == 0) { const float y = (float)((const f16*)(ws + WS_AS1))[(size_t)tok * DM + n]; ((float*)(ws + WS_YS))[(size_t)tok * DM + n] = y * sigmoidf_(v + p.in[18][(size_t)L * DM + n]); }
            else if (EPI == 1) { const float a = fmaxf(v, 0.f); ((f16*)(ws + WS_HS))[(size_t)tok * FF + n] = (f16)(a * a); }
            else if (EPI == 2) { ((float*)(ws + WS_YS))[(size_t)tok * DM + n] = v; }
            else {
                const int d = n & 127, bq = tok >> 2, ii = tok & 3;
                const float* rp = (const float*)(ws + WS_ROPE) + (size_t)(4096 + ii) * 32;
                float vr = v;
                if (d < 32) { const float cs = rp[d & 15], sn = rp[16 + (d & 15)]; const float xp = tile[tok * 33 + ((nl + e) ^ 16)]; vr = (d < 16) ? (v * cs - xp * sn) : (v * cs + xp * sn); }
                if (n < nkvcols) {
                    const int hh = n >> 7, br = hh >> 3, kv = (hh >> 2) & 1, g = hh & 3, cc = kv * 512 + g * 128 + d;
                    const float o = (br >= 1 && kv == 0) ? vr : v;
                    if (br == 0) p.out[O_CMPS + (size_t)tok * 1024 + cc] = o;
                    else if (br == 1) p.out[O_SLCS + (size_t)tok * 1024 + cc] = o;
                    else p.out[O_SWAS + ((size_t)(bq * 512 + 508 + ii)) * 1024 + cc] = o;
                } else {
                    const int cq = n - nkvcols;
                    if (cq < 2048) { ((float*)(ws + WS_QNS))[(size_t)tok * DM + cq] = v * QSCALE; ((float*)(ws + WS_QRS))[(size_t)tok * DM + cq] = vr * QSCALE; }
                    else if (cq < NQG) ((float*)(ws + WS_GATESS))[(size_t)tok * 48 + cq - 2048] = sigmoidf_(v);
                }
            }
        }
        __syncthreads();
    }
}

__device__ __forceinline__ void cmp2_unit(LAS unsigned char* lds, int unit, const Params& p, int tid_in) {
    int tid = tid_in; asm volatile("" : "+v"(tid));
    unsigned char* ws = p.ws;
    const int lane = tid & 63, w = __builtin_amdgcn_readfirstlane(tid >> 6), fr = lane & 15, q = lane >> 4;
    int mi, part, nvalid, R0, kv, b, g; const bool prompt = unit < 32;
    if (prompt) { mi = unit >> 1; part = unit & 1; nvalid = 255; R0 = mi * 256; kv = mi >> 3; b = (mi >> 2) & 1; g = mi & 3; }
    else { const int us = unit - 32; mi = us >> 3; part = us & 7; nvalid = 1023; R0 = 4096 + mi * 1024; kv = mi >> 5; b = (mi >> 2) & 7; g = mi & 3; }
    const int n0 = part * 128;
    LAS f16* At = (LAS f16*)lds;
    LAS f16* Wt = (LAS f16*)(lds + 67584);
    const f16* PROJ = (const f16*)(ws + WS_PROJ); const float* PE = (const float*)(ws + WS_PE) + kv * 256;
    { const int h4 = (tid & 63) * 4; const f32x4 pe = *(const f32x4*)(PE + h4);
#pragma unroll
      for (int hb = 0; hb < 2; ++hb) {
          f16x4 a[8], bb[8];
#pragma unroll
          for (int i = 0; i < 8; ++i) { const int row = (tid >> 6) + 8 * (hb * 8 + i), n = n0 + row;
              if (n < nvalid) { a[i] = *(const f16x4*)(PROJ + (size_t)(R0 + n) * 512 + h4); bb[i] = *(const f16x4*)(PROJ + (size_t)(R0 + n + 1) * 512 + 256 + h4); }
              else { a[i] = (f16x4){0, 0, 0, 0}; bb[i] = a[i]; } }
#pragma unroll
          for (int i = 0; i < 8; ++i) { const int row = (tid >> 6) + 8 * (hb * 8 + i), n = n0 + row; f16x4 o = {0, 0, 0, 0};
              if (n < nvalid) {
#pragma unroll
                  for (int e = 0; e < 4; ++e) o[e] = (f16)gelu_tanh((float)a[i][e] + (float)bb[i][e] + pe[e]); }
              *(LAS f16x4*)(At + row * 264 + h4) = o; }
      } }
    const f16* W2 = (const f16*)(ws + WS_CW2) + (size_t)kv * 128 * 256;
    for (int idx = tid; idx < 128 * 32; idx += 512) { const int d = idx >> 5, c8 = (idx & 31) * 8; *(LAS f16x8*)(Wt + d * 264 + c8) = *(const f16x8*)(W2 + d * 256 + c8); }
    __syncthreads();
    f32x4 acc[8];
#pragma unroll
    for (int dt = 0; dt < 8; ++dt) acc[dt] = (f32x4){0.f, 0.f, 0.f, 0.f};
#pragma unroll
    for (int s = 0; s < 8; ++s) { const f16x8 bop = *(const LAS f16x8*)(At + (16 * w + fr) * 264 + 32 * s + 8 * q);
#pragma unroll
        for (int dt = 0; dt < 8; ++dt) { const f16x8 aop = *(const LAS f16x8*)(Wt + (16 * dt + fr) * 264 + 32 * s + 8 * q); acc[dt] = __builtin_amdgcn_mfma_f32_16x16x32_f16(aop, bop, acc[dt], 0, 0, 0); } }
    const int n = n0 + 16 * w + fr;
    if (prompt) {
        if (kv == 0) { f16* o = (f16*)(ws + WS_KC) + ((size_t)((b * 4 + g) * 256 + n)) * 128 + 4 * q;
#pragma unroll
            for (int dt = 0; dt < 8; ++dt) *(f16x4*)(o + 16 * dt) = cvt4(acc[dt]); }
        else { const int np = (n & ~12) | ((n & 4) << 1) | ((n & 8) >> 1);
            f16* o = (f16*)(ws + WS_VCT) + ((size_t)(b * 4 + g) * 128) * 256 + np;
#pragma unroll
            for (int dt = 0; dt < 8; ++dt)
#pragma unroll
                for (int r = 0; r < 4; ++r) o[(size_t)(16 * dt + 4 * q + r) * 256] = (f16)acc[dt][r]; }
    } else {
        f16* o = (f16*)(ws + (kv ? WS_VCS : WS_KCS)) + ((size_t)((b * 4 + g) * 1024 + n)) * 128 + 4 * q;
#pragma unroll
        for (int dt = 0; dt < 8; ++dt) *(f16x4*)(o + 16 * dt) = cvt4(acc[dt]);
    }
    __syncthreads();
}

__device__ __forceinline__ void pgates_phase(LAS unsigned char* lds, const f16* Wt, const f16* A, float* GATES, int vcu, int G, int tid_in) {
    int tid = tid_in; asm volatile("" : "+v"(tid));
    const int lane = tid & 63, w = __builtin_amdgcn_readfirstlane(tid >> 6), c = lane & 31, h = lane >> 5;
    LAS float* red = (LAS float*)lds;
    const int k0 = w * 256;
    for (int u = vcu; u < 512; u += G) {
        const int rg = u >> 1, n0 = 2048 + (u & 1) * 32;
        f32x16 acc;
#pragma unroll
        for (int r = 0; r < 16; ++r) acc[r] = 0.f;
        const f16* wrow = Wt + (size_t)(n0 + c) * DM + k0 + 8 * h; const f16* arow = A + (size_t)(rg * 32 + c) * DM + k0 + 8 * h;
#pragma unroll
        for (int kb = 0; kb < 256; kb += 128) {
            f16x8 av[8], bv[8];
#pragma unroll
            for (int i = 0; i < 8; ++i) { av[i] = *(const f16x8*)(wrow + kb + 16 * i); bv[i] = *(const f16x8*)(arow + kb + 16 * i); }
#pragma unroll
            for (int i = 0; i < 8; ++i) acc = __builtin_amdgcn_mfma_f32_32x32x16_f16(av[i], bv[i], acc, 0, 0, 0);
        }
#pragma unroll
        for (int r = 0; r < 16; ++r) red[(w * 32 + (r & 3) + 8 * (r >> 2) + 4 * h) * 33 + c] = acc[r];
        __syncthreads();
        const int tok = tid >> 4, nl = (tid & 15) * 2;
        float v0 = 0.f, v1 = 0.f;
#pragma unroll
        for (int ww = 0; ww < 8; ++ww) { v0 += red[(ww * 32 + nl) * 33 + tok]; v1 += red[(ww * 32 + nl + 1) * 33 + tok]; }
        const int col = (u & 1) * 32 + nl;
        if (col < 48) { float* o = GATES + (size_t)(rg * 32 + tok) * 48 + col; o[0] = sigmoidf_(v0); o[1] = sigmoidf_(v1); }
        __syncthreads();
    }
}
constexpr int AT_KB = 0, AT_VB = 32768, AT_VSZ = 16384, AT_PSUM = 69632, AT_SELM = 135168;
struct AStage { u32x4 k0, k1, v0, v1; };
template <bool HASV>
__device__ __forceinline__ void a_load(AStage& s, const f16* Kb, const f16* Vt, int vstride, int tid) {
    const int p0 = tid, p1 = tid + 512;
    s.k0 = *(const u32x4*)(Kb + (p0 >> 4) * 128 + (p0 & 15) * 8); s.k1 = *(const u32x4*)(Kb + (p1 >> 4) * 128 + (p1 & 15) * 8);
    if (HASV) { s.v0 = *(const u32x4*)(Vt + (size_t)(p0 >> 3) * vstride + (p0 & 7) * 8); s.v1 = *(const u32x4*)(Vt + (size_t)(p1 >> 3) * vstride + (p1 & 7) * 8); }
}
template <bool HASV>
__device__ __forceinline__ void a_store(const AStage& s, LAS unsigned char* kb, LAS unsigned char* vb, int tid) {
    const int p0 = tid, p1 = tid + 512;
    { const int row = p0 >> 4, ch = p0 & 15; *(LAS u32x4*)(kb + row * 256 + ((ch ^ (row & 15)) << 4)) = s.k0; }
    { const int row = p1 >> 4, ch = p1 & 15; *(LAS u32x4*)(kb + row * 256 + ((ch ^ (row & 15)) << 4)) = s.k1; }
    if (HASV) {
        { const int d = p0 >> 3, ch = p0 & 7, g = (d >> 1) & 15; u32x4 v = s.v0; if (g & 1) v = (u32x4){v[2], v[3], v[0], v[1]}; *(LAS u32x4*)(vb + d * 128 + ((ch ^ (g >> 1)) << 4)) = v; }
        { const int d = p1 >> 3, ch = p1 & 7, g = (d >> 1) & 15; u32x4 v = s.v1; if (g & 1) v = (u32x4){v[2], v[3], v[0], v[1]}; *(LAS u32x4*)(vb + d * 128 + ((ch ^ (g >> 1)) << 4)) = v; }
    }
}
__device__ __forceinline__ float l_comb(float l) { const auto rr = __builtin_amdgcn_permlane32_swap(__float_as_uint(l), __float_as_uint(l), false, false); return __uint_as_float(rr[0]) + __uint_as_float(rr[1]); }
template <int BR>
__device__ __forceinline__ void flash_loop(unsigned long long tmask, const f16* Kbase, const f16* Vbase, int vtile, int vstride, LAS unsigned char* lds, const f16x8 (&qf)[8], f32x16 (&acc)[4],
                                           float& m, float& l, float inv_l, int cur, int tk, int vmax, unsigned sel_lo, unsigned sel_hi, int tid_in) {
    if (tmask == 0ull) return;
    int tid_o = tid_in; asm volatile("" : "+v"(tid_o));
    const int tid = tid_o;
    const int lane = tid & 63, c = lane & 31, h = lane >> 5;
    const float NEG = -__builtin_inff();
    int j = __builtin_ctzll(tmask); tmask &= tmask - 1ull;
    const int wv = __builtin_amdgcn_readfirstlane(tid >> 6);
    unsigned koff[2], voff[2];
#pragma unroll
    for (int i = 0; i < 2; ++i) { const int o = wv * 1024 + i * 8192 + lane * 16;
        { const int row = o >> 8, slot = (o >> 4) & 15; koff[i] = (unsigned)(row * 256 + ((slot ^ (row & 15)) << 4)); }
        { const int d = o >> 7, slot = (o >> 4) & 7; voff[i] = (unsigned)(d * vstride * 2 + ((slot ^ ((d >> 1) & 7)) << 4)); } }
#define ATT_ISSUE(tile, buf) do { const char* _kg = (const char*)Kbase + (size_t)(tile) * 16384; const char* _vg = (const char*)Vbase + (size_t)(tile) * vtile * 2; \
        _Pragma("unroll") for (int _i = 0; _i < 2; ++_i) { \
            __builtin_amdgcn_global_load_lds((const unsigned*)(_kg + koff[_i]), (LAS unsigned*)(lds + AT_KB + (buf) * 16384 + wv * 1024 + _i * 8192), 16, 0, 0); \
            if (BR != 0) __builtin_amdgcn_global_load_lds((const unsigned*)(_vg + voff[_i]), (LAS unsigned*)(lds + AT_VB + (buf) * AT_VSZ + wv * 1024 + _i * 8192), 16, 0, 0); } } while (0)
    ATT_ISSUE(j, 0);
    asm volatile("s_waitcnt vmcnt(0)" ::: "memory");
    __syncthreads();
    int bi = 0;
    for (;;) {
        int jn = -1;
        if (tmask != 0ull) { jn = __builtin_ctzll(tmask); tmask &= tmask - 1ull; ATT_ISSUE(jn, bi ^ 1); }
        const LAS unsigned char* kb = lds + AT_KB + bi * 16384; const LAS unsigned char* vb = lds + AT_VB + bi * AT_VSZ;
        int lo = 0, hi = 63;
        if (BR <= 1) { hi = vmax - 64 * j; }
        bool rowoff = false;
        if (BR == 2) { const bool rs = j < 32 ? ((sel_lo >> j) & 1u) : ((sel_hi >> (j - 32)) & 1u);
                       if (j == cur) { if (!rs) { lo = 1; hi = 0; } else hi = tk; } else rowoff = !rs; }
        if (BR == 3) { if (j == cur) hi = tk; else if (j == cur - 8) lo = tk + 1; }
        const bool need_mask = !__all(lo == 0 && hi >= 63);
#ifndef ATT_CDUP
#define ATT_CDUP 1
#endif
        const int nhalf = (BR == 2 && __all(rowoff)) ? 0 : ((BR >= 2) ? 2 * ATT_CDUP : 2);
#ifdef ATT_UNROLL
#pragma unroll
#else
#pragma unroll 1
#endif
        for (int hfi = 0; hfi < nhalf; ++hfi) { const int hf = hfi & 1;
            f32x16 pp;
            if (BR >= 2) { const float bias = rowoff ? NEG : -m;
#pragma unroll
                for (int r = 0; r < 16; ++r) pp[r] = bias; }
            else {
#pragma unroll
                for (int r = 0; r < 16; ++r) pp[r] = 0.f; }
            { f16x8 ka[8];
#pragma unroll
              for (int s = 0; s < 8; ++s) ka[s] = *(const LAS f16x8*)(kb + (c + 32 * hf) * 256 + (((2 * s + h) ^ (c & 15)) << 4));
              __builtin_amdgcn_sched_barrier(0);
#pragma unroll
              for (int s = 0; s < 8; ++s) pp = __builtin_amdgcn_mfma_f32_32x32x16_f16(ka[s], qf[s], pp, 0, 0, 0);
            }
            if (need_mask) {
#pragma unroll
                for (int r = 0; r < 16; ++r) { const int k = (r & 3) + 8 * (r >> 2) + 4 * h + 32 * hf; if (k < lo || k > hi) pp[r] = NEG; }
            }
            if (BR == 1) {
#pragma unroll
                for (int r = 0; r < 16; ++r) pp[r] = __builtin_amdgcn_exp2f(pp[r] - m) * inv_l;
                LAS float* ps = (LAS float*)(lds + AT_PSUM) + tk * 256 + 64 * j + 32 * hf;
                float av[16];
#pragma unroll
                for (int r = 0; r < 16; ++r) { float a = pp[r]; a += DPP_F(a, 0xB1); a += DPP_F(a, 0x4E); av[r] = a; }
                if ((c & 3) == 0) {
#pragma unroll
                    for (int q = 0; q < 4; ++q) *(LAS f32x4*)(ps + 8 * q + 4 * h) = (f32x4){av[4 * q], av[4 * q + 1], av[4 * q + 2], av[4 * q + 3]};
                }
            } else {
                float mx = fmaxf(pp[0], pp[1]);
#pragma unroll
                for (int r = 2; r < 16; r += 2) asm("v_max3_f32 %0, %1, %2, %3" : "=v"(mx) : "v"(mx), "v"(pp[r]), "v"(pp[r + 1]));
                { const auto rr = __builtin_amdgcn_permlane32_swap(__float_as_uint(mx), __float_as_uint(mx), false, false); mx = fmaxf(__uint_as_float(rr[0]), __uint_as_float(rr[1])); }
                float rs = 0.f;
                if (BR >= 2) {
                    if (!__all(mx <= 8.0f)) {
                        const float dlt = fmaxf(mx, 0.f), alpha = __builtin_amdgcn_exp2f(-dlt);
                        m += dlt; l *= alpha;
#pragma unroll
                        for (int dt = 0; dt < 4; ++dt)
#pragma unroll
                            for (int r = 0; r < 16; ++r) acc[dt][r] *= alpha;
#pragma unroll
                        for (int r = 0; r < 16; ++r) pp[r] -= dlt;
                    }
#pragma unroll
                    for (int r = 0; r < 16; ++r) { pp[r] = __builtin_amdgcn_exp2f(pp[r]); rs += pp[r]; }
                } else {
                    if (!__all((mx - m) <= 8.0f)) { const float mn = fmaxf(m, mx), alpha = __builtin_amdgcn_exp2f(m - mn); m = mn; l *= alpha; }
#pragma unroll
                    for (int r = 0; r < 16; ++r) { pp[r] = __builtin_amdgcn_exp2f(pp[r] - m); rs += pp[r]; }
                }
                l += rs;
            }
            if (BR >= 1) {
                f16x8 pk[2];
#pragma unroll
                for (int e = 0; e < 8; ++e) { pk[0][e] = (f16)pp[e]; pk[1][e] = (f16)pp[8 + e]; }
                f16x8 va[4][2];
#pragma unroll
                for (int dt = 0; dt < 4; ++dt)
#pragma unroll
                    for (int s2 = 0; s2 < 2; ++s2) {
                        const int s = 2 * hf + s2;
                        const int gsw = (c >> 1) & 7;
                        va[dt][s2] = *(const LAS f16x8*)(vb + (32 * dt + c) * 128 + (((2 * s + h) ^ gsw) << 4));
                    }
                __builtin_amdgcn_sched_barrier(0);
#pragma unroll
                for (int s2 = 0; s2 < 2; ++s2)
#pragma unroll
                    for (int dt = 0; dt < 4; ++dt) acc[dt] = __builtin_amdgcn_mfma_f32_32x32x16_f16(va[dt][s2], pk[s2], acc[dt], 0, 0, 0);
              }
        }
        asm volatile("s_waitcnt vmcnt(0)" ::: "memory");
        __syncthreads();
        if (jn < 0) break;
        j = jn; bi ^= 1;
    }
#undef ATT_ISSUE
}
__device__ __forceinline__ void out16_update(LAS unsigned char* reg, const f32x16 (&acc)[4], float sc, bool first, int lane) {
#pragma unroll
    for (int dt = 0; dt < 4; ++dt)
#pragma unroll
        for (int hf = 0; hf < 2; ++hf) {
            LAS f16x8* ptr = (LAS f16x8*)(reg + ((dt * 2 + hf) * 64 + lane) * 16);
            f16x8 o;
            if (first) {
#pragma unroll
                for (int e = 0; e < 8; ++e) o[e] = (f16)(acc[dt][8 * hf + e] * sc);
            } else {
                const f16x8 pv = *ptr;
#pragma unroll
                for (int e = 0; e < 8; ++e) o[e] = (f16)((float)pv[e] + acc[dt][8 * hf + e] * sc);
            }
            *ptr = o;
        }
}
__device__ __forceinline__ void attn_prompt_tile(LAS unsigned char* lds, int b, int g, int cur, const Params& p, int tid_in) {
    int tid = tid_in; asm volatile("" : "+v"(tid));
    unsigned char* ws = p.ws;
    const int lane = tid & 63, w = __builtin_amdgcn_readfirstlane(tid >> 6), c = lane & 31, h = lane >> 5;
    const int tk = 8 * w + (c >> 2), t = 64 * cur + tk, hd = 4 * g + (c & 3);
    const size_t row = (size_t)b * SEQ + t;
    LAS unsigned char* oreg = lds + AT_PSUM + w * 8192;
    f32x16 acc[4];
    f16x8 qf[8];
    { const f16* qp = (const f16*)(ws + WS_QN) + row * DM + hd * 128 + 8 * h;
#pragma unroll
      for (int s = 0; s < 8; ++s) qf[s] = *(const f16x8*)(qp + 16 * s); }
    const int ntc = (4 * cur + 2) / 64 + 1;
    const f16* Kc = (const f16*)(ws + WS_KC) + (size_t)(b * 4 + g) * 256 * 128; const f16* Vc = (const f16*)(ws + WS_VCT) + (size_t)(b * 4 + g) * 128 * 256;
    const unsigned long long cmask = (1ull << ntc) - 1ull;
    float m = -1e30f, l = 0.f;
#pragma unroll
    for (int dt = 0; dt < 4; ++dt)
#pragma unroll
        for (int r = 0; r < 16; ++r) acc[dt][r] = 0.f;
    { const int vmax = t >= 31 ? ((t - 31) >> 4) : -1;
      flash_loop<0>(cmask, Kc, Vc, 64, 256, lds, qf, acc, m, l, 0.f, cur, tk, vmax, 0u, 0u, tid);
      l = l_comb(l);
      const float inv_l = l > 0.f ? 1.0f / l : 0.f;
      flash_loop<1>(cmask, Kc, Vc, 64, 256, lds, qf, acc, m, l, inv_l, cur, tk, vmax, 0u, 0u, tid); }
    {
        const LAS float* ps = (const LAS float*)(lds + AT_PSUM);
        LAS unsigned* selm = (LAS unsigned*)(lds + AT_SELM);
        int jj = lane; asm volatile("" : "+v"(jj));
#pragma unroll 1
        for (int k = 0; k < 8; ++k) {
            const int tkk = 8 * w + k; float imp = 0.f;
#pragma unroll
            for (int i = 4 * jj - 1; i <= 4 * jj + 3; ++i) if (i >= 0 && i < 64 * ntc && i <= 254) imp += ps[tkk * 256 + i];
            const bool elig = jj <= cur, forced = (jj == 0) || (jj == cur) || (jj == cur - 1);
            const float val = elig ? (forced ? 1.0e4f : imp) : -__builtin_inff();
            int rank = 0;
            const int vbits = __builtin_bit_cast(int, val);
#pragma unroll
            for (int kk = 0; kk < 64; ++kk) { const float vk = __builtin_bit_cast(float, __builtin_amdgcn_readlane(vbits, kk)); rank += ((vk > val) || (vk == val && kk < jj)) ? 1 : 0; }
            const unsigned long long mk = __ballot(elig && rank < 16);
            if (lane == 0) { selm[2 * tkk] = (unsigned)mk; selm[2 * tkk + 1] = (unsigned)(mk >> 32); }
        }
    }
    { const float g_c = ((const float*)(ws + WS_GATES))[row * 48 + hd * 3 + 0];
      LDS_WAIT();
      out16_update(oreg, acc, g_c, true, lane); }
    __syncthreads();
    unsigned sel_lo, sel_hi; unsigned long long umask;
    { const LAS unsigned* selm = (const LAS unsigned*)(lds + AT_SELM);
      unsigned ulo = selm[2 * lane], uhi = selm[2 * lane + 1];
#pragma unroll
      for (int o = 1; o < 64; o <<= 1) { ulo |= __shfl_xor(ulo, o); uhi |= __shfl_xor(uhi, o); }
      umask = ((unsigned long long)(unsigned)__builtin_amdgcn_readfirstlane(uhi) << 32) | (unsigned)__builtin_amdgcn_readfirstlane(ulo);
      sel_lo = selm[2 * tk]; sel_hi = selm[2 * tk + 1]; }
    { const f16* qp = (const f16*)(ws + WS_QN) + row * DM + hd * 128 + 8 * h; const f16* qr = (const f16*)(ws + WS_QR) + row * 512 + hd * 32 + 8 * h;
#pragma unroll
      for (int s = 0; s < 8; ++s) qf[s] = (s < 2) ? *(const f16x8*)(qr + 16 * s) : *(const f16x8*)(qp + 16 * s); }
    m = 0.f; l = 0.f;
#pragma unroll
    for (int dt = 0; dt < 4; ++dt)
#pragma unroll
        for (int r = 0; r < 16; ++r) acc[dt][r] = 0.f;
    flash_loop<2>(umask, (const f16*)(ws + WS_KS) + (size_t)(b * 4 + g) * SEQ * 128, (const f16*)(ws + WS_VST) + (size_t)(b * 4 + g) * 128 * SEQ, 8192, 64, lds, qf, acc, m, l, 0.f, cur, tk, 0, sel_lo, sel_hi, tid);
    { const float g_s = ((const float*)(ws + WS_GATES))[row * 48 + hd * 3 + 1];
      l = l_comb(l); out16_update(oreg, acc, l > 0.f ? g_s / l : 0.f, false, lane); }
    m = 0.f; l = 0.f;
#pragma unroll
    for (int dt = 0; dt < 4; ++dt)
#pragma unroll
        for (int r = 0; r < 16; ++r) acc[dt][r] = 0.f;
    { const int jlo = cur >= 8 ? cur - 8 : 0; const unsigned long long wmask = ((cur == 63 ? ~0ull : ((1ull << (cur + 1)) - 1ull))) & ~((1ull << jlo) - 1ull);
      flash_loop<3>(wmask, (const f16*)(ws + WS_KW) + (size_t)(b * 4 + g) * SEQ * 128, (const f16*)(ws + WS_VWT) + (size_t)(b * 4 + g) * 128 * SEQ, 8192, 64, lds, qf, acc, m, l, 0.f, cur, tk, 0, 0u, 0u, tid); }
    { const float g_w = ((const float*)(ws + WS_GATES))[row * 48 + hd * 3 + 2]; l = l_comb(l); const float sc = l > 0.f ? g_w / l : 0.f;
      f16* op = (f16*)(ws + WS_A1) + row * DM + hd * 128 + 4 * h;
#pragma unroll
      for (int dt = 0; dt < 4; ++dt)
#pragma unroll
          for (int hf = 0; hf < 2; ++hf) {
              const f16x8 pv = *(const LAS f16x8*)(oreg + ((dt * 2 + hf) * 64 + lane) * 16);
              f16x4 o0, o1;
#pragma unroll
              for (int e = 0; e < 4; ++e) { o0[e] = (f16)((float)pv[e] + acc[dt][8 * hf + e] * sc); o1[e] = (f16)((float)pv[4 + e] + acc[dt][8 * hf + 4 + e] * sc); }
              *(f16x4*)(op + 32 * dt + 16 * hf) = o0; *(f16x4*)(op + 32 * dt + 16 * hf + 8) = o1;
          } }
    LDS_WAIT();
    __syncthreads();
}
__device__ __forceinline__ float reduce4(float v0, float v1, float v2, float v3, int lane) {
    const bool up = (lane & 32) != 0;
    float a0 = up ? v2 : v0, a1 = up ? v3 : v1; const float b0 = up ? v0 : v2, b1 = up ? v1 : v3;
    a0 += __shfl_xor(b0, 32); a1 += __shfl_xor(b1, 32);
    const bool up2 = (lane & 16) != 0;
    float c0 = up2 ? a1 : a0; const float d0 = up2 ? a0 : a1;
    c0 += __shfl_xor(d0, 16);
    c0 += __shfl_xor(c0, 8); c0 += __shfl_xor(c0, 4); c0 += __shfl_xor(c0, 2); c0 += __shfl_xor(c0, 1);
    return c0;
}
__device__ __forceinline__ void softmax4(LAS float* sc, int n, int tid) {
    const int lane = tid & 63, w = __builtin_amdgcn_readfirstlane(tid >> 6);
    if (w < 4) {
        LAS float* s = sc + w * 1024; float mx = -__builtin_inff();
        for (int i = lane; i < n; i += 64) mx = fmaxf(mx, s[i]);
        mx = wave_max(mx); if (!(mx > -__builtin_inff())) mx = 0.f;
        float sum = 0.f;
        for (int i = lane; i < n; i += 64) { const float e = __expf(s[i] - mx); s[i] = e; sum += e; }
        sum = wave_sum(sum); const float inv = sum > 0.f ? 1.0f / sum : 1.0f;
        for (int i = lane; i < n; i += 64) s[i] *= inv;
    }
    __syncthreads();
}
constexpr int SA_STG = 33792, SA_V = 17408, SA_QS = 67584, SA_SC2 = 71680, SA_SC = 73728, SA_ST = 74752, SA_LIST = 74816, SA_VAL = 74880, SA_SCALL = 75968;
struct SaRegs { f32x4 k[4], v[4]; };
__device__ __forceinline__ void sa_load_f32(SaRegs& R, const float* r0, const float* r1, int split, int nvalid, int tid) {
#pragma unroll
    for (int i = 0; i < 4; ++i) { const int idx = tid + 512 * i, row = idx >> 5, c4 = (idx & 31) * 4;
        const float* kp = (row < split) ? r0 + (size_t)row * 1024 : r1 + (size_t)(row - split) * 1024;
        if (row < nvalid) { R.k[i] = *(const f32x4*)(kp + c4); R.v[i] = *(const f32x4*)(kp + 512 + c4); }
        else { R.k[i] = (f32x4){0.f, 0.f, 0.f, 0.f}; R.v[i] = (f32x4){0.f, 0.f, 0.f, 0.f}; } }
}
__device__ __forceinline__ void sa_store_f32(const SaRegs& R, LAS unsigned char* stg, int tid) {
#pragma unroll
    for (int i = 0; i < 4; ++i) { const int idx = tid + 512 * i, row = idx >> 5, c4 = (idx & 31) * 4;
        *(LAS f16x4*)(stg + row * 272 + c4 * 2) = cvt4(R.k[i]); *(LAS f16x4*)(stg + SA_V + row * 256 + c4 * 2) = cvt4(R.v[i]); }
}
__device__ __forceinline__ void sa_scores(const LAS unsigned char* stg, const LAS float* q  , LAS float* sc2, int tid) {
    const int key = tid & 63, hd = (tid >> 6) & 3, hf = tid >> 8;
    const LAS f16* kr = (const LAS f16*)(stg + key * 272) + 64 * hf; const LAS float* qr = q + hd * 128 + 64 * hf;
    float s = 0.f;
#pragma unroll
    for (int i = 0; i < 8; ++i) { const f16x8 kk = *(const LAS f16x8*)(kr + 8 * i); const f32x4 qa = *(const LAS f32x4*)(qr + 8 * i), qb = *(const LAS f32x4*)(qr + 8 * i + 4);
        s += (float)kk[0] * qa[0] + (float)kk[1] * qa[1] + (float)kk[2] * qa[2] + (float)kk[3] * qa[3] + (float)kk[4] * qb[0] + (float)kk[5] * qb[1] + (float)kk[6] * qb[2] + (float)kk[7] * qb[3]; }
    sc2[(hf * 4 + hd) * 64 + key] = s;
}
__device__ __forceinline__ void sa_online(LAS unsigned char* lds, int nkeep, int tid) {
    const int lane = tid & 63, w = __builtin_amdgcn_readfirstlane(tid >> 6);
    if (w < 4) {
        const LAS float* sc2 = (const LAS float*)(lds + SA_SC2); LAS float* sc = (LAS float*)(lds + SA_SC); LAS float* st = (LAS float*)(lds + SA_ST);
        float s = sc2[w * 64 + lane] + sc2[(4 + w) * 64 + lane];
        if (lane >= nkeep) s = -__builtin_inff();
        const float mo = st[w], mx = wave_max(s), mn = fmaxf(mo, mx);
        const float pv = __expf(s - mn), ps = wave_sum(pv), al = __expf(mo - mn);
        sc[w * 64 + lane] = pv;
        if (lane == 0) { st[w] = mn; st[4 + w] = st[4 + w] * al + ps; st[8 + w] = al; }
    }
}
__device__ __forceinline__ void attn_sample_unit(LAS unsigned char* lds, int unit, const Params& p, int tid_in) {
    int tid = tid_in; asm volatile("" : "+v"(tid));
    unsigned char* ws = p.ws;
    const int lane = tid & 63, w = __builtin_amdgcn_readfirstlane(tid >> 6);
    const int b = unit >> 4, g = (unit >> 2) & 3, ii = unit & 3, tok = b * LS + ii, t = PAST + ii;
    LAS float* qs = (LAS float*)(lds + SA_QS); LAS float* sc2 = (LAS float*)(lds + SA_SC2); LAS float* sc = (LAS float*)(lds + SA_SC); LAS float* st = (LAS float*)(lds + SA_ST);
    LAS int* list = (LAS int*)(lds + SA_LIST); LAS float* val = (LAS float*)(lds + SA_VAL); LAS float* scall = (LAS float*)(lds + SA_SCALL);
    const int* pt = (const int*)p.in[7] + b * NPAGES;
    { const int hh = (tid >> 7), d = tid & 127;
      qs[hh * 128 + d] = ((const float*)(ws + WS_QNS))[(size_t)tok * DM + (4 * g + hh) * 128 + d];
      qs[512 + hh * 128 + d] = ((const float*)(ws + WS_QRS))[(size_t)tok * DM + (4 * g + hh) * 128 + d]; }
    const int hh_t = tid >> 7, d_t = tid & 127;
    const float* gt = (const float*)(ws + WS_GATESS) + (size_t)tok * 48 + (4 * g + hh_t) * 3;
    const float g_c = gt[0], g_s = gt[1], g_w = gt[2];
    float o_tot = 0.f;
    const f16* Kc = (const f16*)(ws + WS_KCS) + (size_t)(b * 4 + g) * 1024 * 128; const f16* Vc = (const f16*)(ws + WS_VCS) + (size_t)(b * 4 + g) * 1024 * 128;
    {
        f16x8 r0, r1;
        { const int i0 = tid, i1 = tid + 512; r0 = *(const f16x8*)(Kc + (size_t)(i0 >> 4) * 128 + (i0 & 15) * 8); r1 = *(const f16x8*)(Kc + (size_t)(i1 >> 4) * 128 + (i1 & 15) * 8);
          *(LAS f16x8*)(lds + (i0 >> 4) * 272 + (i0 & 15) * 16) = r0; *(LAS f16x8*)(lds + (i1 >> 4) * 272 + (i1 & 15) * 16) = r1; }
        __syncthreads();
        for (int ct = 0; ct < 16; ++ct) {
            LAS unsigned char* cur = lds + (ct & 1) * SA_STG; LAS unsigned char* nxt = lds + ((ct + 1) & 1) * SA_STG;
            if (ct + 1 < 16) { const int i0 = tid, i1 = tid + 512; const f16* kb = Kc + (size_t)(ct + 1) * 64 * 128;
                r0 = *(const f16x8*)(kb + (size_t)(i0 >> 4) * 128 + (i0 & 15) * 8); r1 = *(const f16x8*)(kb + (size_t)(i1 >> 4) * 128 + (i1 & 15) * 8); }
            sa_scores(cur, qs, sc2, tid);
            __syncthreads();
            if (tid < 256) { const int key = tid & 63, hd = tid >> 6, n = 64 * ct + key; scall[hd * 1024 + n] = (n < 1023) ? sc2[hd * 64 + key] + sc2[(4 + hd) * 64 + key] : -__builtin_inff(); }
            if (ct + 1 < 16) { const int i0 = tid, i1 = tid + 512; *(LAS f16x8*)(nxt + (i0 >> 4) * 272 + (i0 & 15) * 16) = r0; *(LAS f16x8*)(nxt + (i1 >> 4) * 272 + (i1 & 15) * 16) = r1; }
            __syncthreads();
        }
    }
    softmax4(scall, 1024, tid);
    if (tid < 257) {
        const int j = tid; float imp = 0.f;
        for (int i = 4 * j - 1; i <= 4 * j + 3; ++i) if (i >= 0 && i <= 1022) imp += (scall[i] + scall[1024 + i]) + (scall[2048 + i] + scall[3072 + i]);
        val[j] = (j == 0 || j >= 255) ? 1.0e4f : imp;
    }
    __syncthreads();
    if (tid < 257) {
        const int j = tid; const float v = val[j]; int rank = 0;
        for (int k = 0; k < 257; ++k) { const float vk = val[k]; rank += ((vk > v) || (vk == v && k < j)) ? 1 : 0; }
        if (rank < 16) list[rank] = j;
    }
    {
        f16x8 r0, r1; float o = 0.f;
        { const int i0 = tid, i1 = tid + 512; r0 = *(const f16x8*)(Vc + (size_t)(i0 >> 4) * 128 + (i0 & 15) * 8); r1 = *(const f16x8*)(Vc + (size_t)(i1 >> 4) * 128 + (i1 & 15) * 8);
          *(LAS f16x8*)(lds + SA_V + (i0 >> 4) * 256 + (i0 & 15) * 16) = r0; *(LAS f16x8*)(lds + SA_V + (i1 >> 4) * 256 + (i1 & 15) * 16) = r1; }
        __syncthreads();
        for (int ct = 0; ct < 16; ++ct) {
            const LAS f16* cur = (const LAS f16*)(lds + (ct & 1) * SA_STG + SA_V); LAS unsigned char* nxt = lds + ((ct + 1) & 1) * SA_STG + SA_V;
            if (ct + 1 < 16) { const int i0 = tid, i1 = tid + 512; const f16* vb = Vc + (size_t)(ct + 1) * 64 * 128;
                r0 = *(const f16x8*)(vb + (size_t)(i0 >> 4) * 128 + (i0 & 15) * 8); r1 = *(const f16x8*)(vb + (size_t)(i1 >> 4) * 128 + (i1 & 15) * 8); }
            const LAS float* pr = scall + hh_t * 1024 + 64 * ct;
#pragma unroll 16
            for (int k = 0; k < 64; ++k) o += pr[k] * (float)cur[k * 128 + d_t];
            if (ct + 1 < 16) { const int i0 = tid, i1 = tid + 512; *(LAS f16x8*)(nxt + (i0 >> 4) * 256 + (i0 & 15) * 16) = r0; *(LAS f16x8*)(nxt + (i1 >> 4) * 256 + (i1 & 15) * 16) = r1; }
            __syncthreads();
        }
        o_tot += g_c * o;
    }
#pragma unroll 1
    for (int br = 0; br < 2; ++br) {
        const int nblk = br == 0 ? 16 : 8;
        const LAS float* q = qs + 512;
        if (tid < 4) { st[tid] = -1e30f; st[4 + tid] = 0.f; st[8 + tid] = 1.f; }
        float o = 0.f;
        SaRegs R;
        const float* r0p; const float* r1p; int split, nvalid;
#define SA_DESC(sidx) do { if (br == 0) { const int blk = list[sidx]; split = 64; r1p = nullptr; \
                if (blk < 256) { r0p = p.in[3] + (((size_t)pt[blk >> 1] * PAGE + (blk & 1) * 64) * 2) * 512 + g * 128; nvalid = 64; } \
                else { r0p = p.out + O_SLCS + (size_t)(b * LS) * 1024 + g * 128; nvalid = ii + 1; } } \
            else { const int pos0 = t - 511 + 64 * (sidx); nvalid = 64; \
                r0p = p.in[4] + ((size_t)(b * 512 + pos0 - (PAST - 512)) * 2) * 512 + g * 128; split = PAST - pos0; if (split > 64) split = 64; \
                r1p = p.out + O_SWAS + ((size_t)(b * 512 + 508)) * 1024 + g * 128; } } while (0)
        SA_DESC(0);
        sa_load_f32(R, r0p, r1p, split, nvalid, tid);
        __syncthreads();
        sa_store_f32(R, lds, tid);
        __syncthreads();
        for (int s = 0; s < nblk; ++s) {
            LAS unsigned char* cur = lds + (s & 1) * SA_STG; LAS unsigned char* nxt = lds + ((s + 1) & 1) * SA_STG;
            const int nv_cur = nvalid;
            if (s + 1 < nblk) { SA_DESC(s + 1); sa_load_f32(R, r0p, r1p, split, nvalid, tid); }
            sa_scores(cur, q, sc2, tid);
            __syncthreads();
            sa_online(lds, nv_cur, tid);
            __syncthreads();
            { const float al = st[8 + hh_t]; const LAS f16* vb = (const LAS f16*)(cur + SA_V); const LAS float* pr = sc + hh_t * 64; float a = 0.f;
#pragma unroll 16
              for (int k = 0; k < 64; ++k) a += pr[k] * (float)vb[k * 128 + d_t];
              o = o * al + a; }
            if (s + 1 < nblk) sa_store_f32(R, nxt, tid);
            __syncthreads();
        }
#undef SA_DESC
        const float lsum = st[4 + hh_t];
        o_tot += (br == 0 ? g_s : g_w) * (lsum > 0.f ? o / lsum : 0.f);
        __syncthreads();
    }
    ((f16*)(ws + WS_AS1))[(size_t)tok * DM + (4 * g + hh_t) * 128 + d_t] = (f16)o_tot;
    __syncthreads();
}
constexpr int NPHASE = 41;
#ifndef SQ0
#define SQ0 40
#endif
#ifndef SG_FIRST
#define SG_FIRST 0
#endif
#ifndef PG8_SP2
#define PG8_SP2 true
#endif
#ifndef PG8_ALIGN
#define PG8_ALIGN false
#endif
#ifndef REP_PRO
#define REP_PRO 1
#endif
#ifndef REP_S5
#define REP_S5 1
#endif
#ifndef REP_ATT
#define REP_ATT 1
#endif
#ifndef REP_SG
#define REP_SG 1
#endif
#ifndef REP_RN
#define REP_RN 1
#endif
#ifndef REP_GEMM
#define REP_GEMM 1
#endif
__host__ __device__ inline bool phase_active(int ph) {
    if (ph == 0) return true;
    const int L = (ph - 1) / 10, s = (ph - 1) % 10;
    if (s == 1) return L <= 2;
    if (s == 2) return L == 2;
    if (s == 4) return false;
    if (s == 3 || s == 5) return L >= 2;
    return true;
}
#ifndef PAD_SEL
#define PAD_SEL 0
#endif
#ifndef PAD_US
#define PAD_US 1000
#endif
#define IN(k) (lo <= (k) && (k) < hi)
#ifndef PAD_LMASK
#define PAD_LMASK 15
#endif
#define PAD_BEGIN(sbit) unsigned long long pad_t0 = 0; if (((PAD_SEL >> (sbit)) & 1) && ((PAD_LMASK >> L) & 1)) pad_t0 = __builtin_amdgcn_s_memrealtime();
#define PAD_END(sbit) if (((PAD_SEL >> (sbit)) & 1) && ((PAD_LMASK >> L) & 1)) { while (__builtin_amdgcn_s_memrealtime() - pad_t0 < (unsigned long long)PAD_US * 100ull) __builtin_amdgcn_s_sleep(8); }
#ifndef BAR_DUP
#define BAR_DUP 1
#endif
#define SEAM(k) do { if (use_bar && (k) + 1 < hi) { for (int _b = 0; _b < BAR_DUP; ++_b) xcd_barrier(bar); } } while (0)
template <int L>
__device__ __forceinline__ void layer_phases(const Params& p, LAS unsigned char* lds, const XcdBarrier& bar, const bool use_bar, const int lo, const int hi, const int tid, const int G, const int bx, const int vcu) {
    unsigned char* const ws = p.ws;
    const int lane = tid & 63, wave = __builtin_amdgcn_readfirstlane(tid >> 6);
    const int gw = vcu * 8 + wave, NGW = G * 8;
    constexpr int base = 1 + 10 * L;
    if (IN(base + 0)) { PAD_BEGIN(0)
        if constexpr (L < 2) {
            for (int rep = 0; rep < REP_S5; ++rep)
            for (int u = vcu; u < NBP * NG; u += G) s5_prompt_unit(lds, L, u >> 7, u & 127, p, tid);
            for (int rep = 0; rep < REP_S5; ++rep)
            for (int u = gw; u < NBS * NG; u += NGW) s5_sample_wave(L, u >> 7, u & 127, p, lane);
        } else {
            constexpr int N = (L == 2) ? (NKV + NQGP) : DM; const f16* Wt = (const f16*)(ws + (L == 2 ? WS_WKVQG : WS_WQG1));
            pg8::Gemm g{(const f16*)(ws + WS_X), Wt, MP, N, DM}; pg8::StaticOrder S; S.init(MP, N, G, bx);
            pg8::EpiProj E{L == 2 ? 12 : 0, p.out, (f16*)(ws + WS_RC), (f16*)(ws + WS_KS), (f16*)(ws + WS_VST), (f16*)(ws + WS_KW), (f16*)(ws + WS_VWT), (f16*)(ws + WS_QN), (f16*)(ws + WS_QR), (float*)(ws + WS_GATES), (const float*)(ws + WS_ROPE)};
            pg8::gemm_phase<pg8::EpiProj, pg8::StaticOrder, PG8_ALIGN, PG8_SP2>(lds, g, S, E);
            if constexpr (L == 2) {
                if (G == 256 && bx >= 160) {
                    pg8::Gemm g2{(const f16*)(ws + WS_RC), (const f16*)(ws + WS_CW1), 272 * 256, 1024, 2048}; pg8::CmpOrder S2{1 << 20, 448 + (bx - 160), 544};
                    pg8::EpiF16 E2{(f16*)(ws + WS_PROJ), 512, 1};
                    pg8::gemm_phase<pg8::EpiF16, pg8::CmpOrder, PG8_ALIGN, PG8_SP2>(lds, g2, S2, E2);
                }
            }
            if constexpr (L == 3) pgates_phase(lds, Wt, (const f16*)(ws + WS_X), (float*)(ws + WS_GATES), vcu, G, tid);
            sgemm_phase<3>(lds, Wt, (L == 2) ? N : NQGP, DM, (const f16*)(ws + WS_AS0), p, L, L == 2 ? NKV : 0, vcu, G, tid);
        }
        PAD_END(0) SEAM(base + 0);
    }
    if constexpr (L <= 2) {
        if (IN(base + 1)) { PAD_BEGIN(1)
            if constexpr (L < 2) {
                const f16* Wt = (const f16*)(ws + WS_WGLU) + (size_t)L * DM * DM;
                pg8::Gemm g{(const f16*)(ws + WS_A1), Wt, MP, DM, DM}; pg8::StaticOrder S; S.init(MP, DM, G, bx);
                pg8::EpiGLU E{(f16*)(ws + WS_Y), (const f16*)(ws + WS_A1), p.in[18] + (size_t)L * DM};
                if (SG_FIRST && (bx & 1)) { sgemm_phase<0>(lds, Wt, DM, DM, (const f16*)(ws + WS_AS1), p, L, 0, vcu, G, tid); }
                pg8::gemm_phase<pg8::EpiGLU, pg8::StaticOrder, PG8_ALIGN, PG8_SP2>(lds, g, S, E);
                if (!(SG_FIRST && (bx & 1))) { sgemm_phase<0>(lds, Wt, DM, DM, (const f16*)(ws + WS_AS1), p, L, 0, vcu, G, tid); }
            } else {
                pg8::Gemm g{(const f16*)(ws + WS_RC), (const f16*)(ws + WS_CW1), 272 * 256, 1024, 2048}; pg8::CmpOrder S{G, bx, G == 256 ? 448 : 544};
                pg8::EpiF16 E{(f16*)(ws + WS_PROJ), 512, 1};
                pg8::gemm_phase<pg8::EpiF16, pg8::CmpOrder, PG8_ALIGN, PG8_SP2>(lds, g, S, E);
            }
            PAD_END(1) SEAM(base + 1);
        }
    }
    if constexpr (L == 2) {
        if (IN(base + 2)) { PAD_BEGIN(2)
            for (int u = vcu; u < 544; u += G) cmp2_unit(lds, u, p, tid);
            PAD_END(2) SEAM(base + 2);
        }
    }
    if constexpr (L >= 2) {
        if (IN(base + 3)) { PAD_BEGIN(3)
            { const int xq = bx & 7;
              unsigned* qctr = (unsigned*)(ws + WS_CTL) + 2048 + 64 * ((L - 2) * 8 + xq);
              volatile LAS unsigned* qslot = (volatile LAS unsigned*)(lds + LDS_XB) + 2;
              for (;;) {
                  if (tid == 0) qslot[0] = __hip_atomic_fetch_add(qctr, 1u, __ATOMIC_RELAXED, __HIP_MEMORY_SCOPE_AGENT);
                  __syncthreads();
                  const int it = (int)qslot[0];
                  __syncthreads();
                  if (it >= 80) break;
                  if (it >= SQ0 && it < SQ0 + 16) attn_sample_unit(lds, xq * 16 + (it - SQ0), p, tid);
                  else attn_prompt_tile(lds, xq >> 2, xq & 3, 63 - (it < SQ0 ? it : it - 16), p, tid);
              } }
            PAD_END(3) SEAM(base + 3);
        }
        if (IN(base + 5)) { PAD_BEGIN(5)
            const f16* Wt = (const f16*)(ws + WS_WO) + (size_t)(L - 2) * DM * DM;
            pg8::Gemm g{(const f16*)(ws + WS_A1), Wt, MP, DM, DM}; pg8::StaticOrder S; S.init(MP, DM, G, bx);
            pg8::EpiF16 E{(f16*)(ws + WS_Y), DM, 0x7fffffff};
            if (SG_FIRST && (bx & 1)) { sgemm_phase<2>(lds, Wt, DM, DM, (const f16*)(ws + WS_AS1), p, L, 0, vcu, G, tid); }
            pg8::gemm_phase<pg8::EpiF16, pg8::StaticOrder, PG8_ALIGN, PG8_SP2>(lds, g, S, E);
            if (!(SG_FIRST && (bx & 1))) { sgemm_phase<2>(lds, Wt, DM, DM, (const f16*)(ws + WS_AS1), p, L, 0, vcu, G, tid); }
            PAD_END(5) SEAM(base + 5);
        }
    }
    if (IN(base + 6)) { PAD_BEGIN(6)
        const float* gpost = (L < 2) ? p.in[19] + (size_t)L * DM : p.in[31] + (size_t)(L - 2) * DM;
        resnorm2_rows<(L == 0), 1>((const f16*)(ws + WS_Y), gpost, p.in[0], (f16*)(ws + WS_X), (float*)(ws + WS_RS), nullptr, nullptr, nullptr, gw, NGW, MP, lane);
        if (gw < MS) resnorm_row((const float*)(ws + WS_YS), gpost, (L == 0) ? p.in[1] : (const float*)(ws + WS_XS), (float*)(ws + WS_XS), 1, nullptr, (f16*)(ws + WS_AS0), nullptr, gw, lane);
        PAD_END(6) SEAM(base + 6);
    }
    if (IN(base + 7)) { PAD_BEGIN(7)
        const f16* Wt = (const f16*)(ws + WS_WUP) + (size_t)L * DM * FF;
        pg8::Gemm g{(const f16*)(ws + WS_X), Wt, MP, FF, DM}; pg8::StaticOrder S; S.init(MP, FF, G, bx);
        pg8::EpiRelu2 E{(f16*)(ws + WS_H), FF};
        if (SG_FIRST && (bx & 1)) { sgemm_phase<1>(lds, Wt, FF, DM, (const f16*)(ws + WS_AS0), p, L, 0, vcu, G, tid); }
        pg8::gemm_phase<pg8::EpiRelu2, pg8::StaticOrder, PG8_ALIGN, PG8_SP2>(lds, g, S, E);
        if (!(SG_FIRST && (bx & 1))) { sgemm_phase<1>(lds, Wt, FF, DM, (const f16*)(ws + WS_AS0), p, L, 0, vcu, G, tid); }
        PAD_END(7) SEAM(base + 7);
    }
    if (IN(base + 8)) { PAD_BEGIN(8)
        const f16* Wt = (const f16*)(ws + WS_WDN) + (size_t)L * DM * FF;
        pg8::Gemm g{(const f16*)(ws + WS_H), Wt, MP, DM, FF}; pg8::StaticOrder S; S.init(MP, DM, G, bx);
        pg8::EpiF16 E{(f16*)(ws + WS_Y), DM, 0x7fffffff};
        if (SG_FIRST && (bx & 1)) { sgemm_phase<2>(lds, Wt, DM, FF, (const f16*)(ws + WS_HS), p, L, 0, vcu, G, tid); }
        pg8::gemm_phase<pg8::EpiF16, pg8::StaticOrder, PG8_ALIGN, PG8_SP2>(lds, g, S, E);
        if (!(SG_FIRST && (bx & 1))) { sgemm_phase<2>(lds, Wt, DM, FF, (const f16*)(ws + WS_HS), p, L, 0, vcu, G, tid); }
        PAD_END(8) SEAM(base + 8);
    }
    if (IN(base + 9)) { PAD_BEGIN(9)
        const float* gpost = p.in[35] + (size_t)L * DM;
        if constexpr (L == 0) resnorm2_rows<false, 2>((const f16*)(ws + WS_Y), gpost, nullptr, (f16*)(ws + WS_X), (float*)(ws + WS_RS), nullptr, p.in[8] + DM, (f16*)(ws + WS_A0), gw, NGW, MP, lane);
        else if constexpr (L < 3) resnorm2_rows<false, 1>((const f16*)(ws + WS_Y), gpost, nullptr, (f16*)(ws + WS_X), (float*)(ws + WS_RS), nullptr, nullptr, nullptr, gw, NGW, MP, lane);
        else resnorm2_rows<false, 0>((const f16*)(ws + WS_Y), gpost, nullptr, (f16*)(ws + WS_X), (float*)(ws + WS_RS), p.out + O_YP, nullptr, nullptr, gw, NGW, MP, lane);
        if (gw < MS) {
            if constexpr (L == 0) resnorm_row((const float*)(ws + WS_YS), gpost, (const float*)(ws + WS_XS), (float*)(ws + WS_XS), 3, p.in[8] + DM, nullptr, (float*)(ws + WS_XNS), gw, lane);
            else if constexpr (L < 3) resnorm_row((const float*)(ws + WS_YS), gpost, (const float*)(ws + WS_XS), (float*)(ws + WS_XS), 1, nullptr, (f16*)(ws + WS_AS0), nullptr, gw, lane);
            else resnorm_row((const float*)(ws + WS_YS), gpost, (const float*)(ws + WS_XS), p.out + O_YS, 0, nullptr, nullptr, nullptr, gw, lane);
        }
        PAD_END(9) SEAM(base + 9);
    }
}
__global__ void __launch_bounds__(512, 2) mk_fwd(Params p) {
    extern __shared__ __attribute__((aligned(16))) unsigned char lds_raw[];
    LAS unsigned char* lds = (LAS unsigned char*)lds_raw;
    const int tid = threadIdx.x;
    const int G = gridDim.x, bx = blockIdx.x, vcu = (G % 8 == 0) ? (bx % 8) * (G / 8) + bx / 8 : bx;
    if (tid < 4) ((LAS unsigned*)(lds + LDS_XB))[tid] = 0u;
    __syncthreads();
    const int lo = p.ph_lo, hi = p.ph_hi;
    const bool use_bar = (hi - lo) > 1;
    XcdBarrier bar; bar.bar = (unsigned*)(p.ws + WS_CTL) + CW_BAR; bar.x = 0; bar.st = (volatile LAS unsigned*)(lds + LDS_XB);
    if (use_bar) bar = xcd_barrier_post((unsigned*)(p.ws + WS_CTL) + CW_BAR, (volatile LAS unsigned*)(lds + LDS_XB));
    if (IN(0)) { constexpr int L = 0; PAD_BEGIN(10) ph_prologue(p, lds, vcu, G, tid); if (REP_PRO > 1) { __syncthreads(); ph_prologue(p, lds, vcu, G, tid); } PAD_END(10) SEAM(0); }
    layer_phases<0>(p, lds, bar, use_bar, lo, hi, tid, G, bx, vcu);
    layer_phases<1>(p, lds, bar, use_bar, lo, hi, tid, G, bx, vcu);
    layer_phases<2>(p, lds, bar, use_bar, lo, hi, tid, G, bx, vcu);
    layer_phases<3>(p, lds, bar, use_bar, lo, hi, tid, G, bx, vcu);
}
#undef IN
#undef SEAM

#ifndef MK_MULTI_LAUNCH
#define MK_MULTI_LAUNCH 0
#endif
extern "C" void kernel_launch(void* const* d_in, const int* in_sizes, int n_in, void* d_out, int out_size, void* d_ws, size_t ws_size, hipStream_t stream) {
    static int grid = 0;
    if (grid == 0) {
        if (n_in != 36 || (size_t)out_size != O_END || ws_size < WS_END) { fprintf(stderr, "kernel_launch: unexpected shapes: n_in %d out %d ws %zu (need %zu)\n", n_in, out_size, ws_size, (size_t)WS_END); grid = -1; return; }
        int dev = 0, cus = 0, per_cu = 0;
        if (hipGetDevice(&dev) != hipSuccess || hipDeviceGetAttribute(&cus, hipDeviceAttributeMultiprocessorCount, dev) != hipSuccess) { grid = -1; return; }
        if (hipFuncSetAttribute((const void*)mk_fwd, hipFuncAttributeMaxDynamicSharedMemorySize, LDS_BYTES) != hipSuccess) { fprintf(stderr, "kernel_launch: hipFuncSetAttribute failed\n"); grid = -1; return; }
        if (hipOccupancyMaxActiveBlocksPerMultiprocessor(&per_cu, (const void*)mk_fwd, 512, LDS_BYTES) != hipSuccess || per_cu < 1) fprintf(stderr, "kernel_launch: occupancy query reports %d\n", per_cu);
        (void)hipGetLastError();
        grid = cus;
    }
    if (grid < 0) return;
    (void)hipMemsetAsync((char*)d_ws + WS_CTL, 0, CTL_BYTES, stream);
    Params P{};
    for (int i = 0; i < 36; ++i) P.in[i] = (const float*)d_in[i];
    P.out = (float*)d_out; P.ws = (unsigned char*)d_ws;
    for (int i = 0; i < 16; ++i) P.inv_freq[i] = powf(500000.0f, -(float)i / 16.0f);
#if MK_MULTI_LAUNCH
    for (int ph = 0; ph < NPHASE; ++ph) { if (!phase_active(ph)) continue; P.ph_lo = ph; P.ph_hi = ph + 1; hipLaunchKernelGGL(mk_fwd, dim3(grid), dim3(512), LDS_BYTES, stream, P); }
#else
    P.ph_lo = 0; P.ph_hi = NPHASE;
    hipLaunchKernelGGL(mk_fwd, dim3(grid), dim3(512), LDS_BYTES, stream, P);
#endif
    const hipError_t le = hipPeekAtLastError();
    if (le != hipSuccess) fprintf(stderr, "kernel_launch: launch failed: %s\n", hipGetErrorName(le));
}
```

```cpp
#include <hip/hip_runtime.h>
#include <cstdio>
#include <cmath>

#define LAS __attribute__((address_space(3)))
#define GAS __attribute__((address_space(1)))
typedef _Float16 f16;
typedef f16 f16x8 __attribute__((ext_vector_type(8)));
typedef f16 f16x4 __attribute__((ext_vector_type(4)));
typedef f16 f16x2 __attribute__((ext_vector_type(2)));
typedef float f32x2 __attribute__((ext_vector_type(2)));
typedef float f32x4 __attribute__((ext_vector_type(4)));
typedef float f32x16 __attribute__((ext_vector_type(16)));
typedef unsigned u32x4 __attribute__((ext_vector_type(4)));
typedef unsigned u32x2 __attribute__((ext_vector_type(2)));
#define LDS_WAIT() asm volatile("s_waitcnt lgkmcnt(0)" ::: "memory")
#define VM_WAIT() asm volatile("s_waitcnt vmcnt(0)" ::: "memory")

constexpr int DM = 2048, FF = 8192, SEQ = 4096, NBP = 2, MP = NBP * SEQ;
constexpr int NBS = 8, LS = 4, MS = NBS * LS;
constexpr int PAST = 16384, NPAGES = 128, PAGE = 128;
constexpr int NG = 128, NST = 64;
constexpr int NQG = 2096, NQGP = 2304, NKV = 3072;
constexpr float EPS = 1e-6f;
constexpr float QSCALE = 0.08838834764831845f;
constexpr float LOG2E = 1.4426950408889634f;

constexpr size_t O_YP = 0, O_YS = O_YP + (size_t)MP * DM, O_CMPP = O_YS + (size_t)MS * DM, O_CMPS = O_CMPP + (size_t)MP * 1024,
                 O_SLCP = O_CMPS + (size_t)MS * 1024, O_SLCS = O_SLCP + (size_t)MP * 1024, O_SWAP = O_SLCS + (size_t)MS * 1024,
                 O_SWAS = O_SWAP + (size_t)NBP * 512 * 1024, O_REP = O_SWAS + (size_t)NBS * 512 * 1024, O_IMP = O_REP + 2 * NBP * NG * NST,
                 O_RES = O_IMP + 2 * NBP * NG * NST, O_IMS = O_RES + 2 * NBS * NG * NST, O_END = O_IMS + 2 * NBS * NG * NST;

constexpr size_t al256(size_t x) { return (x + 255) & ~(size_t)255; }
constexpr size_t WS_CTL = 0, CTL_BYTES = 1u << 20;
constexpr size_t WS_WGLU = WS_CTL + CTL_BYTES;
constexpr size_t WS_WUP = WS_WGLU + (size_t)2 * DM * DM * 2;
constexpr size_t WS_WDN = WS_WUP + (size_t)4 * FF * DM * 2;
constexpr size_t WS_WKVQG = WS_WDN + (size_t)4 * FF * DM * 2;
constexpr size_t WS_WQG1 = WS_WKVQG + (size_t)(NKV + NQGP) * DM * 2;
constexpr size_t WS_WO = WS_WQG1 + (size_t)NQGP * DM * 2;
constexpr size_t WS_CW1 = WS_WO + (size_t)2 * DM * DM * 2;
constexpr size_t WS_CW2 = WS_CW1 + (size_t)2 * 512 * 2048 * 2;
constexpr size_t WS_BST = WS_CW2 + (size_t)2 * 128 * 256 * 2;
constexpr size_t WS_CCT = WS_BST + (size_t)2 * NG * 128 * 16 * 2;
constexpr size_t WS_AT = WS_CCT + (size_t)2 * NG * 16 * 128 * 2;
constexpr size_t WS_BBF = WS_AT + (size_t)2 * NG * NST * 2 * 4;
constexpr size_t WS_DT = WS_BBF + (size_t)2 * NG * NST * 32 * 4;
constexpr size_t WS_ROPE = WS_DT + 1024;
constexpr size_t WS_PE = al256(WS_ROPE + (size_t)4100 * 32 * 4);
constexpr size_t WS_X = WS_PE + 2048;
constexpr size_t WS_Y = WS_X + (size_t)MP * DM * 4;
constexpr size_t WS_A0 = WS_Y + (size_t)MP * DM * 4;
constexpr size_t WS_A1 = WS_A0 + (size_t)MP * DM * 2;
constexpr size_t WS_H = WS_A1 + (size_t)MP * DM * 2;
constexpr size_t WS_QN = WS_H + (size_t)MP * FF * 2;
constexpr size_t WS_QR = WS_QN + (size_t)MP * DM * 2;
constexpr size_t WS_GATES = WS_QR + (size_t)MP * DM * 2;
constexpr size_t WS_RC = WS_GATES + (size_t)MP * 48 * 4;
constexpr size_t RC_P_ELEMS = (size_t)2 * 2 * 4 * 4096 * 128, RC_S_ELEMS = (size_t)2 * 8 * 4 * 16384 * 128;
constexpr size_t WS_KS = WS_RC + (RC_P_ELEMS + RC_S_ELEMS) * 2;
constexpr size_t KVB = (size_t)2 * 4 * 4096 * 128 * 2;
constexpr size_t WS_VST = WS_KS + KVB, WS_KW = WS_VST + KVB, WS_VWT = WS_KW + KVB;
constexpr size_t WS_PROJ = WS_VWT + KVB;
constexpr size_t WS_KC = WS_PROJ + (size_t)(4096 + 65536) * 512 * 4;
constexpr size_t WS_VCT = WS_KC + (size_t)8 * 256 * 128 * 2;
constexpr size_t WS_KCS = WS_VCT + (size_t)8 * 256 * 128 * 2;
constexpr size_t WS_VCS = WS_KCS + (size_t)32 * 1024 * 128 * 2;
constexpr size_t WS_XS = WS_VCS + (size_t)32 * 1024 * 128 * 2;
constexpr size_t WS_YS = WS_XS + (size_t)MS * DM * 4;
constexpr size_t WS_XNS = WS_YS + (size_t)MS * DM * 4;
constexpr size_t WS_AS0 = WS_XNS + (size_t)MS * DM * 4;
constexpr size_t WS_AS1 = WS_AS0 + (size_t)MS * DM * 2;
constexpr size_t WS_HS = WS_AS1 + (size_t)MS * DM * 2;
constexpr size_t WS_QNS = WS_HS + (size_t)MS * FF * 2;
constexpr size_t WS_QRS = WS_QNS + (size_t)MS * DM * 4;
constexpr size_t WS_GATESS = WS_QRS + (size_t)MS * DM * 4;
constexpr size_t WS_MI = al256(WS_GATESS + (size_t)MS * 48 * 4);
constexpr size_t WS_W1 = WS_MI + (size_t)2 * NG * 128 * 256 * 2;
constexpr size_t WS_KT = WS_W1 + (size_t)2 * NG * 256 * 128 * 2;
constexpr size_t WS_RS = WS_KT + (size_t)2 * NG * 4096 * 2;
constexpr size_t WS_END = WS_RS + (size_t)MP * 4;
constexpr int CW_BAR = 4096;

constexpr int LDS_BYTES = 155648;
constexpr int LDS_XB = 155632;

struct Params {
    const float* in[36];
    float* out;
    unsigned char* ws;
    float inv_freq[16];
    int ph_lo, ph_hi;
};

#define DPP_F(v, ctrl) __builtin_bit_cast(float, __builtin_amdgcn_update_dpp(__builtin_bit_cast(int, v), __builtin_bit_cast(int, v), ctrl, 0xf, 0xf, false))
__device__ __forceinline__ float wave_sum(float v) {
    v += __builtin_bit_cast(float, __builtin_amdgcn_update_dpp(0, __builtin_bit_cast(int, v), 0x111, 0xf, 0xf, false));
    v += __builtin_bit_cast(float, __builtin_amdgcn_update_dpp(0, __builtin_bit_cast(int, v), 0x112, 0xf, 0xf, false));
    v += __builtin_bit_cast(float, __builtin_amdgcn_update_dpp(0, __builtin_bit_cast(int, v), 0x114, 0xf, 0xf, false));
    v += __builtin_bit_cast(float, __builtin_amdgcn_update_dpp(0, __builtin_bit_cast(int, v), 0x118, 0xf, 0xf, false));
    v += __builtin_bit_cast(float, __builtin_amdgcn_update_dpp(0, __builtin_bit_cast(int, v), 0x142, 0xa, 0xf, false));
    v += __builtin_bit_cast(float, __builtin_amdgcn_update_dpp(0, __builtin_bit_cast(int, v), 0x143, 0xc, 0xf, false));
    return __builtin_bit_cast(float, __builtin_amdgcn_readlane(__builtin_bit_cast(int, v), 63));
}
__device__ __forceinline__ float wave_max(float v) {
    v = fmaxf(v, DPP_F(v, 0x111)); v = fmaxf(v, DPP_F(v, 0x112)); v = fmaxf(v, DPP_F(v, 0x114)); v = fmaxf(v, DPP_F(v, 0x118));
    v = fmaxf(v, __builtin_bit_cast(float, __builtin_amdgcn_update_dpp(__builtin_bit_cast(int, v), __builtin_bit_cast(int, v), 0x142, 0xa, 0xf, false)));
    v = fmaxf(v, __builtin_bit_cast(float, __builtin_amdgcn_update_dpp(__builtin_bit_cast(int, v), __builtin_bit_cast(int, v), 0x143, 0xc, 0xf, false)));
    return __builtin_bit_cast(float, __builtin_amdgcn_readlane(__builtin_bit_cast(int, v), 63));
}
__device__ __forceinline__ float sigmoidf_(float x) { return __builtin_amdgcn_rcpf(1.0f + __expf(-x)); }
__device__ __forceinline__ float gelu_tanh(float y) { const float z = 0.7978845608028654f * (y + 0.044715f * y * y * y); return y * __builtin_amdgcn_rcpf(1.0f + __expf(-2.0f * z)); }

__device__ __forceinline__ f16x4 cvt4(const f32x4 v) { f16x4 r; r[0] = (f16)v[0]; r[1] = (f16)v[1]; r[2] = (f16)v[2]; r[3] = (f16)v[3]; return r; }
#ifndef WT_STORES
#define WT_STORES 0
#endif
struct WtBuf { __amdgpu_buffer_rsrc_t r; unsigned char* base; };
__device__ __forceinline__ WtBuf wt_make(void* base, unsigned nbytes) {
    const unsigned long long u = (unsigned long long)base;
    const unsigned lo = (unsigned)__builtin_amdgcn_readfirstlane((int)(unsigned)u), hi = (unsigned)__builtin_amdgcn_readfirstlane((int)(unsigned)(u >> 32));
    unsigned char* b = (unsigned char*)(((unsigned long long)hi << 32) | lo);
    WtBuf w; w.r = __builtin_amdgcn_make_buffer_rsrc(b, 0, (int)nbytes, 0x00020000); w.base = b; return w;
}
__device__ __forceinline__ void wt_st16(const WtBuf& w, unsigned off, f16x8 v) { if (WT_STORES) __builtin_amdgcn_raw_buffer_store_b128(__builtin_bit_cast(u32x4, v), w.r, (int)off, 0, 16); else *(f16x8*)(w.base + off) = v; }
__device__ __forceinline__ void wt_st8(const WtBuf& w, unsigned off, f16x4 v) { if (WT_STORES) __builtin_amdgcn_raw_buffer_store_b64(__builtin_bit_cast(u32x2, v), w.r, (int)off, 0, 16); else *(f16x4*)(w.base + off) = v; }
#define XB_TMO      128
#define XB_XCNT(j)  (256  + 64 * (j))
#define XB_XSUB(j)  (1280 + 64 * (j))
#define XB_XGEN(j)  (2304 + 64 * (j))
#define XB_TOP      3328
#define XB_TOPGEN   3392
#define XCD_BAR_WORDS 3456
#define XB_SPIN_CAP (1u << 22)
__device__ __forceinline__ unsigned xb_ld(unsigned* p)              { return __hip_atomic_load(p, __ATOMIC_RELAXED, __HIP_MEMORY_SCOPE_AGENT); }
__device__ __forceinline__ unsigned xb_add(unsigned* p, unsigned v) { return __hip_atomic_fetch_add(p, v, __ATOMIC_RELAXED, __HIP_MEMORY_SCOPE_AGENT); }
__device__ __forceinline__ unsigned xb_xcc_id() { return (unsigned)__builtin_amdgcn_s_getreg((3 << 11) | 20) & 0xFu; }
#define XB_SPIN(cond, bar) do { unsigned _sp = 0; while (cond) { __builtin_amdgcn_s_sleep(1); \
    if ((++_sp & 255u) == 0u) { if (xb_ld(&(bar)[XB_TMO])) break; if (_sp > XB_SPIN_CAP) { atomicAdd(&(bar)[XB_TMO], 1u); break; } } } } while (0)
struct XcdBarrier { unsigned* bar; unsigned x; volatile LAS unsigned* st; };
__device__ __forceinline__ XcdBarrier xcd_barrier_post(unsigned* bar, volatile LAS unsigned* st) {
    XcdBarrier b; b.bar = bar; b.x = xb_xcc_id(); b.st = st;
    if (threadIdx.x == 0) (void)xb_add(&bar[XB_XCNT(b.x)], 1u);
    return b;
}
__device__ __forceinline__ void xcd_barrier_complete(unsigned* bar, unsigned x, unsigned& nloc, unsigned& nx) {
    const unsigned G = gridDim.x * gridDim.y * gridDim.z;
    unsigned sum, cnt, mine, sp = 0u;
    for (;;) {
        sum = 0u; cnt = 0u; mine = 0u;
#pragma unroll
        for (unsigned j = 0; j < 16; ++j) { const unsigned c = xb_ld(&bar[XB_XCNT(j)]); sum += c; cnt += (c > 0u) ? 1u : 0u; mine = (j == x) ? c : mine; }
        if (sum == G) break;
        __builtin_amdgcn_s_sleep(1);
        if ((++sp & 255u) == 0u) { if (xb_ld(&bar[XB_TMO])) break; if (sp > XB_SPIN_CAP) { atomicAdd(&bar[XB_TMO], 1u); break; } }
    }
    nloc = mine > 0u ? mine : 1u; nx = cnt > 0u ? cnt : 1u;
}
__device__ __forceinline__ void xcd_barrier(const XcdBarrier& b) {
    asm volatile("s_waitcnt vmcnt(0)" ::: "memory");
    __syncthreads();
    if (threadIdx.x == 0) {
        unsigned* bar = b.bar;
        __builtin_amdgcn_s_waitcnt(0);
        unsigned nloc = b.st[0], nx = b.st[1];
        if (nloc == 0u) { xcd_barrier_complete(bar, b.x, nloc, nx); b.st[0] = nloc; b.st[1] = nx; }
        const unsigned old = xb_add(&bar[XB_XSUB(b.x)], 1u);
        const unsigned gen = old / nloc;
        if (old + 1u == (gen + 1u) * nloc) {
            __builtin_amdgcn_fence(__ATOMIC_RELEASE, "agent");
            asm volatile("s_waitcnt vmcnt(0)" ::: "memory");
            const unsigned og = xb_add(&bar[XB_TOP], 1u);
            const unsigned tg = og / nx;
            if (og + 1u == (tg + 1u) * nx) xb_add(&bar[XB_TOPGEN], 1u);
            else XB_SPIN(xb_ld(&bar[XB_TOPGEN]) == tg, bar);
            __builtin_amdgcn_fence(__ATOMIC_ACQUIRE, "agent");
            xb_add(&bar[XB_XGEN(b.x)], 1u);
            asm volatile("s_waitcnt vmcnt(0)" ::: "memory");
        } else {
            XB_SPIN(xb_ld(&bar[XB_XGEN(b.x)]) == gen, bar);
            __builtin_amdgcn_fence(__ATOMIC_ACQUIRE, "agent");
            asm volatile("s_waitcnt vmcnt(0)" ::: "memory");
        }
    }
    __syncthreads();
}
#ifndef PG8_WGM
#define PG8_WGM 2
#endif
namespace pg8 {
#define PG8_LAS __attribute__((address_space(3)))
typedef f16 bf16_t;
typedef f16x8 bf16x8;
constexpr int BM = 256, BK = 64, HALF = 128, HTB = HALF * BK * 2  , STAGE_BYTES = 8 * HTB, NXCD = 8, WGM = PG8_WGM;

__host__ __device__ __forceinline__ int lds_byte(int r, int c) { const int st = (r >> 4) * 2 + (c >> 5), rr = r & 15, cc = c & 31, ob = rr * 64 + cc * 2; return st * 1024 + (ob ^ (((ob >> 9) & 1) << 5)); }
__host__ __device__ __forceinline__ void stage_rc(int b, int& R, int& C) { const int st = b / 1024, sb = b % 1024, swz = sb ^ (((sb >> 9) & 1) << 5); R = (st >> 1) * 16 + swz / 64; C = (st & 1) * 32 + (swz % 64) / 2; }
__host__ __device__ __forceinline__ int perm32(int rho) { const int n = rho >> 4, i = rho & 15; return 8 * (i >> 2) + 4 * n + (i & 3); }

struct Unit { int pm, pn; };
struct Gemm { const bf16_t* A; const bf16_t* Bt; int M, N, K; };

struct StaticOrder {
    int nM, nN, nwg, G, c;
    __host__ __device__ void init(int M, int N, int G_, int c_) { nM = M / BM; nN = N / BM; nwg = nM * nN; G = G_; c = c_; }
    __host__ __device__ bool next(int i, Unit& u) const {
        const long L = (long)i * G + c; if (L >= nwg) return false;
        int wgid = (int)L; { const int q = nwg / NXCD, r = nwg % NXCD, xcd = wgid % NXCD, off = wgid / NXCD; wgid = (xcd < r ? xcd * (q + 1) : r * (q + 1) + (xcd - r) * q) + off; }
        const int nig = WGM * nN, gid = wgid / nig, fm = gid * WGM, gsz = (nM - fm) < WGM ? (nM - fm) : WGM;
        u.pm = fm + ((wgid % nig) % gsz); u.pn = (wgid % nig) / gsz; return true;
    }
    __device__ __forceinline__ void a_ready(const Unit&) const {}
    __device__ __forceinline__ void done(const Unit&) const {}
};

struct EpiF32 {
    static constexpr bool PERM = false, AFTER_DRAIN = false;
    float* C; int ldc; int pn_mask;
    __device__ __forceinline__ void operator()(const f32x4 (&acc)[2][2][4][2], const Unit& u, int wr, int wc, int fr, int fq) const {
        const int row0 = u.pm * BM + wr * 64 + fr, col0 = (u.pn & pn_mask) * BM + wc * 32 + 4 * fq;
#pragma unroll
        for (int ai = 0; ai < 2; ++ai)
#pragma unroll
            for (int m = 0; m < 4; ++m) { float* rowp = C + (size_t)(row0 + ai * HALF + m * 16) * ldc + col0;
#pragma unroll
                for (int bj = 0; bj < 2; ++bj)
#pragma unroll
                    for (int n = 0; n < 2; ++n) *(f32x4*)(rowp + bj * HALF + n * 16) = acc[ai][bj][m][n]; }
    }
};
struct EpiGLU {
    static constexpr bool PERM = true, AFTER_DRAIN = false;
    f16* C; const f16* Y; const float* bias;
    __device__ __forceinline__ void operator()(const f32x4 (&acc)[2][2][4][2], const Unit& u, int wr, int wc, int fr, int fq) const {
        const int row0 = u.pm * BM + wr * 64 + fr, col0 = u.pn * BM + wc * 32 + 8 * fq;
        const WtBuf wb = wt_make(C, (unsigned)MP * DM * 2);
        f32x4 bv[2][2];
#pragma unroll
        for (int bj = 0; bj < 2; ++bj)
#pragma unroll
            for (int n = 0; n < 2; ++n) bv[bj][n] = *(const f32x4*)(bias + col0 + bj * HALF + 4 * n);
#pragma unroll
        for (int ai = 0; ai < 2; ++ai)
#pragma unroll
            for (int m = 0; m < 4; ++m) { const size_t off = (size_t)(row0 + ai * HALF + m * 16) * DM + col0;
#pragma unroll
                for (int bj = 0; bj < 2; ++bj) { const f16x8 y = *(const f16x8*)(Y + off + bj * HALF); const f32x4 v0 = acc[ai][bj][m][0] + bv[bj][0], v1 = acc[ai][bj][m][1] + bv[bj][1]; f16x8 o;
#pragma unroll
                    for (int i = 0; i < 4; ++i) { o[i] = (f16)((float)y[i] * sigmoidf_(v0[i])); o[4 + i] = (f16)((float)y[4 + i] * sigmoidf_(v1[i])); }
                    wt_st16(wb, (unsigned)((off + bj * HALF) * 2), o); } }
    }
};
struct EpiF16 {
    static constexpr bool PERM = true, AFTER_DRAIN = false;
    f16* O; int ldc; int pn_mask;
    __device__ __forceinline__ void operator()(const f32x4 (&acc)[2][2][4][2], const Unit& u, int wr, int wc, int fr, int fq) const {
        const int row0 = u.pm * BM + wr * 64 + fr, col0 = (u.pn & pn_mask) * BM + wc * 32 + 8 * fq;
        const WtBuf wb = wt_make(O, 0x7ffffff0u);
#pragma unroll
        for (int ai = 0; ai < 2; ++ai)
#pragma unroll
            for (int m = 0; m < 4; ++m) { const unsigned rowb = (unsigned)(((size_t)(row0 + ai * HALF + m * 16) * ldc + col0) * 2);
#pragma unroll
                for (int bj = 0; bj < 2; ++bj) { const f32x4 v0 = acc[ai][bj][m][0], v1 = acc[ai][bj][m][1]; f16x8 w;
#pragma unroll
                    for (int i = 0; i < 4; ++i) { w[i] = (f16)v0[i]; w[4 + i] = (f16)v1[i]; }
                    wt_st16(wb, rowb + bj * HALF * 2, w); } }
    }
};
struct EpiRelu2 {
    static constexpr bool PERM = true, AFTER_DRAIN = false;
    f16* O; int ldc;
    __device__ __forceinline__ void operator()(const f32x4 (&acc)[2][2][4][2], const Unit& u, int wr, int wc, int fr, int fq) const {
        const int row0 = u.pm * BM + wr * 64 + fr, col0 = u.pn * BM + wc * 32 + 8 * fq;
        const WtBuf wb = wt_make(O, 0x7ffffff0u);
#pragma unroll
        for (int ai = 0; ai < 2; ++ai)
#pragma unroll
            for (int m = 0; m < 4; ++m) { const unsigned rowb = (unsigned)(((size_t)(row0 + ai * HALF + m * 16) * ldc + col0) * 2);
#pragma unroll
                for (int bj = 0; bj < 2; ++bj) { const f32x4 v0 = acc[ai][bj][m][0], v1 = acc[ai][bj][m][1]; f16x8 w;
#pragma unroll
                    for (int i = 0; i < 4; ++i) { const float a = fmaxf(v0[i], 0.f), b = fmaxf(v1[i], 0.f); w[i] = (f16)(a * a); w[4 + i] = (f16)(b * b); }
                    wt_st16(wb, rowb + bj * HALF * 2, w); } }
    }
};
struct EpiProj {
    static constexpr bool PERM = false, AFTER_DRAIN = false;
    int nkv; float* out; f16 *RC, *KS, *VST, *KW, *VWT, *QN, *QR; float* GATES; const float* rope;
    __device__ __forceinline__ void operator()(const f32x4 (&acc)[2][2][4][2], const Unit& u, int wr, int wc, int fr, int fq) const {
        const int row0 = u.pm * BM + wr * 64 + fr, d0 = wc * 32 + 4 * fq, d1 = d0 + 16;
#pragma unroll
        for (int bj = 0; bj < 2; ++bj) {
            if (u.pn < nkv) {
                const int hh = 2 * u.pn + bj, br = hh >> 3, kv = (hh >> 2) & 1, g = hh & 3, cbase = kv * 512 + g * 128;
                const bool rot = (br >= 1) && (kv == 0) && (wc == 0);
#pragma unroll
                for (int ai = 0; ai < 2; ++ai)
#pragma unroll
                    for (int m = 0; m < 4; ++m) {
                        const int row = row0 + ai * HALF + m * 16, b = row >> 12, t = row & 4095;
                        f32x4 v0 = acc[ai][bj][m][0], v1 = acc[ai][bj][m][1];
                        if (rot) { const f32x4 cs = *(const f32x4*)(rope + (size_t)t * 32 + 4 * fq), sn = *(const f32x4*)(rope + (size_t)t * 32 + 16 + 4 * fq);
                            const f32x4 n0 = v0 * cs - v1 * sn, n1 = v1 * cs + v0 * sn; v0 = n0; v1 = n1; }
                        const f16x4 h0 = cvt4(v0), h1 = cvt4(v1);
                        if (br == 0) {
                            float* o = out + O_CMPP + (size_t)row * 1024 + cbase; *(f32x4*)(o + d0) = v0; *(f32x4*)(o + d1) = v1;
                            f16* r = RC + ((size_t)(((kv * 2 + b) * 4 + g) * 4096 + t)) * 128; *(f16x4*)(r + d0) = h0; *(f16x4*)(r + d1) = h1;
                        } else {
                            if (br == 1) { float* o = out + O_SLCP + (size_t)row * 1024 + cbase; *(f32x4*)(o + d0) = v0; *(f32x4*)(o + d1) = v1; }
                            else if (t >= SEQ - 512) { float* o = out + O_SWAP + ((size_t)(b * 512 + t - (SEQ - 512))) * 1024 + cbase; *(f32x4*)(o + d0) = v0; *(f32x4*)(o + d1) = v1; }
                            if (kv == 0) { f16* r = (br == 1 ? KS : KW) + ((size_t)((b * 4 + g) * 4096 + t)) * 128; *(f16x4*)(r + d0) = h0; *(f16x4*)(r + d1) = h1; }
                            else { const int tp = (t & 48) | ((t & 4) << 1) | ((t & 8) >> 1) | (t & 3);
                                f16* r = (br == 1 ? VST : VWT) + ((size_t)((b * 4 + g) * 64 + (t >> 6))) * 8192 + tp;
#pragma unroll
                                for (int i = 0; i < 4; ++i) { r[(d0 + i) * 64] = h0[i]; r[(d1 + i) * 64] = h1[i]; } }
                        }
                    }
            } else {
                const int c0 = (u.pn - nkv) * 256 + bj * 128;
                if (c0 < 2048) {
#pragma unroll
                    for (int ai = 0; ai < 2; ++ai)
#pragma unroll
                        for (int m = 0; m < 4; ++m) {
                            const int row = row0 + ai * HALF + m * 16, t = row & 4095;
                            f32x4 v0 = acc[ai][bj][m][0] * (QSCALE * LOG2E), v1 = acc[ai][bj][m][1] * (QSCALE * LOG2E);
                            f16* qn = QN + (size_t)row * DM + c0; *(f16x4*)(qn + d0) = cvt4(v0); *(f16x4*)(qn + d1) = cvt4(v1);
                            if (wc == 0) { const f32x4 cs = *(const f32x4*)(rope + (size_t)t * 32 + 4 * fq), sn = *(const f32x4*)(rope + (size_t)t * 32 + 16 + 4 * fq);
                                const f32x4 n0 = v0 * cs - v1 * sn, n1 = v1 * cs + v0 * sn;
                                f16* qr = QR + (size_t)row * 512 + (c0 >> 7) * 32; *(f16x4*)(qr + d0) = cvt4(n0); *(f16x4*)(qr + d1) = cvt4(n1); }
                        }
                } else if (c0 == 2048) {
#pragma unroll
                    for (int ai = 0; ai < 2; ++ai)
#pragma unroll
                        for (int m = 0; m < 4; ++m) {
                            const int row = row0 + ai * HALF + m * 16;
#pragma unroll
                            for (int n = 0; n < 2; ++n) { const int lc = wc * 32 + 16 * n + 4 * fq;
                                if (lc < 48) { const f32x4 v = acc[ai][bj][m][n]; f32x4 o;
#pragma unroll
                                    for (int i = 0; i < 4; ++i) o[i] = sigmoidf_(v[i]);
                                    *(f32x4*)(GATES + (size_t)row * 48 + lc) = o; } }
                        }
                }
            }
        }
    }
};
struct CmpOrder {
    int G, c, nunits;
    __device__ __forceinline__ bool next(int i, Unit& u) const {
        if (i > 0 && G > 65536) return false;
        const int idx = i * G + c; if (idx >= nunits) return false;
        const int pm = idx >> 1, kv = pm < 16 ? (pm >> 3) : ((pm - 16) >> 7);
        u.pm = pm; u.pn = (idx & 1) + 2 * kv; return true;
    }
    __device__ __forceinline__ void a_ready(const Unit&) const {}
    __device__ __forceinline__ void done(const Unit&) const {}
};

template <class Epi, class Sched, bool ALIGN_EPI = false, bool SP2 = false>
__device__ __forceinline__ void gemm_phase(PG8_LAS unsigned char* lds, const Gemm g, const Sched& S, const Epi& E) {
    const int tid = threadIdx.x, wid = __builtin_amdgcn_readfirstlane(tid >> 6), lane = tid & 63, wr = wid >> 2, wc = wid & 3, fr = lane & 15, fq = lane >> 4;
    const int K = g.K, nt = K / BK;
    unsigned voffA[2], voffB[2];
#pragma unroll
    for (int i = 0; i < 2; ++i) { int R, C; stage_rc(tid * 16 + i * 8192, R, C); const int Rb = Epi::PERM ? ((R & ~31) + perm32(R & 31)) : R;
        voffA[i] = (unsigned)(R * K + C) * 2u; voffB[i] = (unsigned)(Rb * K + C) * 2u; }
    const size_t kstep = (size_t)(BK * 2);
    const size_t hstep = (size_t)HALF * K * 2;
    const size_t tstep = 2 * hstep;
    const unsigned ldsw = (unsigned)wid * 1024u;
    const int aoff = lds_byte(wr * 64 + fr, fq * 8), boff = lds_byte(wc * 32 + fr, fq * 8);
#define PG8_SA(b, h) (((b) * 2 + (h)) * HTB)
#define PG8_SB(b, h) ((4 + (b) * 2 + (h)) * HTB)
#ifndef PG8_AUX
#define PG8_AUX 0
#endif
#define PG8_STAGE(bufoff, gbase, voff) do { _Pragma("unroll") for (int _i = 0; _i < 2; ++_i) \
        __builtin_amdgcn_global_load_lds((const unsigned*)((const char*)(gbase) + (voff)[_i]), (PG8_LAS unsigned*)(lds + (bufoff) + ldsw + _i * 8192), 16, 0, PG8_AUX); } while (0)
#define PG8_LDA(dst, b, h) do { _Pragma("unroll") for (int m = 0; m < 4; ++m) _Pragma("unroll") for (int k = 0; k < 2; ++k) dst[m][k] = *(const PG8_LAS bf16x8*)(lds + PG8_SA(b, h) + aoff + m * 2048 + k * 1024); } while (0)
#define PG8_LDB(dst, b, h) do { _Pragma("unroll") for (int n = 0; n < 2; ++n) _Pragma("unroll") for (int k = 0; k < 2; ++k) dst[n][k] = *(const PG8_LAS bf16x8*)(lds + PG8_SB(b, h) + boff + n * 2048 + k * 1024); } while (0)
#define PG8_MMA(ai, bj, At, Bt) do { __builtin_amdgcn_s_setprio(1); _Pragma("unroll") for (int m = 0; m < 4; ++m) _Pragma("unroll") for (int n = 0; n < 2; ++n) _Pragma("unroll") for (int k = 0; k < 2; ++k) \
        acc[ai][bj][m][n] = __builtin_amdgcn_mfma_f32_16x16x32_f16(Bt[n][k], At[m][k], acc[ai][bj][m][n], 0, 0, 0); __builtin_amdgcn_s_setprio(0); } while (0)
#define PG8_WAIT_V(n) asm volatile("s_waitcnt vmcnt(" #n ")" ::: "memory")
#define PG8_WAIT_L(n) asm volatile("s_waitcnt lgkmcnt(" #n ")" ::: "memory")
#define PG8_BAR __builtin_amdgcn_s_barrier()
#define PG8_SCHED __builtin_amdgcn_sched_barrier(0)
    Unit cur, nxt; int ui = 0;
    if (!S.next(0, cur)) return;
    f32x4 acc[2][2][4][2];
#pragma unroll
    for (int a = 0; a < 2; ++a)
#pragma unroll
        for (int b = 0; b < 2; ++b)
#pragma unroll
            for (int m = 0; m < 4; ++m)
#pragma unroll
                for (int n = 0; n < 2; ++n) acc[a][b][m][n] = (f32x4){0.f, 0.f, 0.f, 0.f};
    bf16x8 At[4][2], B0[2][2], B1[2][2];
    const char* cA = (const char*)g.A + (size_t)cur.pm * tstep; const char* cB = (const char*)g.Bt + (size_t)cur.pn * tstep;
    S.a_ready(cur);
    if constexpr (SP2) {
        PG8_STAGE(PG8_SB(0, 0), cB, voffB); PG8_STAGE(PG8_SB(0, 1), cB + hstep, voffB); PG8_STAGE(PG8_SA(0, 0), cA, voffA); PG8_STAGE(PG8_SA(0, 1), cA + hstep, voffA);
        if (wr == 1) PG8_BAR;
        PG8_WAIT_V(2); PG8_BAR;
        PG8_STAGE(PG8_SB(1, 0), cB + kstep, voffB); PG8_STAGE(PG8_SA(1, 0), cA + kstep, voffA); PG8_STAGE(PG8_SB(1, 1), cB + hstep + kstep, voffB);
        PG8_WAIT_V(6); PG8_BAR;
    } else {
        PG8_STAGE(PG8_SB(0, 0), cB, voffB); PG8_STAGE(PG8_SA(0, 0), cA, voffA); PG8_STAGE(PG8_SB(0, 1), cB + hstep, voffB); PG8_STAGE(PG8_SA(0, 1), cA + hstep, voffA);
        if (wr == 1) PG8_BAR;
        PG8_WAIT_V(4); PG8_BAR;
        PG8_STAGE(PG8_SB(1, 0), cB + kstep, voffB); PG8_STAGE(PG8_SA(1, 0), cA + kstep, voffA); PG8_STAGE(PG8_SB(1, 1), cB + hstep + kstep, voffB);
        PG8_WAIT_V(6); PG8_BAR;
    }
    for (;;) {
        const bool has_next = S.next(ui + 1, nxt);
        const char* nA = has_next ? (const char*)g.A + (size_t)nxt.pm * tstep : cA; const char* nB = has_next ? (const char*)g.Bt + (size_t)nxt.pn * tstep : cB;
        for (int t = 0; t < nt; t += 2) {
            const bool last = (t == nt - 2);
            const char* a1 = cA + (size_t)(t + 1) * kstep;
            const char* a2 = last ? nA : cA + (size_t)(t + 2) * kstep; const char* b2 = last ? nB : cB + (size_t)(t + 2) * kstep;
            const char* a3 = a2 + kstep; const char* b3 = b2 + kstep;
            if (last && has_next) S.a_ready(nxt);
            if constexpr (SP2) {
            PG8_LDB(B0, 0, 0); PG8_LDB(B1, 0, 1); PG8_SCHED; PG8_LDA(At, 0, 0); PG8_STAGE(PG8_SA(1, 1), a1 + hstep, voffA);
            PG8_WAIT_V(8); PG8_WAIT_L(0); PG8_BAR; PG8_MMA(0, 0, At, B0); PG8_MMA(0, 1, At, B1); PG8_BAR; PG8_SCHED;
            PG8_LDA(At, 0, 1); PG8_STAGE(PG8_SB(0, 0), b2, voffB); PG8_STAGE(PG8_SB(0, 1), b2 + hstep, voffB); PG8_STAGE(PG8_SA(0, 0), a2, voffA);
            PG8_WAIT_V(8); PG8_WAIT_L(0); PG8_BAR; PG8_MMA(1, 0, At, B0); PG8_MMA(1, 1, At, B1); PG8_BAR; PG8_SCHED;
            PG8_LDB(B0, 1, 0); PG8_LDB(B1, 1, 1); PG8_SCHED; PG8_LDA(At, 1, 0); PG8_STAGE(PG8_SA(0, 1), a2 + hstep, voffA);
            PG8_WAIT_V(8); PG8_WAIT_L(0); PG8_BAR; PG8_MMA(0, 0, At, B0); PG8_MMA(0, 1, At, B1); PG8_BAR; PG8_SCHED;
            PG8_LDA(At, 1, 1); PG8_STAGE(PG8_SB(1, 0), b3, voffB); PG8_STAGE(PG8_SB(1, 1), b3 + hstep, voffB); PG8_STAGE(PG8_SA(1, 0), a3, voffA);
            PG8_WAIT_V(8); PG8_WAIT_L(0); PG8_BAR; PG8_MMA(1, 0, At, B0); PG8_MMA(1, 1, At, B1); PG8_BAR; PG8_SCHED;
            } else {
            PG8_LDB(B0, 0, 0); PG8_SCHED; PG8_LDA(At, 0, 0); PG8_STAGE(PG8_SA(1, 1), a1 + hstep, voffA);
            PG8_WAIT_L(8); PG8_BAR; PG8_WAIT_L(0); PG8_MMA(0, 0, At, B0); PG8_BAR; PG8_SCHED;
            PG8_LDB(B1, 0, 1); PG8_STAGE(PG8_SB(0, 0), b2, voffB);
            PG8_BAR; PG8_WAIT_L(0); PG8_MMA(0, 1, At, B1); PG8_BAR;
            PG8_LDA(At, 0, 1); PG8_STAGE(PG8_SA(0, 0), a2, voffA);
            PG8_BAR; PG8_WAIT_L(0); PG8_MMA(1, 0, At, B0); PG8_BAR; PG8_SCHED;
            PG8_STAGE(PG8_SB(0, 1), b2 + hstep, voffB);
            PG8_WAIT_V(6); PG8_BAR; PG8_MMA(1, 1, At, B1); PG8_BAR;
            PG8_LDB(B0, 1, 0); PG8_SCHED; PG8_LDA(At, 1, 0); PG8_STAGE(PG8_SA(0, 1), a2 + hstep, voffA);
            PG8_WAIT_L(8); PG8_BAR; PG8_WAIT_L(0); PG8_MMA(0, 0, At, B0); PG8_BAR; PG8_SCHED;
            PG8_LDB(B1, 1, 1); PG8_STAGE(PG8_SB(1, 0), b3, voffB);
            PG8_BAR; PG8_WAIT_L(0); PG8_MMA(0, 1, At, B1); PG8_BAR;
            PG8_LDA(At, 1, 1); PG8_STAGE(PG8_SA(1, 0), a3, voffA);
            PG8_BAR; PG8_WAIT_L(0); PG8_MMA(1, 0, At, B0); PG8_BAR; PG8_SCHED;
            PG8_STAGE(PG8_SB(1, 1), b3 + hstep, voffB);
            PG8_WAIT_V(6); PG8_BAR; PG8_MMA(1, 1, At, B1); PG8_BAR;
            }
        }
        if constexpr (ALIGN_EPI) { if (wr == 0) PG8_BAR; }
        if constexpr (!Epi::AFTER_DRAIN) { E(acc, cur, wr, wc, fr, fq); S.done(cur); }
        if (!has_next) break;
#pragma unroll
        for (int a = 0; a < 2; ++a)
#pragma unroll
            for (int b = 0; b < 2; ++b)
#pragma unroll
                for (int m = 0; m < 4; ++m)
#pragma unroll
                    for (int n = 0; n < 2; ++n) acc[a][b][m][n] = (f32x4){0.f, 0.f, 0.f, 0.f};
        cur = nxt; cA = nA; cB = nB; ++ui;
        if constexpr (ALIGN_EPI) { if (wr == 1) PG8_BAR; }
    }
    PG8_WAIT_V(0);
    if constexpr (!ALIGN_EPI) { if (wr == 0) PG8_BAR; }
    PG8_BAR;
    if constexpr (Epi::AFTER_DRAIN) { E.fused(acc, cur, wr, wc, fr, fq, lds, wid, lane); S.done(cur); }
#undef PG8_SA
#undef PG8_SB
#undef PG8_STAGE
#undef PG8_LDA
#undef PG8_LDB
#undef PG8_MMA
#undef PG8_WAIT_V
#undef PG8_WAIT_L
#undef PG8_BAR
#undef PG8_SCHED
}
}
struct TDesc { const float* W; f16* WT; const float* gain; int K, N, Npad, row_off, item; };
__device__ __forceinline__ void t_load(const TDesc& d, f32x4 (&v)[16], int lane) {
    const int nblk = d.Npad / 64, kb = d.item / nblk, nb = d.item % nblk, k0 = 64 * kb, n0 = 64 * nb;
    const int c4 = lane & 15, kr = lane >> 4, n = n0 + 4 * c4;
#pragma unroll
    for (int i = 0; i < 16; ++i) v[i] = (n < d.N) ? *(const f32x4*)(d.W + (size_t)(k0 + 4 * i + kr) * d.N + n) : (f32x4){0.f, 0.f, 0.f, 0.f};
}
__device__ __forceinline__ void t_process(const TDesc& d, f32x4 (&v)[16], LAS float* scr, int lane) {
    const int nblk = d.Npad / 64, kb = d.item / nblk, nb = d.item % nblk, k0 = 64 * kb, n0 = 64 * nb;
    const int c4 = lane & 15, kr = lane >> 4;
    if (d.gain) {
#pragma unroll
        for (int i = 0; i < 16; ++i) v[i] = v[i] * d.gain[k0 + 4 * i + kr];
    }
#pragma unroll
    for (int i = 0; i < 16; ++i) { LAS float* q = scr + (4 * i + kr) * 65 + 4 * c4; q[0] = v[i][0]; q[1] = v[i][1]; q[2] = v[i][2]; q[3] = v[i][3]; }
    LDS_WAIT();
#pragma unroll
    for (int j = 0; j < 8; ++j) { const int pr = lane + 64 * j, c = pr & 7, nn = pr >> 3; const LAS float* s = scr + (8 * c) * 65 + nn; f16x8 o;
#pragma unroll
        for (int e = 0; e < 8; ++e) o[e] = (f16)s[e * 65];
        *(f16x8*)(d.WT + (size_t)(d.row_off + n0 + nn) * d.K + k0 + 8 * c) = o; }
    LDS_WAIT();
}
__device__ __forceinline__ void sincos_d(double x, double& s, double& c) {
    const double twopi = 6.283185307179586476925287, inv = 0.15915494309189533576888;
    const double k = rint(x * inv); double r = fma(-k, twopi, x); r = fma(-k, -2.4492935982947064e-16, r);
    const double r2 = r * r; double ts = 1.0, tc = 1.0;
#pragma unroll
    for (int i = 27; i >= 3; i -= 2) ts = 1.0 - ts * r2 / (double)(i * (i - 1));
#pragma unroll
    for (int i = 26; i >= 2; i -= 2) tc = 1.0 - tc * r2 / (double)(i * (i - 1));
    s = r * ts; c = tc;
}
__device__ __forceinline__ void resnorm_row(const float* y, const float* gpost, const float* xin, float* xout, int mode, const float* gnext, f16* o16, float* o32, int row, int lane_in) {
    int lane = lane_in; asm volatile("" : "+v"(lane));
    f32x4 v[8];
    const f32x4* xr = (const f32x4*)(xin + (size_t)row * DM) + lane;
#pragma unroll
    for (int j = 0; j < 8; ++j) v[j] = xr[64 * j];
    if (y) {
        const f32x4* yr = (const f32x4*)(y + (size_t)row * DM) + lane; f32x4 w[8]; float s = 0.f;
#pragma unroll
        for (int j = 0; j < 8; ++j) { w[j] = yr[64 * j]; s += (w[j][0] * w[j][0] + w[j][1] * w[j][1]) + (w[j][2] * w[j][2] + w[j][3] * w[j][3]); }
        const float r1 = 1.0f / sqrtf(wave_sum(s) * (1.0f / DM) + EPS);
#pragma unroll
        for (int j = 0; j < 8; ++j) { const f32x4 gp = *((const f32x4*)gpost + lane + 64 * j); v[j] = v[j] + w[j] * r1 * gp; }
    }
    if (xout) { f32x4* xo = (f32x4*)(xout + (size_t)row * DM) + lane;
#pragma unroll
        for (int j = 0; j < 8; ++j) xo[64 * j] = v[j]; }
    if (mode == 0) return;
    float s2 = 0.f;
#pragma unroll
    for (int j = 0; j < 8; ++j) s2 += (v[j][0] * v[j][0] + v[j][1] * v[j][1]) + (v[j][2] * v[j][2] + v[j][3] * v[j][3]);
    const float r2 = 1.0f / sqrtf(wave_sum(s2) * (1.0f / DM) + EPS);
    if (mode == 1) {
#pragma unroll
        for (int j = 0; j < 8; ++j) *((f16x4*)(o16 + (size_t)row * DM) + lane + 64 * j) = cvt4(v[j] * r2);
    } else if (mode == 2) {
        const int b = row >> 12, t = row & 4095;
#pragma unroll
        for (int j = 0; j < 8; ++j) { const int col = 4 * lane + 256 * j; const f32x4 gn = *((const f32x4*)gnext + lane + 64 * j);
            *(f16x4*)(o16 + ((size_t)((b * NG + (col >> 4)) * SEQ + t)) * 16 + (col & 15)) = cvt4(v[j] * r2 * gn); }
    } else {
#pragma unroll
        for (int j = 0; j < 8; ++j) { const f32x4 gn = *((const f32x4*)gnext + lane + 64 * j); *((f32x4*)(o32 + (size_t)row * DM) + lane + 64 * j) = v[j] * r2 * gn; }
    }
}

__device__ __forceinline__ void resnorm_rows(const f16* y, const float* gpost, const float* xin, float* xout, int mode, const float* gnext, f16* o16, int first, int stride, int nrows, int lane_in) {
    int lane = lane_in; asm volatile("" : "+v"(lane));
    if (first >= nrows) return;
    f32x4 xv[8], yv[8], xn[8]; f16x4 yn[8];
    { const f32x4* xr = (const f32x4*)(xin + (size_t)first * DM) + lane; const f16x4* yr = (const f16x4*)(y + (size_t)first * DM) + lane;
#pragma unroll
      for (int j = 0; j < 8; ++j) { xn[j] = xr[64 * j]; yn[j] = yr[64 * j]; } }
    for (int row = first; row < nrows; row += stride) {
#pragma unroll
        for (int j = 0; j < 8; ++j) { xv[j] = xn[j]; yv[j] = (f32x4){(float)yn[j][0], (float)yn[j][1], (float)yn[j][2], (float)yn[j][3]}; }
        if (row + stride < nrows) { const f32x4* xr = (const f32x4*)(xin + (size_t)(row + stride) * DM) + lane; const f16x4* yr = (const f16x4*)(y + (size_t)(row + stride) * DM) + lane;
#pragma unroll
            for (int j = 0; j < 8; ++j) { xn[j] = xr[64 * j]; yn[j] = yr[64 * j]; } }
        float s = 0.f;
#pragma unroll
        for (int j = 0; j < 8; ++j) s += (yv[j][0] * yv[j][0] + yv[j][1] * yv[j][1]) + (yv[j][2] * yv[j][2] + yv[j][3] * yv[j][3]);
        const float r1 = 1.0f / sqrtf(wave_sum(s) * (1.0f / DM) + EPS);
#pragma unroll
        for (int j = 0; j < 8; ++j) { const f32x4 gp = *((const f32x4*)gpost + lane + 64 * j); xv[j] = xv[j] + yv[j] * r1 * gp; }
        f32x4* xo = (f32x4*)(xout + (size_t)row * DM) + lane;
#pragma unroll
        for (int j = 0; j < 8; ++j) xo[64 * j] = xv[j];
        if (mode == 0) continue;
        float s2 = 0.f;
#pragma unroll
        for (int j = 0; j < 8; ++j) s2 += (xv[j][0] * xv[j][0] + xv[j][1] * xv[j][1]) + (xv[j][2] * xv[j][2] + xv[j][3] * xv[j][3]);
        const float r2 = 1.0f / sqrtf(wave_sum(s2) * (1.0f / DM) + EPS);
        if (mode == 1) {
#pragma unroll
            for (int j = 0; j < 8; ++j) *((f16x4*)(o16 + (size_t)row * DM) + lane + 64 * j) = cvt4(xv[j] * r2);
        } else {
            const int b = row >> 12, t = row & 4095;
#pragma unroll
            for (int j = 0; j < 8; ++j) { const int col = 4 * lane + 256 * j; const f32x4 gn = *((const f32x4*)gnext + lane + 64 * j);
                *(f16x4*)(o16 + ((size_t)((b * NG + (col >> 4)) * SEQ + t)) * 16 + (col & 15)) = cvt4(xv[j] * r2 * gn); }
        }
    }
}

template <bool SRC_F32, int OUT>
__device__ __forceinline__ void resnorm2_rows(const f16* y, const float* gpost, const float* xin32, f16* XN, float* RS, float* out32, const float* gnext, f16* XG, int first, int stride, int nrows, int lane_in) {
    int lane = lane_in; asm volatile("" : "+v"(lane));
    if (first >= nrows) return;
    f32x4 xv[8], yv[8], xn32[8]; f16x4 xn16[8], yn[8]; float sn = 1.f;
    {   const f16x4* yr = (const f16x4*)(y + (size_t)first * DM) + lane;
#pragma unroll
        for (int j = 0; j < 8; ++j) yn[j] = yr[64 * j];
        if (SRC_F32) { const f32x4* xr = (const f32x4*)(xin32 + (size_t)first * DM) + lane;
#pragma unroll
            for (int j = 0; j < 8; ++j) xn32[j] = xr[64 * j]; }
        else { const f16x4* xr = (const f16x4*)(XN + (size_t)first * DM) + lane; sn = RS[first];
#pragma unroll
            for (int j = 0; j < 8; ++j) xn16[j] = xr[64 * j]; } }
    for (int row = first; row < nrows; row += stride) {
#pragma unroll
        for (int j = 0; j < 8; ++j) { yv[j] = (f32x4){(float)yn[j][0], (float)yn[j][1], (float)yn[j][2], (float)yn[j][3]};
            if (SRC_F32) xv[j] = xn32[j]; else xv[j] = (f32x4){(float)xn16[j][0], (float)xn16[j][1], (float)xn16[j][2], (float)xn16[j][3]} * sn; }
        if (row + stride < nrows) { const int nr = row + stride; const f16x4* yr = (const f16x4*)(y + (size_t)nr * DM) + lane;
#pragma unroll
            for (int j = 0; j < 8; ++j) yn[j] = yr[64 * j];
            if (SRC_F32) { const f32x4* xr = (const f32x4*)(xin32 + (size_t)nr * DM) + lane;
#pragma unroll
                for (int j = 0; j < 8; ++j) xn32[j] = xr[64 * j]; }
            else { const f16x4* xr = (const f16x4*)(XN + (size_t)nr * DM) + lane; sn = RS[nr];
#pragma unroll
                for (int j = 0; j < 8; ++j) xn16[j] = xr[64 * j]; } }
        float s = 0.f;
#pragma unroll
        for (int j = 0; j < 8; ++j) s += (yv[j][0] * yv[j][0] + yv[j][1] * yv[j][1]) + (yv[j][2] * yv[j][2] + yv[j][3] * yv[j][3]);
        const float r1 = 1.0f / sqrtf(wave_sum(s) * (1.0f / DM) + EPS);
#pragma unroll
        for (int j = 0; j < 8; ++j) { const f32x4 gp = *((const f32x4*)gpost + lane + 64 * j); xv[j] = xv[j] + yv[j] * r1 * gp; }
        if (OUT == 0) { f32x4* xo = (f32x4*)(out32 + (size_t)row * DM) + lane;
#pragma unroll
            for (int j = 0; j < 8; ++j) xo[64 * j] = xv[j];
            continue; }
        float s2 = 0.f;
#pragma unroll
        for (int j = 0; j < 8; ++j) s2 += (xv[j][0] * xv[j][0] + xv[j][1] * xv[j][1]) + (xv[j][2] * xv[j][2] + xv[j][3] * xv[j][3]);
        const float ms = wave_sum(s2) * (1.0f / DM) + EPS, r2 = 1.0f / sqrtf(ms);
#pragma unroll
        for (int j = 0; j < 8; ++j) *((f16x4*)(XN + (size_t)row * DM) + lane + 64 * j) = cvt4(xv[j] * r2);
        if (lane == 0) RS[row] = sqrtf(ms);
        if (OUT == 2) {
            const int b = row >> 12, t = row & 4095;
#pragma unroll
            for (int j = 0; j < 8; ++j) { const int col = 4 * lane + 256 * j; const f32x4 gn = *((const f32x4*)gnext + lane + 64 * j);
                *(f16x4*)(XG + ((size_t)((b * NG + (col >> 4)) * SEQ + t)) * 16 + (col & 15)) = cvt4(xv[j] * r2 * gn); }
        }
    }
}
__device__ __forceinline__ void ph_prologue(const Params& p, LAS unsigned char* lds, int vcu, int G, int tid_in) {
    int tid = tid_in; asm volatile("" : "+v"(tid));
    const int lane = tid & 63, wave = __builtin_amdgcn_readfirstlane(tid >> 6), gw = vcu * 8 + wave, NGW = G * 8;
    unsigned char* ws = p.ws;
    LAS float* scr = (LAS float*)(lds + wave * 16640);
    {
        constexpr int I_GLU = 32 * 32, I_UP = 32 * 128, I_DN = 128 * 32, I_KV = 32 * 48, I_QG = 32 * 36, I_WO = 32 * 32, I_C1 = 32 * 4, I_C2 = 4 * 2;
        constexpr int NIT = 2 * I_GLU + 4 * I_UP + 4 * I_DN + I_KV + 2 * I_QG + 2 * I_WO + 4 * I_C1 + 2 * I_C2;
        auto desc = [&](int it) -> TDesc {
            int r = it;
            if (r < 2 * I_GLU) { const int l = r / I_GLU; return TDesc{p.in[17] + (size_t)l * DM * DM, (f16*)(ws + WS_WGLU) + (size_t)l * DM * DM, nullptr, DM, DM, DM, 0, r % I_GLU}; } r -= 2 * I_GLU;
            if (r < 4 * I_UP) { const int l = r / I_UP; return TDesc{p.in[33] + (size_t)l * DM * FF, (f16*)(ws + WS_WUP) + (size_t)l * DM * FF, p.in[32] + l * DM, DM, FF, FF, 0, r % I_UP}; } r -= 4 * I_UP;
            if (r < 4 * I_DN) { const int l = r / I_DN; return TDesc{p.in[34] + (size_t)l * DM * FF, (f16*)(ws + WS_WDN) + (size_t)l * DM * FF, nullptr, FF, DM, DM, 0, r % I_DN}; } r -= 4 * I_DN;
            if (r < I_KV) return TDesc{p.in[21], (f16*)(ws + WS_WKVQG), p.in[20], DM, NKV, NKV, 0, r}; r -= I_KV;
            if (r < I_QG) return TDesc{p.in[29], (f16*)(ws + WS_WKVQG), p.in[28], DM, NQG, NQGP, NKV, r}; r -= I_QG;
            if (r < I_QG) return TDesc{p.in[29] + (size_t)DM * NQG, (f16*)(ws + WS_WQG1), p.in[28] + DM, DM, NQG, NQGP, 0, r}; r -= I_QG;
            if (r < 2 * I_WO) { const int l = r / I_WO; return TDesc{p.in[30] + (size_t)l * DM * DM, (f16*)(ws + WS_WO) + (size_t)l * DM * DM, nullptr, DM, DM, DM, 0, r % I_WO}; } r -= 2 * I_WO;
            if (r < 4 * I_C1) { const int q = r / I_C1, kv = q >> 1, j = q & 1; return TDesc{p.in[kv ? 25 : 22] + (size_t)j * 2048 * 256, (f16*)(ws + WS_CW1) + (size_t)kv * 512 * 2048, nullptr, 2048, 256, 256, j * 256, r % I_C1}; } r -= 4 * I_C1;
            { const int kv = r / I_C2; return TDesc{p.in[kv ? 27 : 24], (f16*)(ws + WS_CW2) + (size_t)kv * 128 * 256, nullptr, 256, 128, 128, 0, r % I_C2}; }
        };
        int it = gw;
        if (it < NIT) {
            f32x4 va[16], vb[16];
            TDesc d0 = desc(it), d1 = d0;
            t_load(d0, va, lane);
            for (;;) {
                const int it1 = it + NGW; const bool has1 = it1 < NIT;
                if (has1) { d1 = desc(it1); t_load(d1, vb, lane); }
                t_process(d0, va, scr, lane);
                if (!has1) break;
                const int it2 = it1 + NGW; const bool has2 = it2 < NIT;
                if (has2) { d0 = desc(it2); t_load(d0, va, lane); }
                t_process(d1, vb, scr, lane);
                if (!has2) break;
                it = it2;
            }
        }
    }
    const int gt = vcu * 512 + tid, NGT = G * 512;
    if (wave == 0) {
        LAS float* sw = (LAS float*)lds;
        for (int lg = vcu; lg < 2 * NG; lg += G) {
            const int l = lg / NG, g = lg % NG, pp = lane, it = lg * NST + pp;
            const double dt = exp((double)p.in[11][lg]);
            const double lr = (double)p.in[9][it], li = (double)p.in[10][it];
            const double mag = exp(lr * dt); double sn, cs; sincos_d(li * dt, sn, cs);
            const double are = mag * cs, aim = mag * sn, den = lr * lr + li * li, nr0 = are - 1.0;
            const double fre = (nr0 * lr + aim * li) / den, fim = (aim * lr - nr0 * li) / den;
            float* AT = (float*)(ws + WS_AT); AT[2 * it] = (float)are; AT[2 * it + 1] = (float)aim;
            if (pp == 0) ((float*)(ws + WS_DT))[lg] = (float)dt;
            const float* bre = p.in[12] + (size_t)it * 16; const float* bim = p.in[13] + (size_t)it * 16;
            float* BBF = (float*)(ws + WS_BBF) + (size_t)it * 32;
            f16* BST = (f16*)(ws + WS_BST) + (size_t)lg * 128 * 16;
            const double idt = 1.0 / dt;
            float xr[16], xi[16];
#pragma unroll
            for (int i = 0; i < 16; ++i) { const double br = bre[i], bi = bim[i]; const double vr = fre * br - fim * bi, vi = fre * bi + fim * br;
                BBF[i] = (float)vr; BBF[16 + i] = (float)vi; xr[i] = (float)(vr * idt); xi[i] = (float)(vi * idt); BST[pp * 16 + i] = (f16)xr[i]; BST[(64 + pp) * 16 + i] = (f16)xi[i]; }
            sw[pp * 36] = (float)are; sw[pp * 36 + 1] = (float)aim;
#pragma unroll
            for (int i = 0; i < 16; ++i) { sw[pp * 36 + 4 + i] = xr[i]; sw[pp * 36 + 20 + i] = xi[i]; }
            const float* cre = p.in[14] + (size_t)lg * 16 * 64; const float* cim = p.in[15] + (size_t)lg * 16 * 64;
            {
              f16* MI = (f16*)(ws + WS_MI) + (size_t)lg * 128 * 256;
              double pre = 1.0, pim = 0.0;
              for (int t = 15; t >= 0; --t) {
                  const float fr_ = (float)pre, fi_ = (float)pim; f16x8 r0, r1, i0, i1;
#pragma unroll
                  for (int i = 0; i < 8; ++i) { r0[i] = (f16)(fr_ * xr[i] - fi_ * xi[i]); r1[i] = (f16)(fr_ * xr[8 + i] - fi_ * xi[8 + i]); i0[i] = (f16)(fr_ * xi[i] + fi_ * xr[i]); i1[i] = (f16)(fr_ * xi[8 + i] + fi_ * xr[8 + i]); }
                  *(f16x8*)(MI + (size_t)pp * 256 + t * 16) = r0; *(f16x8*)(MI + (size_t)pp * 256 + t * 16 + 8) = r1;
                  *(f16x8*)(MI + (size_t)(64 + pp) * 256 + t * 16) = i0; *(f16x8*)(MI + (size_t)(64 + pp) * 256 + t * 16 + 8) = i1;
                  const double nr = pre * are - pim * aim, ni = pre * aim + pim * are; pre = nr; pim = ni;
              } }
            {
              f16* W1 = (f16*)(ws + WS_W1) + (size_t)lg * 256 * 128;
              float cr[16], ci[16];
#pragma unroll
              for (int j = 0; j < 16; ++j) { cr[j] = cre[j * 64 + pp]; ci[j] = cim[j * 64 + pp]; }
              double pre = are, pim = aim;
              for (int t = 0; t < 16; ++t) {
                  const float Ar = (float)pre, Ai = (float)pim;
#pragma unroll
                  for (int j = 0; j < 16; ++j) { W1[(size_t)(t * 16 + j) * 128 + pp] = (f16)(cr[j] * Ar - ci[j] * Ai); W1[(size_t)(t * 16 + j) * 128 + 64 + pp] = (f16)(-cr[j] * Ai - ci[j] * Ar); }
                  const double nr = pre * are - pim * aim, ni = pre * aim + pim * are; pre = nr; pim = ni;
              }
              f16* CCT = (f16*)(ws + WS_CCT) + (size_t)lg * 16 * 128;
#pragma unroll
              for (int j = 0; j < 16; ++j) { CCT[j * 128 + pp] = (f16)cr[j]; CCT[j * 128 + 64 + pp] = (f16)(-ci[j]); } }
            LDS_WAIT();
            {
              const int j = lane >> 2, ib = (lane & 3) * 4;
              float acc[4][16];
#pragma unroll
              for (int e = 0; e < 4; ++e)
#pragma unroll
                  for (int tau = 0; tau < 16; ++tau) acc[e][tau] = 0.f;
              for (int p2 = 0; p2 < 64; ++p2) {
                  const float a2r = sw[p2 * 36], a2i = sw[p2 * 36 + 1], c2r = cre[j * 64 + p2], c2i = cim[j * 64 + p2];
#pragma unroll
                  for (int e = 0; e < 4; ++e) { float wr = sw[p2 * 36 + 4 + ib + e], wi = sw[p2 * 36 + 20 + ib + e];
#pragma unroll
                      for (int tau = 0; tau < 16; ++tau) { acc[e][tau] += c2r * wr - c2i * wi; const float nr = wr * a2r - wi * a2i; wi = wr * a2i + wi * a2r; wr = nr; } }
              }
              f16* KT = (f16*)(ws + WS_KT) + (size_t)lg * 4096;
#pragma unroll
              for (int tau = 0; tau < 16; ++tau) { f16x4 o; o[0] = (f16)acc[0][tau]; o[1] = (f16)acc[1][tau]; o[2] = (f16)acc[2][tau]; o[3] = (f16)acc[3][tau]; *(f16x4*)(KT + tau * 256 + j * 16 + ib) = o; } }
            LDS_WAIT();
        }
    }
    for (int it = gt; it < 4100 * 16; it += NGT) {
        const int pi = it >> 4, f = it & 15; const int pos = pi < 4096 ? pi : PAST + (pi - 4096);
        const float ang = (float)pos * p.inv_freq[f]; double sn, cs; sincos_d((double)ang, sn, cs);
        float* R = (float*)(ws + WS_ROPE) + (size_t)pi * 32; R[f] = (float)cs; R[16 + f] = (float)sn;
    }
    for (int it = gw; it < 512; it += NGW) {
        const int kv = it >> 8, h = it & 255; const float* pe = p.in[kv ? 26 : 23]; const float* w1 = p.in[kv ? 25 : 22];
        float s = 0.f;
        for (int i = lane; i < 4096; i += 64) s += pe[i] * w1[(size_t)i * 256 + h];
        s = wave_sum(s);
        if (lane == 0) ((float*)(ws + WS_PE))[it] = s;
    }
    {
        f16* RCS = (f16*)(ws + WS_RC) + RC_P_ELEMS; const int* pt = (const int*)p.in[7];
        for (int ch = gw; ch < NBS * NPAGES * 2; ch += NGW) {
            const int b = ch >> 8, pg = (ch >> 1) & 127, hf = ch & 1; const int page = pt[b * NPAGES + pg];
            const float* srcb = p.in[2] + ((size_t)page * PAGE + hf * 64) * 1024; const int pos0 = pg * PAGE + hf * 64;
            for (int r = 0; r < 64; r += 2) {
                f32x4 v[2][4];
#pragma unroll
                for (int u = 0; u < 2; ++u)
#pragma unroll
                    for (int j = 0; j < 4; ++j) v[u][j] = *((const f32x4*)(srcb + (size_t)(r + u) * 1024) + lane + 64 * j);
#pragma unroll
                for (int u = 0; u < 2; ++u)
#pragma unroll
                    for (int j = 0; j < 4; ++j) { const int e = 4 * lane + 256 * j, kv = e >> 9, g = (e >> 7) & 3, d = e & 127;
                        *(f16x4*)(RCS + ((size_t)(((kv * 8 + b) * 4 + g)) * PAST + pos0 + r + u) * 128 + d) = cvt4(v[u][j]); }
            }
        }
    }
    for (int it = gw; it < NBS * 508; it += NGW) {
        const int b = it / 508, r = it % 508;
        const f32x4* src = (const f32x4*)(p.in[4] + ((size_t)(b * 512 + r + 4)) * 1024) + lane; f32x4* dst = (f32x4*)(p.out + O_SWAS + ((size_t)(b * 512 + r)) * 1024) + lane;
#pragma unroll
        for (int j = 0; j < 4; ++j) dst[64 * j] = src[64 * j];
    }
    for (int m = gw; m < MP + MS; m += NGW) {
        if (m < MP) resnorm_row(nullptr, nullptr, p.in[0], nullptr, 2, p.in[8], (f16*)(ws + WS_A0), nullptr, m, lane);
        else resnorm_row(nullptr, nullptr, p.in[1], nullptr, 3, p.in[8], nullptr, (float*)(ws + WS_XNS), m - MP, lane);
    }
}
__device__ __forceinline__ void s5_prompt_unit(LAS unsigned char* lds, int l, int b, int g, const Params& p, int tid_in) {
    int tid = tid_in; asm volatile("" : "+v"(tid));
    const int lane = tid & 63, w = __builtin_amdgcn_readfirstlane(tid >> 6), fr = lane & 15, q = lane >> 4;
    unsigned char* ws = p.ws;
    const f16* xg = (const f16*)(ws + WS_A0) + ((size_t)(b * NG + g) * SEQ) * 16;
    const f16* BST = (const f16*)(ws + WS_BST) + (size_t)(l * NG + g) * 128 * 16;
    const f16* CCT = (const f16*)(ws + WS_CCT) + (size_t)(l * NG + g) * 16 * 128;
    const f16x8 z8 = {0, 0, 0, 0, 0, 0, 0, 0};
    f16x8 Bs[8], Cc[4];
#pragma unroll
    for (int nt = 0; nt < 8; ++nt) Bs[nt] = (q < 2) ? *(const f16x8*)(BST + (nt * 16 + fr) * 16 + 8 * q) : z8;
#pragma unroll
    for (int s = 0; s < 4; ++s) Cc[s] = *(const f16x8*)(CCT + fr * 128 + 32 * s + 8 * q);
    const float* AT = (const float*)(ws + WS_AT) + (size_t)((l * NG + g) * NST + lane) * 2;
    const float ar = AT[0], ai = AT[1];
    const float dt = ((const float*)(ws + WS_DT))[l * NG + g];
    const f32x4 dsk = *(const f32x4*)(p.in[16] + (size_t)l * DM + g * 16 + 4 * q);
    float hr = 0.f, hi = 0.f;
    const f32x4 z4 = {0.f, 0.f, 0.f, 0.f};
    float p16r = ar, p16i = ai;
#pragma unroll
    for (int i = 0; i < 4; ++i) { const float nr = p16r * p16r - p16i * p16i, ni = 2.f * p16r * p16i; p16r = nr; p16i = ni; }
    float h0r[32], h0i[32];
    {
        LAS f16* mi = (LAS f16*)(lds + 72704);
        LAS float* tb = (LAS float*)(lds + w * 8448);
        const f16* MI = (const f16*)(ws + WS_MI) + (size_t)(l * NG + g) * 128 * 256;
        for (int idx = tid; idx < 128 * 32; idx += 512) { const int r = idx >> 5, c8 = (idx & 31) * 8; *(LAS f16x8*)(mi + r * 264 + c8) = *(const f16x8*)(MI + (size_t)r * 256 + c8); }
        __syncthreads();
#pragma unroll
        for (int ct = 0; ct < 2; ++ct) {
            f32x4 accn[8];
#pragma unroll
            for (int nt = 0; nt < 8; ++nt) accn[nt] = z4;
#pragma unroll
            for (int s = 0; s < 8; ++s) {
                const int t = 2 * s + (q >> 1), i0 = 8 * (q & 1);
                const f16x8 ubc = *(const f16x8*)(xg + (size_t)(512 * w + (16 * ct + fr) * 16 + t) * 16 + i0);
#pragma unroll
                for (int nt = 0; nt < 8; ++nt) { const f16x8 am = *(const LAS f16x8*)(mi + (nt * 16 + fr) * 264 + 32 * s + 8 * q); accn[nt] = __builtin_amdgcn_mfma_f32_16x16x32_f16(am, ubc, accn[nt], 0, 0, 0); }
            }
#pragma unroll
            for (int nt = 0; nt < 8; ++nt) *(LAS f32x4*)(tb + fr * 132 + nt * 16 + 4 * q) = accn[nt];
            LDS_WAIT();
#pragma unroll
            for (int c = 0; c < 16; ++c) { h0r[16 * ct + c] = hr; h0i[16 * ct + c] = hi;
                const float br = tb[c * 132 + lane], bi = tb[c * 132 + 64 + lane]; const float nr = p16r * hr - p16i * hi + br, ni = p16r * hi + p16i * hr + bi; hr = nr; hi = ni; }
            LDS_WAIT();
        }
        __syncthreads();
    }
    LAS f16* hsb = (LAS f16*)(lds + w * 4352);
    LAS float* carry = (LAS float*)(lds + 34816);
    LAS f16* kt = (LAS f16*)(lds + 38912);
    LAS f16* w1 = (LAS f16*)(lds + 47104);
    carry[(w * 64 + lane) * 2] = hr; carry[(w * 64 + lane) * 2 + 1] = hi;
    *(LAS f16x8*)(kt + tid * 8) = *(const f16x8*)((const f16*)(ws + WS_KT) + (size_t)(l * NG + g) * 4096 + tid * 8);
    { const f16* W1g = (const f16*)(ws + WS_W1) + (size_t)(l * NG + g) * 256 * 128;
      for (int idx = tid; idx < 256 * 16; idx += 512) { const int r = idx >> 4, c8 = (idx & 15) * 8; *(LAS f16x8*)(w1 + r * 136 + c8) = *(const f16x8*)(W1g + (size_t)r * 128 + c8); } }
    __syncthreads();
    {
        float pr = ar, pi = ai;
#pragma unroll
        for (int i = 0; i < 9; ++i) { const float nr = pr * pr - pi * pi, ni = 2.f * pr * pi; pr = nr; pi = ni; }
        float zr = 0.f, zi = 0.f;
        for (int v = 0; v < w; ++v) { const float sr = carry[(v * 64 + lane) * 2], si = carry[(v * 64 + lane) * 2 + 1]; const float nr = pr * zr - pi * zi + sr, ni = pr * zi + pi * zr + si; zr = nr; zi = ni; }
#pragma unroll
        for (int c = 0; c < 32; ++c) { h0r[c] += zr; h0i[c] += zi; const float nr = p16r * zr - p16i * zi, ni = p16r * zi + p16i * zr; zr = nr; zi = ni; }
        hr += zr; hi += zi;
    }
    f16* yact = (f16*)(ws + WS_A1);
#pragma unroll
    for (int ct = 0; ct < 2; ++ct) {
        const int tok0 = 512 * w + (16 * ct + fr) * 16;
        f16x8 ubc[8];
#pragma unroll
        for (int s = 0; s < 8; ++s) ubc[s] = *(const f16x8*)(xg + (size_t)(tok0 + 2 * s + (q >> 1)) * 16 + 8 * (q & 1));
        f16x4 xnv[16];
#pragma unroll
        for (int t = 0; t < 16; ++t) xnv[t] = *(const f16x4*)(xg + (size_t)(tok0 + t) * 16 + 4 * q);
#pragma unroll
        for (int c = 0; c < 16; ++c) { hsb[c * 136 + lane] = (f16)h0r[16 * ct + c]; hsb[c * 136 + 64 + lane] = (f16)h0i[16 * ct + c]; }
        LDS_WAIT();
        f16x8 hsB[4];
#pragma unroll
        for (int s = 0; s < 4; ++s) hsB[s] = *(const LAS f16x8*)(hsb + fr * 136 + 32 * s + 8 * q);
        LDS_WAIT();
#pragma unroll
        for (int t = 0; t < 16; ++t) {
            f32x4 acc = z4;
#pragma unroll
            for (int s = 0; s < 4; ++s) { const f16x8 aw = *(const LAS f16x8*)(w1 + (t * 16 + fr) * 136 + 32 * s + 8 * q); acc = __builtin_amdgcn_mfma_f32_16x16x32_f16(aw, hsB[s], acc, 0, 0, 0); }
#pragma unroll
            for (int ks = 0; ks <= t / 2; ++ks) {
                const int tau = t - 2 * ks - (q >> 1);
                const f16x8 ak = (tau >= 0) ? *(const LAS f16x8*)(kt + (tau * 16 + fr) * 16 + 8 * (q & 1)) : z8;
                acc = __builtin_amdgcn_mfma_f32_16x16x32_f16(ak, ubc[ks], acc, 0, 0, 0);
            }
            f16x4 o;
#pragma unroll
            for (int r = 0; r < 4; ++r) o[r] = (f16)gelu_tanh(dt * acc[r] + dsk[r] * (float)xnv[t][r]);
            *(f16x4*)(yact + (size_t)(b * SEQ + tok0 + t) * DM + g * 16 + 4 * q) = o;
            __builtin_amdgcn_sched_barrier(0);
        }
    }
    if (w == 7) { const size_t o = (size_t)((l * NBP + b) * NG + g) * NST + lane; p.out[O_REP + o] = dt * hr; p.out[O_IMP + o] = dt * hi; }
    __syncthreads();
}
__device__ __forceinline__ void s5_sample_wave(int l, int b, int g, const Params& p, int lane_in) {
    int lane = lane_in; asm volatile("" : "+v"(lane));
    unsigned char* ws = p.ws;
    const size_t sidx = (size_t)((l * NBS + b) * NG + g) * NST + lane;
    float hr = p.in[5][sidx], hi = p.in[6][sidx];
    const float* AT = (const float*)(ws + WS_AT) + (size_t)((l * NG + g) * NST + lane) * 2; const float ar = AT[0], ai = AT[1];
    const float* BBF = (const float*)(ws + WS_BBF) + (size_t)((l * NG + g) * NST + lane) * 32;
    float bre[16], bim[16];
#pragma unroll
    for (int i = 0; i < 16; ++i) { bre[i] = BBF[i]; bim[i] = BBF[16 + i]; }
    const float* cre = p.in[14] + (size_t)(l * NG + g) * 16 * 64 + lane; const float* cim = p.in[15] + (size_t)(l * NG + g) * 16 * 64 + lane;
    const float dsk = (lane < 16) ? p.in[16][(size_t)l * DM + g * 16 + lane] : 0.f;
    for (int i = 0; i < LS; ++i) {
        const float* xn = (const float*)(ws + WS_XNS) + (size_t)(b * LS + i) * DM + g * 16;
        float br = 0.f, bi = 0.f;
#pragma unroll
        for (int k = 0; k < 16; ++k) { const float u = xn[k]; br += bre[k] * u; bi += bim[k] * u; }
        const float nr = ar * hr - ai * hi + br, ni = ar * hi + ai * hr + bi; hr = nr; hi = ni;
        float yv = 0.f;
#pragma unroll
        for (int j = 0; j < 16; ++j) { const float s = wave_sum(cre[j * 64] * hr - cim[j * 64] * hi); if (lane == j) yv = s; }
        if (lane < 16) { const float y = gelu_tanh(yv + dsk * xn[lane]); ((f16*)(ws + WS_AS1))[(size_t)(b * LS + i) * DM + g * 16 + lane] = (f16)y; }
    }
    p.out[O_RES + sidx] = hr; p.out[O_IMS + sidx] = hi;
}
template <int EPI>
__device__ __forceinline__ void sgemm_phase(LAS unsigned char* lds, const f16* Wt, int N, int K, const f16* act, const Params& p, int L, int nkvcols, int vcu, int G, int tid_in) {
    int tid = tid_in; asm volatile("" : "+v"(tid));
    const int lane = tid & 63, w = __builtin_amdgcn_readfirstlane(tid >> 6), c = lane & 31, h = lane >> 5;
    LAS float* red = (LAS float*)lds;
    LAS float* tile = (LAS float*)(lds + 8 * 32 * 33 * 4);
    unsigned char* ws = p.ws;
    const int kw = K >> 3, k0 = w * kw;
    for (int u = vcu; u < N / 32; u += G) {
        const int n0 = 32 * u;
        f32x16 acc;
#pragma unroll
        for (int r = 0; r < 16; ++r) acc[r] = 0.f;
        const f16* wrow = Wt + (size_t)(n0 + c) * K + k0 + 8 * h; const f16* arow = act + (size_t)c * K + k0 + 8 * h;
        for (int kb = 0; kb < kw; kb += 128) {
            f16x8 av[8], bv[8];
#pragma unroll
            for (int i = 0; i < 8; ++i) { av[i] = *(const f16x8*)(wrow + kb + 16 * i); bv[i] = *(const f16x8*)(arow + kb + 16 * i); }
#pragma unroll
            for (int i = 0; i < 8; ++i) acc = __builtin_amdgcn_mfma_f32_32x32x16_f16(av[i], bv[i], acc, 0, 0, 0);
        }
#pragma unroll
        for (int r = 0; r < 16; ++r) red[(w * 32 + (r & 3) + 8 * (r >> 2) + 4 * h) * 33 + c] = acc[r];
        __syncthreads();
        const int tok = tid >> 4, nl = (tid & 15) * 2;
        float v0 = 0.f, v1 = 0.f;
#pragma unroll
        for (int ww = 0; ww < 8; ++ww) { v0 += red[(ww * 32 + nl) * 33 + tok]; v1 += red[(ww * 32 + nl + 1) * 33 + tok]; }
        tile[tok * 33 + nl] = v0; tile[tok * 33 + nl + 1] = v1;
        __syncthreads();
#pragma unroll
        for (int e = 0; e < 2; ++e) {
            const int n = n0 + nl + e; const float v = e ? v1 : v0;
            if (EPI == 0) { const float y = (float)((const f16*)(ws + WS_AS1))[(size_t)tok * DM + n]; ((float*)(ws + WS_YS))[(size_t)tok * DM + n] = y * sigmoidf_(v + p.in[18][(size_t)L * DM + n]); }
            else if (EPI == 1) { const float a = fmaxf(v, 0.f); ((f16*)(ws + WS_HS))[(size_t)tok * FF + n] = (f16)(a * a); }
            else if (EPI == 2) { ((float*)(ws + WS_YS))[(size_t)tok * DM + n] = v; }
            else {
                const int d = n & 127, bq = tok >> 2, ii = tok & 3;
                const float* rp = (const float*)(ws + WS_ROPE) + (size_t)(4096 + ii) * 32;
                float vr = v;
                if (d < 32) { const float cs = rp[d & 15], sn = rp[16 + (d & 15)]; const float xp = tile[tok * 33 + ((nl + e) ^ 16)]; vr = (d < 16) ? (v * cs - xp * sn) : (v * cs + xp * sn); }
                if (n < nkvcols) {
                    const int hh = n >> 7, br = hh >> 3, kv = (hh >> 2) & 1, g = hh & 3, cc = kv * 512 + g * 128 + d;
                    const float o = (br >= 1 && kv == 0) ? vr : v;
                    if (br == 0) p.out[O_CMPS + (size_t)tok * 1024 + cc] = o;
                    else if (br == 1) p.out[O_SLCS + (size_t)tok * 1024 + cc] = o;
                    else p.out[O_SWAS + ((size_t)(bq * 512 + 508 + ii)) * 1024 + cc] = o;
                } else {
                    const int cq = n - nkvcols;
                    if (cq < 2048) { ((float*)(ws + WS_QNS))[(size_t)tok * DM + cq] = v * QSCALE; ((float*)(ws + WS_QRS))[(size_t)tok * DM + cq] = vr * QSCALE; }
                    else if (cq < NQG) ((float*)(ws + WS_GATESS))[(size_t)tok * 48 + cq - 2048] = sigmoidf_(v);
                }
            }
        }
        __syncthreads();
    }
}

__device__ __forceinline__ void cmp2_unit(LAS unsigned char* lds, int unit, const Params& p, int tid_in) {
    int tid = tid_in; asm volatile("" : "+v"(tid));
    unsigned char* ws = p.ws;
    const int lane = tid & 63, w = __builtin_amdgcn_readfirstlane(tid >> 6), fr = lane & 15, q = lane >> 4;
    int mi, part, nvalid, R0, kv, b, g; const bool prompt = unit < 32;
    if (prompt) { mi = unit >> 1; part = unit & 1; nvalid = 255; R0 = mi * 256; kv = mi >> 3; b = (mi >> 2) & 1; g = mi & 3; }
    else { const int us = unit - 32; mi = us >> 3; part = us & 7; nvalid = 1023; R0 = 4096 + mi * 1024; kv = mi >> 5; b = (mi >> 2) & 7; g = mi & 3; }
    const int n0 = part * 128;
    LAS f16* At = (LAS f16*)lds;
    LAS f16* Wt = (LAS f16*)(lds + 67584);
    const f16* PROJ = (const f16*)(ws + WS_PROJ); const float* PE = (const float*)(ws + WS_PE) + kv * 256;
    { const int h4 = (tid & 63) * 4; const f32x4 pe = *(const f32x4*)(PE + h4);
#pragma unroll
      for (int hb = 0; hb < 2; ++hb) {
          f16x4 a[8], bb[8];
#pragma unroll
          for (int i = 0; i < 8; ++i) { const int row = (tid >> 6) + 8 * (hb * 8 + i), n = n0 + row;
              if (n < nvalid) { a[i] = *(const f16x4*)(PROJ + (size_t)(R0 + n) * 512 + h4); bb[i] = *(const f16x4*)(PROJ + (size_t)(R0 + n + 1) * 512 + 256 + h4); }
              else { a[i] = (f16x4){0, 0, 0, 0}; bb[i] = a[i]; } }
#pragma unroll
          for (int i = 0; i < 8; ++i) { const int row = (tid >> 6) + 8 * (hb * 8 + i), n = n0 + row; f16x4 o = {0, 0, 0, 0};
              if (n < nvalid) {
#pragma unroll
                  for (int e = 0; e < 4; ++e) o[e] = (f16)gelu_tanh((float)a[i][e] + (float)bb[i][e] + pe[e]); }
              *(LAS f16x4*)(At + row * 264 + h4) = o; }
      } }
    const f16* W2 = (const f16*)(ws + WS_CW2) + (size_t)kv * 128 * 256;
    for (int idx = tid; idx < 128 * 32; idx += 512) { const int d = idx >> 5, c8 = (idx & 31) * 8; *(LAS f16x8*)(Wt + d * 264 + c8) = *(const f16x8*)(W2 + d * 256 + c8); }
    __syncthreads();
    f32x4 acc[8];
#pragma unroll
    for (int dt = 0; dt < 8; ++dt) acc[dt] = (f32x4){0.f, 0.f, 0.f, 0.f};
#pragma unroll
    for (int s = 0; s < 8; ++s) { const f16x8 bop = *(const LAS f16x8*)(At + (16 * w + fr) * 264 + 32 * s + 8 * q);
#pragma unroll
        for (int dt = 0; dt < 8; ++dt) { const f16x8 aop = *(const LAS f16x8*)(Wt + (16 * dt + fr) * 264 + 32 * s + 8 * q); acc[dt] = __builtin_amdgcn_mfma_f32_16x16x32_f16(aop, bop, acc[dt], 0, 0, 0); } }
    const int n = n0 + 16 * w + fr;
    if (prompt) {
        if (kv == 0) { f16* o = (f16*)(ws + WS_KC) + ((size_t)((b * 4 + g) * 256 + n)) * 128 + 4 * q;
#pragma unroll
            for (int dt = 0; dt < 8; ++dt) *(f16x4*)(o + 16 * dt) = cvt4(acc[dt]); }
        else { const int np = (n & ~12) | ((n & 4) << 1) | ((n & 8) >> 1);
            f16* o = (f16*)(ws + WS_VCT) + ((size_t)(b * 4 + g) * 128) * 256 + np;
#pragma unroll
            for (int dt = 0; dt < 8; ++dt)
#pragma unroll
                for (int r = 0; r < 4; ++r) o[(size_t)(16 * dt + 4 * q + r) * 256] = (f16)acc[dt][r]; }
    } else {
        f16* o = (f16*)(ws + (kv ? WS_VCS : WS_KCS)) + ((size_t)((b * 4 + g) * 1024 + n)) * 128 + 4 * q;
#pragma unroll
        for (int dt = 0; dt < 8; ++dt) *(f16x4*)(o + 16 * dt) = cvt4(acc[dt]);
    }
    __syncthreads();
}

__device__ __forceinline__ void pgates_phase(LAS unsigned char* lds, const f16* Wt, const f16* A, float* GATES, int vcu, int G, int tid_in) {
    int tid = tid_in; asm volatile("" : "+v"(tid));
    const int lane = tid & 63, w = __builtin_amdgcn_readfirstlane(tid >> 6), c = lane & 31, h = lane >> 5;
    LAS float* red = (LAS float*)lds;
    const int k0 = w * 256;
    for (int u = vcu; u < 512; u += G) {
        const int rg = u >> 1, n0 = 2048 + (u & 1) * 32;
        f32x16 acc;
#pragma unroll
        for (int r = 0; r < 16; ++r) acc[r] = 0.f;
        const f16* wrow = Wt + (size_t)(n0 + c) * DM + k0 + 8 * h; const f16* arow = A + (size_t)(rg * 32 + c) * DM + k0 + 8 * h;
#pragma unroll
        for (int kb = 0; kb < 256; kb += 128) {
            f16x8 av[8], bv[8];
#pragma unroll
            for (int i = 0; i < 8; ++i) { av[i] = *(const f16x8*)(wrow + kb + 16 * i); bv[i] = *(const f16x8*)(arow + kb + 16 * i); }
#pragma unroll
            for (int i = 0; i < 8; ++i) acc = __builtin_amdgcn_mfma_f32_32x32x16_f16(av[i], bv[i], acc, 0, 0, 0);
        }
#pragma unroll
        for (int r = 0; r < 16; ++r) red[(w * 32 + (r & 3) + 8 * (r >> 2) + 4 * h) * 33 + c] = acc[r];
        __syncthreads();
        const int tok = tid >> 4, nl = (tid & 15) * 2;
        float v0 = 0.f, v1 = 0.f;
#pragma unroll
        for (int ww = 0; ww < 8; ++ww) { v0 += red[(ww * 32 + nl) * 33 + tok]; v1 += red[(ww * 32 + nl + 1) * 33 + tok]; }
        const int col = (u & 1) * 32 + nl;
        if (col < 48) { float* o = GATES + (size_t)(rg * 32 + tok) * 48 + col; o[0] = sigmoidf_(v0); o[1] = sigmoidf_(v1); }
        __syncthreads();
    }
}
constexpr int AT_KB = 0, AT_VB = 32768, AT_VSZ = 16384, AT_PSUM = 69632, AT_SELM = 135168;
struct AStage { u32x4 k0, k1, v0, v1; };
template <bool HASV>
__device__ __forceinline__ void a_load(AStage& s, const f16* Kb, const f16* Vt, int vstride, int tid) {
    const int p0 = tid, p1 = tid + 512;
    s.k0 = *(const u32x4*)(Kb + (p0 >> 4) * 128 + (p0 & 15) * 8); s.k1 = *(const u32x4*)(Kb + (p1 >> 4) * 128 + (p1 & 15) * 8);
    if (HASV) { s.v0 = *(const u32x4*)(Vt + (size_t)(p0 >> 3) * vstride + (p0 & 7) * 8); s.v1 = *(const u32x4*)(Vt + (size_t)(p1 >> 3) * vstride + (p1 & 7) * 8); }
}
template <bool HASV>
__device__ __forceinline__ void a_store(const AStage& s, LAS unsigned char* kb, LAS unsigned char* vb, int tid) {
    const int p0 = tid, p1 = tid + 512;
    { const int row = p0 >> 4, ch = p0 & 15; *(LAS u32x4*)(kb + row * 256 + ((ch ^ (row & 15)) << 4)) = s.k0; }
    { const int row = p1 >> 4, ch = p1 & 15; *(LAS u32x4*)(kb + row * 256 + ((ch ^ (row & 15)) << 4)) = s.k1; }
    if (HASV) {
        { const int d = p0 >> 3, ch = p0 & 7, g = (d >> 1) & 15; u32x4 v = s.v0; if (g & 1) v = (u32x4){v[2], v[3], v[0], v[1]}; *(LAS u32x4*)(vb + d * 128 + ((ch ^ (g >> 1)) << 4)) = v; }
        { const int d = p1 >> 3, ch = p1 & 7, g = (d >> 1) & 15; u32x4 v = s.v1; if (g & 1) v = (u32x4){v[2], v[3], v[0], v[1]}; *(LAS u32x4*)(vb + d * 128 + ((ch ^ (g >> 1)) << 4)) = v; }
    }
}
__device__ __forceinline__ float l_comb(float l) { const auto rr = __builtin_amdgcn_permlane32_swap(__float_as_uint(l), __float_as_uint(l), false, false); return __uint_as_float(rr[0]) + __uint_as_float(rr[1]); }
template <int BR>
__device__ __forceinline__ void flash_loop(unsigned long long tmask, const f16* Kbase, const f16* Vbase, int vtile, int vstride, LAS unsigned char* lds, const f16x8 (&qf)[8], f32x16 (&acc)[4],
                                           float& m, float& l, float inv_l, int cur, int tk, int vmax, unsigned sel_lo, unsigned sel_hi, int tid_in) {
    if (tmask == 0ull) return;
    int tid_o = tid_in; asm volatile("" : "+v"(tid_o));
    const int tid = tid_o;
    const int lane = tid & 63, c = lane & 31, h = lane >> 5;
    const float NEG = -__builtin_inff();
    int j = __builtin_ctzll(tmask); tmask &= tmask - 1ull;
    const int wv = __builtin_amdgcn_readfirstlane(tid >> 6);
    unsigned koff[2], voff[2];
#pragma unroll
    for (int i = 0; i < 2; ++i) { const int o = wv * 1024 + i * 8192 + lane * 16;
        { const int row = o >> 8, slot = (o >> 4) & 15; koff[i] = (unsigned)(row * 256 + ((slot ^ (row & 15)) << 4)); }
        { const int d = o >> 7, slot = (o >> 4) & 7; voff[i] = (unsigned)(d * vstride * 2 + ((slot ^ ((d >> 1) & 7)) << 4)); } }
#define ATT_ISSUE(tile, buf) do { const char* _kg = (const char*)Kbase + (size_t)(tile) * 16384; const char* _vg = (const char*)Vbase + (size_t)(tile) * vtile * 2; \
        _Pragma("unroll") for (int _i = 0; _i < 2; ++_i) { \
            __builtin_amdgcn_global_load_lds((const unsigned*)(_kg + koff[_i]), (LAS unsigned*)(lds + AT_KB + (buf) * 16384 + wv * 1024 + _i * 8192), 16, 0, 0); \
            if (BR != 0) __builtin_amdgcn_global_load_lds((const unsigned*)(_vg + voff[_i]), (LAS unsigned*)(lds + AT_VB + (buf) * AT_VSZ + wv * 1024 + _i * 8192), 16, 0, 0); } } while (0)
    ATT_ISSUE(j, 0);
    asm volatile("s_waitcnt vmcnt(0)" ::: "memory");
    __syncthreads();
    int bi = 0;
    for (;;) {
        int jn = -1;
        if (tmask != 0ull) { jn = __builtin_ctzll(tmask); tmask &= tmask - 1ull; ATT_ISSUE(jn, bi ^ 1); }
        const LAS unsigned char* kb = lds + AT_KB + bi * 16384; const LAS unsigned char* vb = lds + AT_VB + bi * AT_VSZ;
        int lo = 0, hi = 63;
        if (BR <= 1) { hi = vmax - 64 * j; }
        bool rowoff = false;
        if (BR == 2) { const bool rs = j < 32 ? ((sel_lo >> j) & 1u) : ((sel_hi >> (j - 32)) & 1u);
                       if (j == cur) { if (!rs) { lo = 1; hi = 0; } else hi = tk; } else rowoff = !rs; }
        if (BR == 3) { if (j == cur) hi = tk; else if (j == cur - 8) lo = tk + 1; }
        const bool need_mask = !__all(lo == 0 && hi >= 63);
#ifndef ATT_CDUP
#define ATT_CDUP 1
#endif
        const int nhalf = (BR == 2 && __all(rowoff)) ? 0 : ((BR >= 2) ? 2 * ATT_CDUP : 2);
#ifdef ATT_UNROLL
#pragma unroll
#else
#pragma unroll 1
#endif
        for (int hfi = 0; hfi < nhalf; ++hfi) { const int hf = hfi & 1;
            f32x16 pp;
            if (BR >= 2) { const float bias = rowoff ? NEG : -m;
#pragma unroll
                for (int r = 0; r < 16; ++r) pp[r] = bias; }
            else {
#pragma unroll
                for (int r = 0; r < 16; ++r) pp[r] = 0.f; }
            { f16x8 ka[8];
#pragma unroll
              for (int s = 0; s < 8; ++s) ka[s] = *(const LAS f16x8*)(kb + (c + 32 * hf) * 256 + (((2 * s + h) ^ (c & 15)) << 4));
              __builtin_amdgcn_sched_barrier(0);
#pragma unroll
              for (int s = 0; s < 8; ++s) pp = __builtin_amdgcn_mfma_f32_32x32x16_f16(ka[s], qf[s], pp, 0, 0, 0);
            }
            if (need_mask) {
#pragma unroll
                for (int r = 0; r < 16; ++r) { const int k = (r & 3) + 8 * (r >> 2) + 4 * h + 32 * hf; if (k < lo || k > hi) pp[r] = NEG; }
            }
            if (BR == 1) {
#pragma unroll
                for (int r = 0; r < 16; ++r) pp[r] = __builtin_amdgcn_exp2f(pp[r] - m) * inv_l;
                LAS float* ps = (LAS float*)(lds + AT_PSUM) + tk * 256 + 64 * j + 32 * hf;
                float av[16];
#pragma unroll
                for (int r = 0; r < 16; ++r) { float a = pp[r]; a += DPP_F(a, 0xB1); a += DPP_F(a, 0x4E); av[r] = a; }
                if ((c & 3) == 0) {
#pragma unroll
                    for (int q = 0; q < 4; ++q) *(LAS f32x4*)(ps + 8 * q + 4 * h) = (f32x4){av[4 * q], av[4 * q + 1], av[4 * q + 2], av[4 * q + 3]};
                }
            } else {
                float mx = fmaxf(pp[0], pp[1]);
#pragma unroll
                for (int r = 2; r < 16; r += 2) asm("v_max3_f32 %0, %1, %2, %3" : "=v"(mx) : "v"(mx), "v"(pp[r]), "v"(pp[r + 1]));
                { const auto rr = __builtin_amdgcn_permlane32_swap(__float_as_uint(mx), __float_as_uint(mx), false, false); mx = fmaxf(__uint_as_float(rr[0]), __uint_as_float(rr[1])); }
                float rs = 0.f;
                if (BR >= 2) {
                    if (!__all(mx <= 8.0f)) {
                        const float dlt = fmaxf(mx, 0.f), alpha = __builtin_amdgcn_exp2f(-dlt);
                        m += dlt; l *= alpha;
#pragma unroll
                        for (int dt = 0; dt < 4; ++dt)
#pragma unroll
                            for (int r = 0; r < 16; ++r) acc[dt][r] *= alpha;
#pragma unroll
                        for (int r = 0; r < 16; ++r) pp[r] -= dlt;
                    }
#pragma unroll
                    for (int r = 0; r < 16; ++r) { pp[r] = __builtin_amdgcn_exp2f(pp[r]); rs += pp[r]; }
                } else {
                    if (!__all((mx - m) <= 8.0f)) { const float mn = fmaxf(m, mx), alpha = __builtin_amdgcn_exp2f(m - mn); m = mn; l *= alpha; }
#pragma unroll
                    for (int r = 0; r < 16; ++r) { pp[r] = __builtin_amdgcn_exp2f(pp[r] - m); rs += pp[r]; }
                }
                l += rs;
            }
            if (BR >= 1) {
                f16x8 pk[2];
#pragma unroll
                for (int e = 0; e < 8; ++e) { pk[0][e] = (f16)pp[e]; pk[1][e] = (f16)pp[8 + e]; }
                f16x8 va[4][2];
#pragma unroll
                for (int dt = 0; dt < 4; ++dt)
#pragma unroll
                    for (int s2 = 0; s2 < 2; ++s2) {
                        const int s = 2 * hf + s2;
                        const int gsw = (c >> 1) & 7;
                        va[dt][s2] = *(const LAS f16x8*)(vb + (32 * dt + c) * 128 + (((2 * s + h) ^ gsw) << 4));
                    }
                __builtin_amdgcn_sched_barrier(0);
#pragma unroll
                for (int s2 = 0; s2 < 2; ++s2)
#pragma unroll
                    for (int dt = 0; dt < 4; ++dt) acc[dt] = __builtin_amdgcn_mfma_f32_32x32x16_f16(va[dt][s2], pk[s2], acc[dt], 0, 0, 0);
              }
        }
        asm volatile("s_waitcnt vmcnt(0)" ::: "memory");
        __syncthreads();
        if (jn < 0) break;
        j = jn; bi ^= 1;
    }
#undef ATT_ISSUE
}
__device__ __forceinline__ void out16_update(LAS unsigned char* reg, const f32x16 (&acc)[4], float sc, bool first, int lane) {
#pragma unroll
    for (int dt = 0; dt < 4; ++dt)
#pragma unroll
        for (int hf = 0; hf < 2; ++hf) {
            LAS f16x8* ptr = (LAS f16x8*)(reg + ((dt * 2 + hf) * 64 + lane) * 16);
            f16x8 o;
            if (first) {
#pragma unroll
                for (int e = 0; e < 8; ++e) o[e] = (f16)(acc[dt][8 * hf + e] * sc);
            } else {
                const f16x8 pv = *ptr;
#pragma unroll
                for (int e = 0; e < 8; ++e) o[e] = (f16)((float)pv[e] + acc[dt][8 * hf + e] * sc);
            }
            *ptr = o;
        }
}
__device__ __forceinline__ void attn_prompt_tile(LAS unsigned char* lds, int b, int g, int cur, const Params& p, int tid_in) {
    int tid = tid_in; asm volatile("" : "+v"(tid));
    unsigned char* ws = p.ws;
    const int lane = tid & 63, w = __builtin_amdgcn_readfirstlane(tid >> 6), c = lane & 31, h = lane >> 5;
    const int tk = 8 * w + (c >> 2), t = 64 * cur + tk, hd = 4 * g + (c & 3);
    const size_t row = (size_t)b * SEQ + t;
    LAS unsigned char* oreg = lds + AT_PSUM + w * 8192;
    f32x16 acc[4];
    f16x8 qf[8];
    { const f16* qp = (const f16*)(ws + WS_QN) + row * DM + hd * 128 + 8 * h;
#pragma unroll
      for (int s = 0; s < 8; ++s) qf[s] = *(const f16x8*)(qp + 16 * s); }
    const int ntc = (4 * cur + 2) / 64 + 1;
    const f16* Kc = (const f16*)(ws + WS_KC) + (size_t)(b * 4 + g) * 256 * 128; const f16* Vc = (const f16*)(ws + WS_VCT) + (size_t)(b * 4 + g) * 128 * 256;
    const unsigned long long cmask = (1ull << ntc) - 1ull;
    float m = -1e30f, l = 0.f;
#pragma unroll
    for (int dt = 0; dt < 4; ++dt)
#pragma unroll
        for (int r = 0; r < 16; ++r) acc[dt][r] = 0.f;
    { const int vmax = t >= 31 ? ((t - 31) >> 4) : -1;
      flash_loop<0>(cmask, Kc, Vc, 64, 256, lds, qf, acc, m, l, 0.f, cur, tk, vmax, 0u, 0u, tid);
      l = l_comb(l);
      const float inv_l = l > 0.f ? 1.0f / l : 0.f;
      flash_loop<1>(cmask, Kc, Vc, 64, 256, lds, qf, acc, m, l, inv_l, cur, tk, vmax, 0u, 0u, tid); }
    {
        const LAS float* ps = (const LAS float*)(lds + AT_PSUM);
        LAS unsigned* selm = (LAS unsigned*)(lds + AT_SELM);
        int jj = lane; asm volatile("" : "+v"(jj));
#pragma unroll 1
        for (int k = 0; k < 8; ++k) {
            const int tkk = 8 * w + k; float imp = 0.f;
#pragma unroll
            for (int d = -1; d <= 3; ++d) { const int i = 4 * jj + d; const bool ok = i >= 0 && i < 64 * ntc && i <= 254;
                const float v = ps[tkk * 256 + (ok ? i : 0)]; imp += ok ? v : 0.f; }
            const bool elig = jj <= cur, forced = (jj == 0) || (jj == cur) || (jj == cur - 1);
            const float val = elig ? (forced ? 1.0e4f : imp) : -__builtin_inff();
            int rank = 0;
            const int vbits = __builtin_bit_cast(int, val);
#pragma unroll
            for (int kk = 0; kk < 64; ++kk) { const float vk = __builtin_bit_cast(float, __builtin_amdgcn_readlane(vbits, kk)); rank += ((vk > val) || (vk == val && kk < jj)) ? 1 : 0; }
            const unsigned long long mk = __ballot(elig && rank < 16);
            if (lane == 0) { selm[2 * tkk] = (unsigned)mk; selm[2 * tkk + 1] = (unsigned)(mk >> 32); }
        }
    }
    { const float g_c = ((const float*)(ws + WS_GATES))[row * 48 + hd * 3 + 0];
      LDS_WAIT();
      out16_update(oreg, acc, g_c, true, lane); }
    __syncthreads();
    unsigned sel_lo, sel_hi; unsigned long long umask;
    { const LAS unsigned* selm = (const LAS unsigned*)(lds + AT_SELM);
      unsigned ulo = selm[2 * lane], uhi = selm[2 * lane + 1];
#pragma unroll
      for (int o = 1; o < 64; o <<= 1) { ulo |= __shfl_xor(ulo, o); uhi |= __shfl_xor(uhi, o); }
      umask = ((unsigned long long)(unsigned)__builtin_amdgcn_readfirstlane(uhi) << 32) | (unsigned)__builtin_amdgcn_readfirstlane(ulo);
      sel_lo = selm[2 * tk]; sel_hi = selm[2 * tk + 1]; }
    { const f16* qp = (const f16*)(ws + WS_QN) + row * DM + hd * 128 + 8 * h; const f16* qr = (const f16*)(ws + WS_QR) + row * 512 + hd * 32 + 8 * h;
#pragma unroll
      for (int s = 0; s < 8; ++s) qf[s] = (s < 2) ? *(const f16x8*)(qr + 16 * s) : *(const f16x8*)(qp + 16 * s); }
    m = 0.f; l = 0.f;
#pragma unroll
    for (int dt = 0; dt < 4; ++dt)
#pragma unroll
        for (int r = 0; r < 16; ++r) acc[dt][r] = 0.f;
    flash_loop<2>(umask, (const f16*)(ws + WS_KS) + (size_t)(b * 4 + g) * SEQ * 128, (const f16*)(ws + WS_VST) + (size_t)(b * 4 + g) * 128 * SEQ, 8192, 64, lds, qf, acc, m, l, 0.f, cur, tk, 0, sel_lo, sel_hi, tid);
    { const float g_s = ((const float*)(ws + WS_GATES))[row * 48 + hd * 3 + 1];
      l = l_comb(l); out16_update(oreg, acc, l > 0.f ? g_s / l : 0.f, false, lane); }
    m = 0.f; l = 0.f;
#pragma unroll
    for (int dt = 0; dt < 4; ++dt)
#pragma unroll
        for (int r = 0; r < 16; ++r) acc[dt][r] = 0.f;
    { const int jlo = cur >= 8 ? cur - 8 : 0; const unsigned long long wmask = ((cur == 63 ? ~0ull : ((1ull << (cur + 1)) - 1ull))) & ~((1ull << jlo) - 1ull);
      flash_loop<3>(wmask, (const f16*)(ws + WS_KW) + (size_t)(b * 4 + g) * SEQ * 128, (const f16*)(ws + WS_VWT) + (size_t)(b * 4 + g) * 128 * SEQ, 8192, 64, lds, qf, acc, m, l, 0.f, cur, tk, 0, 0u, 0u, tid); }
    { const float g_w = ((const float*)(ws + WS_GATES))[row * 48 + hd * 3 + 2]; l = l_comb(l); const float sc = l > 0.f ? g_w / l : 0.f;
      f16* op = (f16*)(ws + WS_A1) + row * DM + hd * 128 + 4 * h;
#pragma unroll
      for (int dt = 0; dt < 4; ++dt)
#pragma unroll
          for (int hf = 0; hf < 2; ++hf) {
              const f16x8 pv = *(const LAS f16x8*)(oreg + ((dt * 2 + hf) * 64 + lane) * 16);
              f16x4 o0, o1;
#pragma unroll
              for (int e = 0; e < 4; ++e) { o0[e] = (f16)((float)pv[e] + acc[dt][8 * hf + e] * sc); o1[e] = (f16)((float)pv[4 + e] + acc[dt][8 * hf + 4 + e] * sc); }
              *(f16x4*)(op + 32 * dt + 16 * hf) = o0; *(f16x4*)(op + 32 * dt + 16 * hf + 8) = o1;
          } }
    LDS_WAIT();
    __syncthreads();
}
__device__ __forceinline__ float reduce4(float v0, float v1, float v2, float v3, int lane) {
    const bool up = (lane & 32) != 0;
    float a0 = up ? v2 : v0, a1 = up ? v3 : v1; const float b0 = up ? v0 : v2, b1 = up ? v1 : v3;
    a0 += __shfl_xor(b0, 32); a1 += __shfl_xor(b1, 32);
    const bool up2 = (lane & 16) != 0;
    float c0 = up2 ? a1 : a0; const float d0 = up2 ? a0 : a1;
    c0 += __shfl_xor(d0, 16);
    c0 += __shfl_xor(c0, 8); c0 += __shfl_xor(c0, 4); c0 += __shfl_xor(c0, 2); c0 += __shfl_xor(c0, 1);
    return c0;
}
__device__ __forceinline__ void softmax4(LAS float* sc, int n, int tid) {
    const int lane = tid & 63, w = __builtin_amdgcn_readfirstlane(tid >> 6);
    if (w < 4) {
        LAS float* s = sc + w * 1024; float mx = -__builtin_inff();
        for (int i = lane; i < n; i += 64) mx = fmaxf(mx, s[i]);
        mx = wave_max(mx); if (!(mx > -__builtin_inff())) mx = 0.f;
        float sum = 0.f;
        for (int i = lane; i < n; i += 64) { const float e = __expf(s[i] - mx); s[i] = e; sum += e; }
        sum = wave_sum(sum); const float inv = sum > 0.f ? 1.0f / sum : 1.0f;
        for (int i = lane; i < n; i += 64) s[i] *= inv;
    }
    __syncthreads();
}
constexpr int SA_STG = 33792, SA_V = 17408, SA_QS = 67584, SA_SC2 = 71680, SA_SC = 73728, SA_ST = 74752, SA_LIST = 74816, SA_VAL = 74880, SA_SCALL = 75968;
struct SaRegs { f32x4 k[4], v[4]; };
__device__ __forceinline__ void sa_load_f32(SaRegs& R, const float* r0, const float* r1, int split, int nvalid, int tid) {
#pragma unroll
    for (int i = 0; i < 4; ++i) { const int idx = tid + 512 * i, row = idx >> 5, c4 = (idx & 31) * 4;
        const float* kp = (row < split) ? r0 + (size_t)row * 1024 : r1 + (size_t)(row - split) * 1024;
        if (row < nvalid) { R.k[i] = *(const f32x4*)(kp + c4); R.v[i] = *(const f32x4*)(kp + 512 + c4); }
        else { R.k[i] = (f32x4){0.f, 0.f, 0.f, 0.f}; R.v[i] = (f32x4){0.f, 0.f, 0.f, 0.f}; } }
}
__device__ __forceinline__ void sa_store_f32(const SaRegs& R, LAS unsigned char* stg, int tid) {
#pragma unroll
    for (int i = 0; i < 4; ++i) { const int idx = tid + 512 * i, row = idx >> 5, c4 = (idx & 31) * 4;
        *(LAS f16x4*)(stg + row * 272 + c4 * 2) = cvt4(R.k[i]); *(LAS f16x4*)(stg + SA_V + row * 256 + c4 * 2) = cvt4(R.v[i]); }
}
__device__ __forceinline__ void sa_scores(const LAS unsigned char* stg, const LAS float* q  , LAS float* sc2, int tid) {
    const int key = tid & 63, hd = (tid >> 6) & 3, hf = tid >> 8;
    const LAS f16* kr = (const LAS f16*)(stg + key * 272) + 64 * hf; const LAS float* qr = q + hd * 128 + 64 * hf;
    float s = 0.f;
#pragma unroll
    for (int i = 0; i < 8; ++i) { const f16x8 kk = *(const LAS f16x8*)(kr + 8 * i); const f32x4 qa = *(const LAS f32x4*)(qr + 8 * i), qb = *(const LAS f32x4*)(qr + 8 * i + 4);
        s += (float)kk[0] * qa[0] + (float)kk[1] * qa[1] + (float)kk[2] * qa[2] + (float)kk[3] * qa[3] + (float)kk[4] * qb[0] + (float)kk[5] * qb[1] + (float)kk[6] * qb[2] + (float)kk[7] * qb[3]; }
    sc2[(hf * 4 + hd) * 64 + key] = s;
}
__device__ __forceinline__ void sa_online(LAS unsigned char* lds, int nkeep, int tid) {
    const int lane = tid & 63, w = __builtin_amdgcn_readfirstlane(tid >> 6);
    if (w < 4) {
        const LAS float* sc2 = (const LAS float*)(lds + SA_SC2); LAS float* sc = (LAS float*)(lds + SA_SC); LAS float* st = (LAS float*)(lds + SA_ST);
        float s = sc2[w * 64 + lane] + sc2[(4 + w) * 64 + lane];
        if (lane >= nkeep) s = -__builtin_inff();
        const float mo = st[w], mx = wave_max(s), mn = fmaxf(mo, mx);
        const float pv = __expf(s - mn), ps = wave_sum(pv), al = __expf(mo - mn);
        sc[w * 64 + lane] = pv;
        if (lane == 0) { st[w] = mn; st[4 + w] = st[4 + w] * al + ps; st[8 + w] = al; }
    }
}
__device__ __forceinline__ void attn_sample_unit(LAS unsigned char* lds, int unit, const Params& p, int tid_in) {
    int tid = tid_in; asm volatile("" : "+v"(tid));
    unsigned char* ws = p.ws;
    const int lane = tid & 63, w = __builtin_amdgcn_readfirstlane(tid >> 6);
    const int b = unit >> 4, g = (unit >> 2) & 3, ii = unit & 3, tok = b * LS + ii, t = PAST + ii;
    LAS float* qs = (LAS float*)(lds + SA_QS); LAS float* sc2 = (LAS float*)(lds + SA_SC2); LAS float* sc = (LAS float*)(lds + SA_SC); LAS float* st = (LAS float*)(lds + SA_ST);
    LAS int* list = (LAS int*)(lds + SA_LIST); LAS float* val = (LAS float*)(lds + SA_VAL); LAS float* scall = (LAS float*)(lds + SA_SCALL);
    const int* pt = (const int*)p.in[7] + b * NPAGES;
    { const int hh = (tid >> 7), d = tid & 127;
      qs[hh * 128 + d] = ((const float*)(ws + WS_QNS))[(size_t)tok * DM + (4 * g + hh) * 128 + d];
      qs[512 + hh * 128 + d] = ((const float*)(ws + WS_QRS))[(size_t)tok * DM + (4 * g + hh) * 128 + d]; }
    const int hh_t = tid >> 7, d_t = tid & 127;
    const float* gt = (const float*)(ws + WS_GATESS) + (size_t)tok * 48 + (4 * g + hh_t) * 3;
    const float g_c = gt[0], g_s = gt[1], g_w = gt[2];
    float o_tot = 0.f;
    const f16* Kc = (const f16*)(ws + WS_KCS) + (size_t)(b * 4 + g) * 1024 * 128; const f16* Vc = (const f16*)(ws + WS_VCS) + (size_t)(b * 4 + g) * 1024 * 128;
    {
        f16x8 r0, r1;
        { const int i0 = tid, i1 = tid + 512; r0 = *(const f16x8*)(Kc + (size_t)(i0 >> 4) * 128 + (i0 & 15) * 8); r1 = *(const f16x8*)(Kc + (size_t)(i1 >> 4) * 128 + (i1 & 15) * 8);
          *(LAS f16x8*)(lds + (i0 >> 4) * 272 + (i0 & 15) * 16) = r0; *(LAS f16x8*)(lds + (i1 >> 4) * 272 + (i1 & 15) * 16) = r1; }
        __syncthreads();
        for (int ct = 0; ct < 16; ++ct) {
            LAS unsigned char* cur = lds + (ct & 1) * SA_STG; LAS unsigned char* nxt = lds + ((ct + 1) & 1) * SA_STG;
            if (ct + 1 < 16) { const int i0 = tid, i1 = tid + 512; const f16* kb = Kc + (size_t)(ct + 1) * 64 * 128;
                r0 = *(const f16x8*)(kb + (size_t)(i0 >> 4) * 128 + (i0 & 15) * 8); r1 = *(const f16x8*)(kb + (size_t)(i1 >> 4) * 128 + (i1 & 15) * 8); }
            sa_scores(cur, qs, sc2, tid);
            __syncthreads();
            if (tid < 256) { const int key = tid & 63, hd = tid >> 6, n = 64 * ct + key; scall[hd * 1024 + n] = (n < 1023) ? sc2[hd * 64 + key] + sc2[(4 + hd) * 64 + key] : -__builtin_inff(); }
            if (ct + 1 < 16) { const int i0 = tid, i1 = tid + 512; *(LAS f16x8*)(nxt + (i0 >> 4) * 272 + (i0 & 15) * 16) = r0; *(LAS f16x8*)(nxt + (i1 >> 4) * 272 + (i1 & 15) * 16) = r1; }
            __syncthreads();
        }
    }
    softmax4(scall, 1024, tid);
    if (tid < 257) {
        const int j = tid; float imp = 0.f;
        for (int i = 4 * j - 1; i <= 4 * j + 3; ++i) if (i >= 0 && i <= 1022) imp += (scall[i] + scall[1024 + i]) + (scall[2048 + i] + scall[3072 + i]);
        val[j] = (j == 0 || j >= 255) ? 1.0e4f : imp;
    }
    __syncthreads();
    if (tid < 257) {
        const int j = tid; const float v = val[j]; int rank = 0;
        for (int k = 0; k < 257; ++k) { const float vk = val[k]; rank += ((vk > v) || (vk == v && k < j)) ? 1 : 0; }
        if (rank < 16) list[rank] = j;
    }
    {
        f16x8 r0, r1; float o = 0.f;
        { const int i0 = tid, i1 = tid + 512; r0 = *(const f16x8*)(Vc + (size_t)(i0 >> 4) * 128 + (i0 & 15) * 8); r1 = *(const f16x8*)(Vc + (size_t)(i1 >> 4) * 128 + (i1 & 15) * 8);
          *(LAS f16x8*)(lds + SA_V + (i0 >> 4) * 256 + (i0 & 15) * 16) = r0; *(LAS f16x8*)(lds + SA_V + (i1 >> 4) * 256 + (i1 & 15) * 16) = r1; }
        __syncthreads();
        for (int ct = 0; ct < 16; ++ct) {
            const LAS f16* cur = (const LAS f16*)(lds + (ct & 1) * SA_STG + SA_V); LAS unsigned char* nxt = lds + ((ct + 1) & 1) * SA_STG + SA_V;
            if (ct + 1 < 16) { const int i0 = tid, i1 = tid + 512; const f16* vb = Vc + (size_t)(ct + 1) * 64 * 128;
                r0 = *(const f16x8*)(vb + (size_t)(i0 >> 4) * 128 + (i0 & 15) * 8); r1 = *(const f16x8*)(vb + (size_t)(i1 >> 4) * 128 + (i1 & 15) * 8); }
            const LAS float* pr = scall + hh_t * 1024 + 64 * ct;
#pragma unroll 16
            for (int k = 0; k < 64; ++k) o += pr[k] * (float)cur[k * 128 + d_t];
            if (ct + 1 < 16) { const int i0 = tid, i1 = tid + 512; *(LAS f16x8*)(nxt + (i0 >> 4) * 256 + (i0 & 15) * 16) = r0; *(LAS f16x8*)(nxt + (i1 >> 4) * 256 + (i1 & 15) * 16) = r1; }
            __syncthreads();
        }
        o_tot += g_c * o;
    }
#pragma unroll 1
    for (int br = 0; br < 2; ++br) {
        const int nblk = br == 0 ? 16 : 8;
        const LAS float* q = qs + 512;
        if (tid < 4) { st[tid] = -1e30f; st[4 + tid] = 0.f; st[8 + tid] = 1.f; }
        float o = 0.f;
        SaRegs R;
        const float* r0p; const float* r1p; int split, nvalid;
#define SA_DESC(sidx) do { if (br == 0) { const int blk = list[sidx]; split = 64; r1p = nullptr; \
                if (blk < 256) { r0p = p.in[3] + (((size_t)pt[blk >> 1] * PAGE + (blk & 1) * 64) * 2) * 512 + g * 128; nvalid = 64; } \
                else { r0p = p.out + O_SLCS + (size_t)(b * LS) * 1024 + g * 128; nvalid = ii + 1; } } \
            else { const int pos0 = t - 511 + 64 * (sidx); nvalid = 64; \
                r0p = p.in[4] + ((size_t)(b * 512 + pos0 - (PAST - 512)) * 2) * 512 + g * 128; split = PAST - pos0; if (split > 64) split = 64; \
                r1p = p.out + O_SWAS + ((size_t)(b * 512 + 508)) * 1024 + g * 128; } } while (0)
        SA_DESC(0);
        sa_load_f32(R, r0p, r1p, split, nvalid, tid);
        __syncthreads();
        sa_store_f32(R, lds, tid);
        __syncthreads();
        for (int s = 0; s < nblk; ++s) {
            LAS unsigned char* cur = lds + (s & 1) * SA_STG; LAS unsigned char* nxt = lds + ((s + 1) & 1) * SA_STG;
            const int nv_cur = nvalid;
            if (s + 1 < nblk) { SA_DESC(s + 1); sa_load_f32(R, r0p, r1p, split, nvalid, tid); }
            sa_scores(cur, q, sc2, tid);
            __syncthreads();
            sa_online(lds, nv_cur, tid);
            __syncthreads();
            { const float al = st[8 + hh_t]; const LAS f16* vb = (const LAS f16*)(cur + SA_V); const LAS float* pr = sc + hh_t * 64; float a = 0.f;
#pragma unroll 16
              for (int k = 0; k < 64; ++k) a += pr[k] * (float)vb[k * 128 + d_t];
              o = o * al + a; }
            if (s + 1 < nblk) sa_store_f32(R, nxt, tid);
            __syncthreads();
        }
#undef SA_DESC
        const float lsum = st[4 + hh_t];
        o_tot += (br == 0 ? g_s : g_w) * (lsum > 0.f ? o / lsum : 0.f);
        __syncthreads();
    }
    ((f16*)(ws + WS_AS1))[(size_t)tok * DM + (4 * g + hh_t) * 128 + d_t] = (f16)o_tot;
    __syncthreads();
}
constexpr int NPHASE = 41;
#ifndef SQ0
#define SQ0 40
#endif
#ifndef SG_FIRST
#define SG_FIRST 0
#endif
#ifndef PG8_SP2
#define PG8_SP2 true
#endif
#ifndef PG8_ALIGN
#define PG8_ALIGN false
#endif
#ifndef REP_PRO
#define REP_PRO 1
#endif
#ifndef REP_S5
#define REP_S5 1
#endif
#ifndef REP_ATT
#define REP_ATT 1
#endif
#ifndef REP_SG
#define REP_SG 1
#endif
#ifndef REP_RN
#define REP_RN 1
#endif
#ifndef REP_GEMM
#define REP_GEMM 1
#endif
__host__ __device__ inline bool phase_active(int ph) {
    if (ph == 0) return true;
    const int L = (ph - 1) / 10, s = (ph - 1) % 10;
    if (s == 1) return L <= 2;
    if (s == 2) return L == 2;
    if (s == 4) return false;
    if (s == 3 || s == 5) return L >= 2;
    return true;
}
#ifndef PAD_SEL
#define PAD_SEL 0
#endif
#ifndef PAD_US
#define PAD_US 1000
#endif
#define IN(k) (lo <= (k) && (k) < hi)
#ifndef PAD_LMASK
#define PAD_LMASK 15
#endif
#define PAD_BEGIN(sbit) unsigned long long pad_t0 = 0; if (((PAD_SEL >> (sbit)) & 1) && ((PAD_LMASK >> L) & 1)) pad_t0 = __builtin_amdgcn_s_memrealtime();
#define PAD_END(sbit) if (((PAD_SEL >> (sbit)) & 1) && ((PAD_LMASK >> L) & 1)) { while (__builtin_amdgcn_s_memrealtime() - pad_t0 < (unsigned long long)PAD_US * 100ull) __builtin_amdgcn_s_sleep(8); }
#ifndef BAR_DUP
#define BAR_DUP 1
#endif
#define SEAM(k) do { if (use_bar && (k) + 1 < hi) { for (int _b = 0; _b < BAR_DUP; ++_b) xcd_barrier(bar); } } while (0)
template <int L>
__device__ __forceinline__ void layer_phases(const Params& p, LAS unsigned char* lds, const XcdBarrier& bar, const bool use_bar, const int lo, const int hi, const int tid, const int G, const int bx, const int vcu) {
    unsigned char* const ws = p.ws;
    const int lane = tid & 63, wave = __builtin_amdgcn_readfirstlane(tid >> 6);
    const int gw = vcu * 8 + wave, NGW = G * 8;
    constexpr int base = 1 + 10 * L;
    if (IN(base + 0)) { PAD_BEGIN(0)
        if constexpr (L < 2) {
            for (int rep = 0; rep < REP_S5; ++rep)
            for (int u = vcu; u < NBP * NG; u += G) s5_prompt_unit(lds, L, u >> 7, u & 127, p, tid);
            for (int rep = 0; rep < REP_S5; ++rep)
            for (int u = gw; u < NBS * NG; u += NGW) s5_sample_wave(L, u >> 7, u & 127, p, lane);
        } else {
            constexpr int N = (L == 2) ? (NKV + NQGP) : DM; const f16* Wt = (const f16*)(ws + (L == 2 ? WS_WKVQG : WS_WQG1));
            pg8::Gemm g{(const f16*)(ws + WS_X), Wt, MP, N, DM}; pg8::StaticOrder S; S.init(MP, N, G, bx);
            pg8::EpiProj E{L == 2 ? 12 : 0, p.out, (f16*)(ws + WS_RC), (f16*)(ws + WS_KS), (f16*)(ws + WS_VST), (f16*)(ws + WS_KW), (f16*)(ws + WS_VWT), (f16*)(ws + WS_QN), (f16*)(ws + WS_QR), (float*)(ws + WS_GATES), (const float*)(ws + WS_ROPE)};
            pg8::gemm_phase<pg8::EpiProj, pg8::StaticOrder, PG8_ALIGN, PG8_SP2>(lds, g, S, E);
            if constexpr (L == 2) {
                if (G == 256 && bx >= 160) {
                    pg8::Gemm g2{(const f16*)(ws + WS_RC), (const f16*)(ws + WS_CW1), 272 * 256, 1024, 2048}; pg8::CmpOrder S2{1 << 20, 448 + (bx - 160), 544};
                    pg8::EpiF16 E2{(f16*)(ws + WS_PROJ), 512, 1};
                    pg8::gemm_phase<pg8::EpiF16, pg8::CmpOrder, PG8_ALIGN, PG8_SP2>(lds, g2, S2, E2);
                }
            }
            if constexpr (L == 3) pgates_phase(lds, Wt, (const f16*)(ws + WS_X), (float*)(ws + WS_GATES), vcu, G, tid);
            sgemm_phase<3>(lds, Wt, (L == 2) ? N : NQGP, DM, (const f16*)(ws + WS_AS0), p, L, L == 2 ? NKV : 0, vcu, G, tid);
        }
        PAD_END(0) SEAM(base + 0);
    }
    if constexpr (L <= 2) {
        if (IN(base + 1)) { PAD_BEGIN(1)
            if constexpr (L < 2) {
                const f16* Wt = (const f16*)(ws + WS_WGLU) + (size_t)L * DM * DM;
                pg8::Gemm g{(const f16*)(ws + WS_A1), Wt, MP, DM, DM}; pg8::StaticOrder S; S.init(MP, DM, G, bx);
                pg8::EpiGLU E{(f16*)(ws + WS_Y), (const f16*)(ws + WS_A1), p.in[18] + (size_t)L * DM};
                if (SG_FIRST && (bx & 1)) { sgemm_phase<0>(lds, Wt, DM, DM, (const f16*)(ws + WS_AS1), p, L, 0, vcu, G, tid); }
                pg8::gemm_phase<pg8::EpiGLU, pg8::StaticOrder, PG8_ALIGN, PG8_SP2>(lds, g, S, E);
                if (!(SG_FIRST && (bx & 1))) { sgemm_phase<0>(lds, Wt, DM, DM, (const f16*)(ws + WS_AS1), p, L, 0, vcu, G, tid); }
            } else {
                pg8::Gemm g{(const f16*)(ws + WS_RC), (const f16*)(ws + WS_CW1), 272 * 256, 1024, 2048}; pg8::CmpOrder S{G, bx, G == 256 ? 448 : 544};
                pg8::EpiF16 E{(f16*)(ws + WS_PROJ), 512, 1};
                pg8::gemm_phase<pg8::EpiF16, pg8::CmpOrder, PG8_ALIGN, PG8_SP2>(lds, g, S, E);
            }
            PAD_END(1) SEAM(base + 1);
        }
    }
    if constexpr (L == 2) {
        if (IN(base + 2)) { PAD_BEGIN(2)
            for (int u = vcu; u < 544; u += G) cmp2_unit(lds, u, p, tid);
            PAD_END(2) SEAM(base + 2);
        }
    }
    if constexpr (L >= 2) {
        if (IN(base + 3)) { PAD_BEGIN(3)
            { const int xq = bx & 7;
              unsigned* qctr = (unsigned*)(ws + WS_CTL) + 2048 + 64 * ((L - 2) * 8 + xq);
              volatile LAS unsigned* qslot = (volatile LAS unsigned*)(lds + LDS_XB) + 2;
              for (;;) {
                  if (tid == 0) qslot[0] = __hip_atomic_fetch_add(qctr, 1u, __ATOMIC_RELAXED, __HIP_MEMORY_SCOPE_AGENT);
                  __syncthreads();
                  const int it = (int)qslot[0];
                  __syncthreads();
                  if (it >= 80) break;
                  if (it >= SQ0 && it < SQ0 + 16) attn_sample_unit(lds, xq * 16 + (it - SQ0), p, tid);
                  else attn_prompt_tile(lds, xq >> 2, xq & 3, 63 - (it < SQ0 ? it : it - 16), p, tid);
              } }
            PAD_END(3) SEAM(base + 3);
        }
        if (IN(base + 5)) { PAD_BEGIN(5)
            const f16* Wt = (const f16*)(ws + WS_WO) + (size_t)(L - 2) * DM * DM;
            pg8::Gemm g{(const f16*)(ws + WS_A1), Wt, MP, DM, DM}; pg8::StaticOrder S; S.init(MP, DM, G, bx);
            pg8::EpiF16 E{(f16*)(ws + WS_Y), DM, 0x7fffffff};
            if (SG_FIRST && (bx & 1)) { sgemm_phase<2>(lds, Wt, DM, DM, (const f16*)(ws + WS_AS1), p, L, 0, vcu, G, tid); }
            pg8::gemm_phase<pg8::EpiF16, pg8::StaticOrder, PG8_ALIGN, PG8_SP2>(lds, g, S, E);
            if (!(SG_FIRST && (bx & 1))) { sgemm_phase<2>(lds, Wt, DM, DM, (const f16*)(ws + WS_AS1), p, L, 0, vcu, G, tid); }
            PAD_END(5) SEAM(base + 5);
        }
    }
    if (IN(base + 6)) { PAD_BEGIN(6)
        const float* gpost = (L < 2) ? p.in[19] + (size_t)L * DM : p.in[31] + (size_t)(L - 2) * DM;
        resnorm2_rows<(L == 0), 1>((const f16*)(ws + WS_Y), gpost, p.in[0], (f16*)(ws + WS_X), (float*)(ws + WS_RS), nullptr, nullptr, nullptr, gw, NGW, MP, lane);
        if (gw < MS) resnorm_row((const float*)(ws + WS_YS), gpost, (L == 0) ? p.in[1] : (const float*)(ws + WS_XS), (float*)(ws + WS_XS), 1, nullptr, (f16*)(ws + WS_AS0), nullptr, gw, lane);
        PAD_END(6) SEAM(base + 6);
    }
    if (IN(base + 7)) { PAD_BEGIN(7)
        const f16* Wt = (const f16*)(ws + WS_WUP) + (size_t)L * DM * FF;
        pg8::Gemm g{(const f16*)(ws + WS_X), Wt, MP, FF, DM}; pg8::StaticOrder S; S.init(MP, FF, G, bx);
        pg8::EpiRelu2 E{(f16*)(ws + WS_H), FF};
        if (SG_FIRST && (bx & 1)) { sgemm_phase<1>(lds, Wt, FF, DM, (const f16*)(ws + WS_AS0), p, L, 0, vcu, G, tid); }
        pg8::gemm_phase<pg8::EpiRelu2, pg8::StaticOrder, PG8_ALIGN, PG8_SP2>(lds, g, S, E);
        if (!(SG_FIRST && (bx & 1))) { sgemm_phase<1>(lds, Wt, FF, DM, (const f16*)(ws + WS_AS0), p, L, 0, vcu, G, tid); }
        PAD_END(7) SEAM(base + 7);
    }
    if (IN(base + 8)) { PAD_BEGIN(8)
        const f16* Wt = (const f16*)(ws + WS_WDN) + (size_t)L * DM * FF;
        pg8::Gemm g{(const f16*)(ws + WS_H), Wt, MP, DM, FF}; pg8::StaticOrder S; S.init(MP, DM, G, bx);
        pg8::EpiF16 E{(f16*)(ws + WS_Y), DM, 0x7fffffff};
        if (SG_FIRST && (bx & 1)) { sgemm_phase<2>(lds, Wt, DM, FF, (const f16*)(ws + WS_HS), p, L, 0, vcu, G, tid); }
        pg8::gemm_phase<pg8::EpiF16, pg8::StaticOrder, PG8_ALIGN, PG8_SP2>(lds, g, S, E);
        if (!(SG_FIRST && (bx & 1))) { sgemm_phase<2>(lds, Wt, DM, FF, (const f16*)(ws + WS_HS), p, L, 0, vcu, G, tid); }
        PAD_END(8) SEAM(base + 8);
    }
    if (IN(base + 9)) { PAD_BEGIN(9)
        const float* gpost = p.in[35] + (size_t)L * DM;
        if constexpr (L == 0) resnorm2_rows<false, 2>((const f16*)(ws + WS_Y), gpost, nullptr, (f16*)(ws + WS_X), (float*)(ws + WS_RS), nullptr, p.in[8] + DM, (f16*)(ws + WS_A0), gw, NGW, MP, lane);
        else if constexpr (L < 3) resnorm2_rows<false, 1>((const f16*)(ws + WS_Y), gpost, nullptr, (f16*)(ws + WS_X), (float*)(ws + WS_RS), nullptr, nullptr, nullptr, gw, NGW, MP, lane);
        else resnorm2_rows<false, 0>((const f16*)(ws + WS_Y), gpost, nullptr, (f16*)(ws + WS_X), (float*)(ws + WS_RS), p.out + O_YP, nullptr, nullptr, gw, NGW, MP, lane);
        if (gw < MS) {
            if constexpr (L == 0) resnorm_row((const float*)(ws + WS_YS), gpost, (const float*)(ws + WS_XS), (float*)(ws + WS_XS), 3, p.in[8] + DM, nullptr, (float*)(ws + WS_XNS), gw, lane);
            else if constexpr (L < 3) resnorm_row((const float*)(ws + WS_YS), gpost, (const float*)(ws + WS_XS), (float*)(ws + WS_XS), 1, nullptr, (f16*)(ws + WS_AS0), nullptr, gw, lane);
            else resnorm_row((const float*)(ws + WS_YS), gpost, (const float*)(ws + WS_XS), p.out + O_YS, 0, nullptr, nullptr, nullptr, gw, lane);
        }
        PAD_END(9) SEAM(base + 9);
    }
}
__global__ void __launch_bounds__(512, 2) mk_fwd(Params p) {
    extern __shared__ __attribute__((aligned(16))) unsigned char lds_raw[];
    LAS unsigned char* lds = (LAS unsigned char*)lds_raw;
    const int tid = threadIdx.x;
    const int G = gridDim.x, bx = blockIdx.x, vcu = (G % 8 == 0) ? (bx % 8) * (G / 8) + bx / 8 : bx;
    if (tid < 4) ((LAS unsigned*)(lds + LDS_XB))[tid] = 0u;
    __syncthreads();
    const int lo = p.ph_lo, hi = p.ph_hi;
    const bool use_bar = (hi - lo) > 1;
    XcdBarrier bar; bar.bar = (unsigned*)(p.ws + WS_CTL) + CW_BAR; bar.x = 0; bar.st = (volatile LAS unsigned*)(lds + LDS_XB);
    if (use_bar) bar = xcd_barrier_post((unsigned*)(p.ws + WS_CTL) + CW_BAR, (volatile LAS unsigned*)(lds + LDS_XB));
    if (IN(0)) { constexpr int L = 0; PAD_BEGIN(10) ph_prologue(p, lds, vcu, G, tid); if (REP_PRO > 1) { __syncthreads(); ph_prologue(p, lds, vcu, G, tid); } PAD_END(10) SEAM(0); }
    layer_phases<0>(p, lds, bar, use_bar, lo, hi, tid, G, bx, vcu);
    layer_phases<1>(p, lds, bar, use_bar, lo, hi, tid, G, bx, vcu);
    layer_phases<2>(p, lds, bar, use_bar, lo, hi, tid, G, bx, vcu);
    layer_phases<3>(p, lds, bar, use_bar, lo, hi, tid, G, bx, vcu);
}
#undef IN
#undef SEAM

#ifndef MK_MULTI_LAUNCH
#define MK_MULTI_LAUNCH 0
#endif
extern "C" void kernel_launch(void* const* d_in, const int* in_sizes, int n_in, void* d_out, int out_size, void* d_ws, size_t ws_size, hipStream_t stream) {
    static int grid = 0;
    if (grid == 0) {
        if (n_in != 36 || (size_t)out_size != O_END || ws_size < WS_END) { fprintf(stderr, "kernel_launch: unexpected shapes: n_in %d out %d ws %zu (need %zu)\n", n_in, out_size, ws_size, (size_t)WS_END); grid = -1; return; }
        int dev = 0, cus = 0, per_cu = 0;
        if (hipGetDevice(&dev) != hipSuccess || hipDeviceGetAttribute(&cus, hipDeviceAttributeMultiprocessorCount, dev) != hipSuccess) { grid = -1; return; }
        if (hipFuncSetAttribute((const void*)mk_fwd, hipFuncAttributeMaxDynamicSharedMemorySize, LDS_BYTES) != hipSuccess) { fprintf(stderr, "kernel_launch: hipFuncSetAttribute failed\n"); grid = -1; return; }
        if (hipOccupancyMaxActiveBlocksPerMultiprocessor(&per_cu, (const void*)mk_fwd, 512, LDS_BYTES) != hipSuccess || per_cu < 1) fprintf(stderr, "kernel_launch: occupancy query reports %d\n", per_cu);
        (void)hipGetLastError();
        grid = cus;
    }
    if (grid < 0) return;
    (void)hipMemsetAsync((char*)d_ws + WS_CTL, 0, CTL_BYTES, stream);
    Params P{};
    for (int i = 0; i < 36; ++i) P.in[i] = (const float*)d_in[i];
    P.out = (float*)d_out; P.ws = (unsigned char*)d_ws;
    for (int i = 0; i < 16; ++i) P.inv_freq[i] = powf(500000.0f, -(float)i / 16.0f);
#if MK_MULTI_LAUNCH
    for (int ph = 0; ph < NPHASE; ++ph) { if (!phase_active(ph)) continue; P.ph_lo = ph; P.ph_hi = ph + 1; hipLaunchKernelGGL(mk_fwd, dim3(grid), dim3(512), LDS_BYTES, stream, P); }
#else
    P.ph_lo = 0; P.ph_hi = NPHASE;
    hipLaunchKernelGGL(mk_fwd, dim3(grid), dim3(512), LDS_BYTES, stream, P);
#endif
    const hipError_t le = hipPeekAtLastError();
    if (le != hipSuccess) fprintf(stderr, "kernel_launch: launch failed: %s\n", hipGetErrorName(le));
}
```
